# Optimizing an MI355X kernel written in HIP

```python
import jax, jax.numpy as jnp
from jax import lax
import numpy as np

D_MODEL = 1024
BATCH = 4
SEQ = 8192
DEPTH = 1

MIX_WIDTH = D_MODEL
HEAD_DIM = 64
N_HEADS = (MIX_WIDTH // 2) // HEAD_DIM
N_KV_HEADS = 2
ATTN_WIDTH = N_HEADS * HEAD_DIM
KV_WIDTH = N_KV_HEADS * HEAD_DIM
CONV_CH = MIX_WIDTH - ATTN_WIDTH
CONV_GROUPS = CONV_CH // HEAD_DIM
CONV_W = 31
IN_WIDTH = ATTN_WIDTH + 2 * KV_WIDTH + 2 * CONV_CH
Q_BLOCK = 128
GRID_W = 64
ROPE_THETA = 10000.0
ROPE_AXIS_DIM = HEAD_DIM // 2
N_KEYS = 128
N_EXPERTS = N_KEYS * N_KEYS
PEER_HEADS = 8
PEER_DQ = 256
PEER_TOPK = 16
TOKEN_CHUNK = 128
EPS = 1e-6

kernel_name = "hybrid_conv_gqa_peer_encoder"


def _rmsnorm(x, g):
    xf = x.astype(jnp.float32)
    y = xf * lax.rsqrt(jnp.mean(xf * xf, axis=-1, keepdims=True) + EPS)
    return (y * g.astype(jnp.float32)).astype(x.dtype)


def _layernorm(x, g, b):
    xf = x.astype(jnp.float32)
    mu = jnp.mean(xf, axis=-1, keepdims=True)
    var = jnp.mean(jnp.square(xf - mu), axis=-1, keepdims=True)
    y = (xf - mu) * lax.rsqrt(var + EPS)
    return (y * g.astype(jnp.float32) + b.astype(jnp.float32)).astype(x.dtype)


def _rope_rotate(x, ang):
    p = ang.shape[-1]
    cos = jnp.cos(ang)[:, None, :]
    sin = jnp.sin(ang)[:, None, :]
    xf = x.astype(jnp.float32)
    x1, x2 = xf[..., :p], xf[..., p:]
    return jnp.concatenate([x1 * cos - x2 * sin, x2 * cos + x1 * sin], axis=-1)


def _axial_rope(x, ang_row, ang_col):
    r = _rope_rotate(x[..., :ROPE_AXIS_DIM], ang_row)
    c = _rope_rotate(x[..., ROPE_AXIS_DIM:], ang_col)
    return jnp.concatenate([r, c], axis=-1).astype(x.dtype)


def _gqa_blocked(q, k, v):
    b, s, hkv, g, hd = q.shape
    nb = s // Q_BLOCK
    qb = q.reshape(b, nb, Q_BLOCK, hkv, g, hd).transpose(1, 0, 2, 3, 4, 5)

    def one_block(qblk):
        sc = jnp.einsum('bqkgd,bskd->bkgqs', qblk, k).astype(jnp.float32)
        p = jax.nn.softmax(sc, axis=-1).astype(v.dtype)
        return jnp.einsum('bkgqs,bskd->bqkgd', p, v)

    ob = lax.map(one_block, qb)
    return ob.transpose(1, 0, 2, 3, 4, 5).reshape(b, s, hkv * g * hd)


def _conformer_conv(a, gate, conv_dw, conv_b, conv_ln_g, conv_ln_b):
    h = a * jax.nn.sigmoid(gate)
    pad = (CONV_W - 1) // 2
    h = lax.conv_general_dilated(
        h, conv_dw.astype(h.dtype), window_strides=(1,), padding=((pad, pad),),
        dimension_numbers=('NWC', 'WIO', 'NWC'), feature_group_count=CONV_CH)
    h = h + conv_b.astype(h.dtype)
    h = _layernorm(h, conv_ln_g, conv_ln_b)
    return jax.nn.silu(h)


def _peer(xn, peer_wq, peer_keys, peer_u, peer_v):
    t, d = xn.shape
    xc_all = xn.reshape(t // TOKEN_CHUNK, TOKEN_CHUNK, d)
    half = PEER_DQ // 2

    def chunk(xc):
        q = (xc @ peer_wq).reshape(TOKEN_CHUNK, PEER_HEADS, PEER_DQ)
        s1 = jnp.einsum('chd,nd->chn', q[..., :half], peer_keys[0]).astype(jnp.float32)
        s2 = jnp.einsum('chd,nd->chn', q[..., half:], peer_keys[1]).astype(jnp.float32)
        v1, i1 = lax.top_k(s1, PEER_TOPK)
        v2, i2 = lax.top_k(s2, PEER_TOPK)
        cand_s = (v1[..., :, None] + v2[..., None, :]).reshape(TOKEN_CHUNK, PEER_HEADS, -1)
        cand_i = (i1[..., :, None] * N_KEYS + i2[..., None, :]).reshape(TOKEN_CHUNK, PEER_HEADS, -1)
        top_s, pos = lax.top_k(cand_s, PEER_TOPK)
        e = jnp.take_along_axis(cand_i, pos, axis=-1)
        g = jax.nn.softmax(top_s, axis=-1).astype(xc.dtype)
        u = peer_u[e]
        h = jax.nn.gelu(jnp.einsum('cd,chkd->chk', xc, u))
        return jnp.einsum('chk,chkd->cd', g * h, peer_v[e])

    return lax.map(chunk, xc_all).reshape(t, d)


def setup_inputs(seed: int = 0) -> dict:
    key = jax.random.key(seed)
    ks = jax.random.split(key, 16)
    f32 = jnp.float32
    nrm = lambda k, shp, sc: jax.random.normal(k, shp, f32) * sc
    return {
        "x": nrm(ks[0], (BATCH, SEQ, D_MODEL), 1.0),
        "norm1_g": 1.0 + nrm(ks[1], (D_MODEL,), 0.02),
        "w_in": nrm(ks[2], (D_MODEL, IN_WIDTH), D_MODEL ** -0.5),
        "q_norm_g": 1.0 + nrm(ks[3], (HEAD_DIM,), 0.02),
        "k_norm_g": 1.0 + nrm(ks[4], (HEAD_DIM,), 0.02),
        "conv_dw": nrm(ks[5], (CONV_W, 1, CONV_CH), CONV_W ** -0.5),
        "conv_b": nrm(ks[6], (CONV_CH,), 0.01),
        "conv_ln_g": 1.0 + nrm(ks[7], (CONV_CH,), 0.02),
        "conv_ln_b": nrm(ks[8], (CONV_CH,), 0.01),
        "w_out": nrm(ks[9], (MIX_WIDTH, D_MODEL), MIX_WIDTH ** -0.5),
        "norm2_g": 1.0 + nrm(ks[10], (D_MODEL,), 0.02),
        "peer_wq": nrm(ks[11], (D_MODEL, PEER_HEADS * PEER_DQ), D_MODEL ** -0.5),
        "peer_keys": nrm(ks[12], (2, N_KEYS, PEER_DQ // 2), (PEER_DQ // 2) ** -0.5),
        "peer_u": nrm(ks[13], (N_EXPERTS, D_MODEL), D_MODEL ** -0.5),
        "peer_v": nrm(ks[14], (N_EXPERTS, D_MODEL), 0.3),
        "final_g": 1.0 + nrm(ks[15], (D_MODEL,), 0.02),
    }


def reference(x, norm1_g, w_in, q_norm_g, k_norm_g, conv_dw, conv_b, conv_ln_g,
              conv_ln_b, w_out, norm2_g, peer_wq, peer_keys, peer_u, peer_v, final_g):
    b, s, d = x.shape
    rows = s // GRID_W
    row = jnp.repeat(jnp.arange(rows), GRID_W).astype(jnp.float32)
    col = jnp.tile(jnp.arange(GRID_W), rows).astype(jnp.float32)
    n_pairs = ROPE_AXIS_DIM // 2
    inv_freq = ROPE_THETA ** (-jnp.arange(n_pairs, dtype=jnp.float32) / n_pairs)
    ang_row = row[:, None] * inv_freq[None, :]
    ang_col = col[:, None] * inv_freq[None, :]
    group = N_HEADS // N_KV_HEADS

    for _ in range(DEPTH):
        h = _rmsnorm(x, norm1_g)
        p = h @ w_in
        o0 = ATTN_WIDTH
        o1 = o0 + KV_WIDTH
        o2 = o1 + KV_WIDTH
        o3 = o2 + CONV_CH
        q = p[..., :o0].reshape(b, s, N_HEADS, HEAD_DIM)
        k = p[..., o0:o1].reshape(b, s, N_KV_HEADS, HEAD_DIM)
        v = p[..., o1:o2].reshape(b, s, N_KV_HEADS, HEAD_DIM)
        q = _axial_rope(_rmsnorm(q, q_norm_g), ang_row, ang_col)
        k = _axial_rope(_rmsnorm(k, k_norm_g), ang_row, ang_col)
        q = (q * (HEAD_DIM ** -0.5)).reshape(b, s, N_KV_HEADS, group, HEAD_DIM)
        attn_out = _gqa_blocked(q, k, v)
        conv_out = _conformer_conv(p[..., o2:o3], p[..., o3:], conv_dw, conv_b,
                                   conv_ln_g, conv_ln_b)
        mixed = jnp.concatenate([attn_out, conv_out], axis=-1)
        x = x + mixed @ w_out
        hn = _rmsnorm(x, norm2_g).reshape(b * s, d)
        x = x + _peer(hn, peer_wq, peer_keys, peer_u, peer_v).reshape(b, s, d)

    return _rmsnorm(x, final_g)
```

```cpp
#include <hip/hip_runtime.h>
#include <cstdio>
#include <cstdint>
namespace pg8 {
#define PG8_LAS __attribute__((address_space(3)))
typedef unsigned short bf16_t;
typedef short bf16x8 __attribute__((ext_vector_type(8)));
typedef float f32x4 __attribute__((ext_vector_type(4)));
typedef unsigned u32x4 __attribute__((ext_vector_type(4)));
constexpr int BM = 256, BK = 64, HALF = 128, HTB = HALF * BK * 2  , STAGE_BYTES = 8 * HTB, NXCD = 8, WGM = 8;

__host__ __device__ __forceinline__ int lds_byte(int r, int c) { const int st = (r >> 4) * 2 + (c >> 5), rr = r & 15, cc = c & 31, ob = rr * 64 + cc * 2; return st * 1024 + (ob ^ (((ob >> 9) & 1) << 5)); }
__host__ __device__ __forceinline__ void stage_rc(int b, int& R, int& C) { const int st = b / 1024, sb = b % 1024, swz = sb ^ (((sb >> 9) & 1) << 5); R = (st >> 1) * 16 + swz / 64; C = (st & 1) * 32 + (swz % 64) / 2; }
__host__ __device__ __forceinline__ int perm32(int rho) { const int n = rho >> 4, i = rho & 15; return 8 * (i >> 2) + 4 * n + (i & 3); }

struct Unit { int pm, pn; };
struct Gemm { const bf16_t* A; const bf16_t* Bt; int M, N, K; };

struct StaticOrder {
    int nM, nN, nwg, G, c;
    __host__ __device__ void init(int M, int N, int G_, int c_) { nM = M / BM; nN = N / BM; nwg = nM * nN; G = G_; c = c_; }
    __host__ __device__ bool next(int i, Unit& u) const {
        const long L = (long)i * G + c; if (L >= nwg) return false;
        int wgid = (int)L; { const int q = nwg / NXCD, r = nwg % NXCD, xcd = wgid % NXCD, off = wgid / NXCD; wgid = (xcd < r ? xcd * (q + 1) : r * (q + 1) + (xcd - r) * q) + off; }
        const int nig = WGM * nN, gid = wgid / nig, fm = gid * WGM, gsz = (nM - fm) < WGM ? (nM - fm) : WGM;
        u.pm = fm + ((wgid % nig) % gsz); u.pn = (wgid % nig) / gsz; return true;
    }
    __device__ __forceinline__ void a_ready(const Unit&) const {}
    __device__ __forceinline__ void done(const Unit&) const {}
};


__device__ __forceinline__ unsigned cvt_pk_bf16(float lo, float hi) { unsigned r; asm volatile("v_cvt_pk_bf16_f32 %0, %1, %2" : "=v"(r) : "v"(lo), "v"(hi)); return r; }
__device__ __forceinline__ u32x4 pack8(const f32x4 a, const f32x4 b) { u32x4 w; w.x = cvt_pk_bf16(a[0], a[1]); w.y = cvt_pk_bf16(a[2], a[3]); w.z = cvt_pk_bf16(b[0], b[1]); w.w = cvt_pk_bf16(b[2], b[3]); return w; }

struct EpiP1 {
    static constexpr bool PERM = true, AFTER_DRAIN = false;
    bf16_t *Q, *Kb, *Vb, *H; const float *qg, *kg; const float* rope; float qscale;
    __device__ __forceinline__ void operator()(const f32x4 (&acc)[2][2][4][2], const Unit& u, int wr, int wc, int fr, int fq) const {
        const int row0 = u.pm * BM + wr * 64 + fr;
        if (u.pn < 2 || (u.pn == 2 && wc < 2)) {
            const bool isq = u.pn < 2;
            const float* g = isq ? qg : kg;
            f32x4 gv[2][2];
#pragma unroll
            for (int bj = 0; bj < 2; ++bj)
#pragma unroll
                for (int n = 0; n < 2; ++n) gv[bj][n] = *(const f32x4*)(g + 32 * bj + 16 * n + 4 * fq);
            const float sc = isq ? qscale : 1.f;
            bf16_t* base = isq ? (Q + (4 * u.pn + wc) * 64) : (Kb + wc * 64);
            const int pitch = isq ? 512 : 128;
#pragma unroll
            for (int ai = 0; ai < 2; ++ai)
#pragma unroll
                for (int m = 0; m < 4; ++m) {
                    const int row = row0 + ai * HALF + m * 16;
                    float ss = 0.f;
#pragma unroll
                    for (int bj = 0; bj < 2; ++bj)
#pragma unroll
                        for (int n = 0; n < 2; ++n) { const f32x4 v = acc[ai][bj][m][n]; ss += (v[0] * v[0] + v[1] * v[1]) + (v[2] * v[2] + v[3] * v[3]); }
                    ss += __shfl_xor(ss, 16); ss += __shfl_xor(ss, 32);
                    const float rstd = __builtin_amdgcn_rsqf(ss * (1.0f / 64.0f) + 1e-6f) * sc;
                    const int t = row & 8191;
#pragma unroll
                    for (int bj = 0; bj < 2; ++bj) {
                        const int pos = bj ? (t & 63) : (t >> 6);
                        const f32x4* rp = (const f32x4*)(rope + (pos * 16 + 4 * fq) * 2);
                        const f32x4 r01 = rp[0], r23 = rp[1];
                        const f32x4 x1 = acc[ai][bj][m][0] * gv[bj][0] * rstd, x2 = acc[ai][bj][m][1] * gv[bj][1] * rstd;
                        const f32x4 cs = (f32x4){r01[0], r01[2], r23[0], r23[2]}, sn = (f32x4){r01[1], r01[3], r23[1], r23[3]};
                        const f32x4 o1 = x1 * cs - x2 * sn, o2 = x2 * cs + x1 * sn;
                        *(u32x4*)(base + (size_t)row * pitch + 32 * bj + 8 * fq) = pack8(o1, o2);
                    }
                }
        } else if (u.pn == 2) {
            bf16_t* base = Vb + (wc - 2) * 64;
#pragma unroll
            for (int ai = 0; ai < 2; ++ai)
#pragma unroll
                for (int m = 0; m < 4; ++m) {
                    const int row = row0 + ai * HALF + m * 16;
#pragma unroll
                    for (int bj = 0; bj < 2; ++bj) *(u32x4*)(base + (size_t)row * 128 + 32 * bj + 8 * fq) = pack8(acc[ai][bj][m][0], acc[ai][bj][m][1]);
                }
        } else {
            bf16_t* base = H + (u.pn - 3) * 128 + wc * 32 + 8 * fq;
#pragma unroll
            for (int ai = 0; ai < 2; ++ai)
#pragma unroll
                for (int m = 0; m < 4; ++m) {
                    const int row = row0 + ai * HALF + m * 16;
                    f32x4 o[2];
#pragma unroll
                    for (int n = 0; n < 2; ++n) { const f32x4 a = acc[ai][0][m][n], b = acc[ai][1][m][n];
#pragma unroll
                        for (int e = 0; e < 4; ++e) o[n][e] = a[e] * __builtin_amdgcn_rcpf(1.0f + __builtin_amdgcn_exp2f(-1.4426950408889634f * b[e])); }
                    *(u32x4*)(base + (size_t)row * 512) = pack8(o[0], o[1]);
                }
        }
    }
};

struct EpiP3 {
    static constexpr bool PERM = true, AFTER_DRAIN = false;
    const float* x; float* X1; bf16_t* X1B; float* SS;
    __device__ __forceinline__ void operator()(const f32x4 (&acc)[2][2][4][2], const Unit& u, int wr, int wc, int fr, int fq) const {
        const int row0 = u.pm * BM + wr * 64 + fr, col0 = u.pn * BM + wc * 32 + 8 * fq;
#pragma unroll
        for (int ai = 0; ai < 2; ++ai)
#pragma unroll
            for (int m = 0; m < 4; ++m) {
                const int row = row0 + ai * HALF + m * 16; const size_t off = (size_t)row * 1024 + col0;
                float ss = 0.f;
#pragma unroll
                for (int bj = 0; bj < 2; ++bj) {
                    const f32x4 xa = *(const f32x4*)(x + off + bj * HALF), xb = *(const f32x4*)(x + off + bj * HALF + 4);
                    const f32x4 v0 = acc[ai][bj][m][0] + xa, v1 = acc[ai][bj][m][1] + xb;
                    *(f32x4*)(X1 + off + bj * HALF) = v0; *(f32x4*)(X1 + off + bj * HALF + 4) = v1;
                    *(u32x4*)(X1B + off + bj * HALF) = pack8(v0, v1);
                    ss += (v0[0] * v0[0] + v0[1] * v0[1]) + (v0[2] * v0[2] + v0[3] * v0[3]) + (v1[0] * v1[0] + v1[1] * v1[1]) + (v1[2] * v1[2] + v1[3] * v1[3]);
                }
                ss += __shfl_xor(ss, 16); ss += __shfl_xor(ss, 32);
                if (fq == 0) SS[(size_t)row * 16 + u.pn * 4 + wc] = ss;
                if (m & 1) asm volatile("" ::: "memory");
            }
    }
};

struct EpiP4 {
    static constexpr bool PERM = true, AFTER_DRAIN = false;
    bf16_t* QP; const float* SS;
    __device__ __forceinline__ void operator()(const f32x4 (&acc)[2][2][4][2], const Unit& u, int wr, int wc, int fr, int fq) const {
        const int row0 = u.pm * BM + wr * 64 + fr, col0 = u.pn * BM + wc * 32 + 8 * fq;
#pragma unroll
        for (int ai = 0; ai < 2; ++ai)
#pragma unroll
            for (int m = 0; m < 4; ++m) {
                const int row = row0 + ai * HALF + m * 16;
                const f32x4* sp = (const f32x4*)(SS + (size_t)row * 16);
                const f32x4 s0 = sp[0], s1 = sp[1], s2 = sp[2], s3 = sp[3];
                const float s = ((s0[0] + s0[1]) + (s0[2] + s0[3])) + ((s1[0] + s1[1]) + (s1[2] + s1[3])) + ((s2[0] + s2[1]) + (s2[2] + s2[3])) + ((s3[0] + s3[1]) + (s3[2] + s3[3]));
                const float rstd = __builtin_amdgcn_rsqf(s * (1.0f / 1024.0f) + 1e-6f);
#pragma unroll
                for (int bj = 0; bj < 2; ++bj)
                    *(u32x4*)(QP + (size_t)row * 2048 + col0 + bj * HALF) = pack8(acc[ai][bj][m][0] * rstd, acc[ai][bj][m][1] * rstd);
            }
    }
};
template <class Epi, class Sched, bool ALIGN_EPI = false, bool SP2 = false>
__device__ __forceinline__ void gemm_phase(PG8_LAS unsigned char* lds, const Gemm g, const Sched& S, const Epi& E) {
    const int tid = threadIdx.x, wid = __builtin_amdgcn_readfirstlane(tid >> 6), lane = tid & 63, wr = wid >> 2, wc = wid & 3, fr = lane & 15, fq = lane >> 4;
    const int K = g.K, nt = K / BK;
    unsigned voffA[2], voffB[2];
#pragma unroll
    for (int i = 0; i < 2; ++i) { int R, C; stage_rc(tid * 16 + i * 8192, R, C); const int Rb = Epi::PERM ? ((R & ~31) + perm32(R & 31)) : R;
        voffA[i] = (unsigned)(R * K + C) * 2u; voffB[i] = (unsigned)(Rb * K + C) * 2u; }
    const size_t kstep = (size_t)(BK * 2);
    const size_t hstep = (size_t)HALF * K * 2;
    const size_t tstep = 2 * hstep;
    const unsigned ldsw = (unsigned)wid * 1024u;
    const int aoff = lds_byte(wr * 64 + fr, fq * 8), boff = lds_byte(wc * 32 + fr, fq * 8);
#define PG8_SA(b, h) (((b) * 2 + (h)) * HTB)
#define PG8_SB(b, h) ((4 + (b) * 2 + (h)) * HTB)
#define PG8_STAGE(bufoff, gbase, voff) do { _Pragma("unroll") for (int _i = 0; _i < 2; ++_i) \
        __builtin_amdgcn_global_load_lds((const unsigned*)((const char*)(gbase) + (voff)[_i]), (PG8_LAS unsigned*)(lds + (bufoff) + ldsw + _i * 8192), 16, 0, 0); } while (0)
#define PG8_LDA(dst, b, h) do { _Pragma("unroll") for (int m = 0; m < 4; ++m) _Pragma("unroll") for (int k = 0; k < 2; ++k) dst[m][k] = *(const PG8_LAS bf16x8*)(lds + PG8_SA(b, h) + aoff + m * 2048 + k * 1024); } while (0)
#define PG8_LDB(dst, b, h) do { _Pragma("unroll") for (int n = 0; n < 2; ++n) _Pragma("unroll") for (int k = 0; k < 2; ++k) dst[n][k] = *(const PG8_LAS bf16x8*)(lds + PG8_SB(b, h) + boff + n * 2048 + k * 1024); } while (0)
#define PG8_MMA(ai, bj, At, Bt) do { __builtin_amdgcn_s_setprio(1); _Pragma("unroll") for (int m = 0; m < 4; ++m) _Pragma("unroll") for (int n = 0; n < 2; ++n) _Pragma("unroll") for (int k = 0; k < 2; ++k) \
        acc[ai][bj][m][n] = __builtin_amdgcn_mfma_f32_16x16x32_bf16(Bt[n][k], At[m][k], acc[ai][bj][m][n], 0, 0, 0); __builtin_amdgcn_s_setprio(0); } while (0)
#define PG8_WAIT_V(n) asm volatile("s_waitcnt vmcnt(" #n ")" ::: "memory")
#define PG8_WAIT_L(n) asm volatile("s_waitcnt lgkmcnt(" #n ")" ::: "memory")
#define PG8_BAR __builtin_amdgcn_s_barrier()
#define PG8_SCHED __builtin_amdgcn_sched_barrier(0)
    Unit cur, nxt; int ui = 0;
    if (!S.next(0, cur)) return;
    f32x4 acc[2][2][4][2];
#pragma unroll
    for (int a = 0; a < 2; ++a)
#pragma unroll
        for (int b = 0; b < 2; ++b)
#pragma unroll
            for (int m = 0; m < 4; ++m)
#pragma unroll
                for (int n = 0; n < 2; ++n) acc[a][b][m][n] = (f32x4){0.f, 0.f, 0.f, 0.f};
    bf16x8 At[4][2], B0[2][2], B1[2][2];
    const char* cA = (const char*)g.A + (size_t)cur.pm * tstep; const char* cB = (const char*)g.Bt + (size_t)cur.pn * tstep;
    S.a_ready(cur);
    if constexpr (SP2) {
        PG8_STAGE(PG8_SB(0, 0), cB, voffB); PG8_STAGE(PG8_SB(0, 1), cB + hstep, voffB); PG8_STAGE(PG8_SA(0, 0), cA, voffA); PG8_STAGE(PG8_SA(0, 1), cA + hstep, voffA);
        if (wr == 1) PG8_BAR;
        PG8_WAIT_V(2); PG8_BAR;
        PG8_STAGE(PG8_SB(1, 0), cB + kstep, voffB); PG8_STAGE(PG8_SA(1, 0), cA + kstep, voffA); PG8_STAGE(PG8_SB(1, 1), cB + hstep + kstep, voffB);
        PG8_WAIT_V(6); PG8_BAR;
    } else {
        PG8_STAGE(PG8_SB(0, 0), cB, voffB); PG8_STAGE(PG8_SA(0, 0), cA, voffA); PG8_STAGE(PG8_SB(0, 1), cB + hstep, voffB); PG8_STAGE(PG8_SA(0, 1), cA + hstep, voffA);
        if (wr == 1) PG8_BAR;
        PG8_WAIT_V(4); PG8_BAR;
        PG8_STAGE(PG8_SB(1, 0), cB + kstep, voffB); PG8_STAGE(PG8_SA(1, 0), cA + kstep, voffA); PG8_STAGE(PG8_SB(1, 1), cB + hstep + kstep, voffB);
        PG8_WAIT_V(6); PG8_BAR;
    }
    for (;;) {
        const bool has_next = S.next(ui + 1, nxt);
        const char* nA = has_next ? (const char*)g.A + (size_t)nxt.pm * tstep : cA; const char* nB = has_next ? (const char*)g.Bt + (size_t)nxt.pn * tstep : cB;
        for (int t = 0; t < nt; t += 2) {
            const bool last = (t == nt - 2);
            const char* a1 = cA + (size_t)(t + 1) * kstep;
            const char* a2 = last ? nA : cA + (size_t)(t + 2) * kstep; const char* b2 = last ? nB : cB + (size_t)(t + 2) * kstep;
            const char* a3 = a2 + kstep; const char* b3 = b2 + kstep;
            if (last && has_next) S.a_ready(nxt);
            if constexpr (SP2) {
            PG8_LDB(B0, 0, 0); PG8_LDB(B1, 0, 1); PG8_SCHED; PG8_LDA(At, 0, 0); PG8_STAGE(PG8_SA(1, 1), a1 + hstep, voffA);
            PG8_WAIT_V(8); PG8_WAIT_L(0); PG8_BAR; PG8_MMA(0, 0, At, B0); PG8_MMA(0, 1, At, B1); PG8_BAR; PG8_SCHED;
            PG8_LDA(At, 0, 1); PG8_STAGE(PG8_SB(0, 0), b2, voffB); PG8_STAGE(PG8_SB(0, 1), b2 + hstep, voffB); PG8_STAGE(PG8_SA(0, 0), a2, voffA);
            PG8_WAIT_V(8); PG8_WAIT_L(0); PG8_BAR; PG8_MMA(1, 0, At, B0); PG8_MMA(1, 1, At, B1); PG8_BAR; PG8_SCHED;
            PG8_LDB(B0, 1, 0); PG8_LDB(B1, 1, 1); PG8_SCHED; PG8_LDA(At, 1, 0); PG8_STAGE(PG8_SA(0, 1), a2 + hstep, voffA);
            PG8_WAIT_V(8); PG8_WAIT_L(0); PG8_BAR; PG8_MMA(0, 0, At, B0); PG8_MMA(0, 1, At, B1); PG8_BAR; PG8_SCHED;
            PG8_LDA(At, 1, 1); PG8_STAGE(PG8_SB(1, 0), b3, voffB); PG8_STAGE(PG8_SB(1, 1), b3 + hstep, voffB); PG8_STAGE(PG8_SA(1, 0), a3, voffA);
            PG8_WAIT_V(8); PG8_WAIT_L(0); PG8_BAR; PG8_MMA(1, 0, At, B0); PG8_MMA(1, 1, At, B1); PG8_BAR; PG8_SCHED;
            } else {
            PG8_LDB(B0, 0, 0); PG8_SCHED; PG8_LDA(At, 0, 0); PG8_STAGE(PG8_SA(1, 1), a1 + hstep, voffA);
            PG8_WAIT_L(8); PG8_BAR; PG8_WAIT_L(0); PG8_MMA(0, 0, At, B0); PG8_BAR; PG8_SCHED;
            PG8_LDB(B1, 0, 1); PG8_STAGE(PG8_SB(0, 0), b2, voffB);
            PG8_BAR; PG8_WAIT_L(0); PG8_MMA(0, 1, At, B1); PG8_BAR;
            PG8_LDA(At, 0, 1); PG8_STAGE(PG8_SA(0, 0), a2, voffA);
            PG8_BAR; PG8_WAIT_L(0); PG8_MMA(1, 0, At, B0); PG8_BAR; PG8_SCHED;
            PG8_STAGE(PG8_SB(0, 1), b2 + hstep, voffB);
            PG8_WAIT_V(6); PG8_BAR; PG8_MMA(1, 1, At, B1); PG8_BAR;
            PG8_LDB(B0, 1, 0); PG8_SCHED; PG8_LDA(At, 1, 0); PG8_STAGE(PG8_SA(0, 1), a2 + hstep, voffA);
            PG8_WAIT_L(8); PG8_BAR; PG8_WAIT_L(0); PG8_MMA(0, 0, At, B0); PG8_BAR; PG8_SCHED;
            PG8_LDB(B1, 1, 1); PG8_STAGE(PG8_SB(1, 0), b3, voffB);
            PG8_BAR; PG8_WAIT_L(0); PG8_MMA(0, 1, At, B1); PG8_BAR;
            PG8_LDA(At, 1, 1); PG8_STAGE(PG8_SA(1, 0), a3, voffA);
            PG8_BAR; PG8_WAIT_L(0); PG8_MMA(1, 0, At, B0); PG8_BAR; PG8_SCHED;
            PG8_STAGE(PG8_SB(1, 1), b3 + hstep, voffB);
            PG8_WAIT_V(6); PG8_BAR; PG8_MMA(1, 1, At, B1); PG8_BAR;
            }
        }
        if constexpr (ALIGN_EPI) { if (wr == 0) PG8_BAR; }
        if constexpr (!Epi::AFTER_DRAIN) { E(acc, cur, wr, wc, fr, fq); S.done(cur); }
        if (!has_next) break;
#pragma unroll
        for (int a = 0; a < 2; ++a)
#pragma unroll
            for (int b = 0; b < 2; ++b)
#pragma unroll
                for (int m = 0; m < 4; ++m)
#pragma unroll
                    for (int n = 0; n < 2; ++n) acc[a][b][m][n] = (f32x4){0.f, 0.f, 0.f, 0.f};
        cur = nxt; cA = nA; cB = nB; ++ui;
        if constexpr (ALIGN_EPI) { if (wr == 1) PG8_BAR; }
    }
    PG8_WAIT_V(0);
    if constexpr (!ALIGN_EPI) { if (wr == 0) PG8_BAR; }
    PG8_BAR;
    if constexpr (Epi::AFTER_DRAIN) { E.fused(acc, cur, wr, wc, fr, fq, lds, wid, lane); S.done(cur); }
#undef PG8_SA
#undef PG8_SB
#undef PG8_STAGE
#undef PG8_LDA
#undef PG8_LDB
#undef PG8_MMA
#undef PG8_WAIT_V
#undef PG8_WAIT_L
#undef PG8_BAR
#undef PG8_SCHED
}
}
#ifndef PG8_SP2
#define PG8_SP2 true
#endif
#ifndef PG8_ALIGN
#define PG8_ALIGN true
#endif
#include <hip/hip_bf16.h>
#include <cmath>
namespace attn_body {
using bf16=__hip_bfloat16;
using bf16x8=__attribute__((ext_vector_type(8)))short;
using s16x4=__attribute__((ext_vector_type(4)))short;
using f32x16=__attribute__((ext_vector_type(16)))float;
using u32x4=__attribute__((ext_vector_type(4)))unsigned;
constexpr int BATCH=4,NHEAD=8,SEQ=8192,D=64,QPITCH=512,KVPITCH=128,OPITCH=1024;
constexpr int NW=8,QBLK=32,QB=QBLK*NW,KVBLK=64,NQB=SEQ/QB;
constexpr int ATTN_UNIT_ROWS=QB;
__device__ __forceinline__ int crow(int r,int hi){return (r&3)+8*(r>>2)+4*hi;}
#define SBAR() __builtin_amdgcn_sched_barrier(0)
__device__ __forceinline__ void cmask(f32x16&p0,f32x16&p1,int jb,int qrel,int hi){
  const float NEG=-INFINITY; int kb=64*jb+4*hi;
  #pragma unroll
  for(int r=0;r<16;++r){int kv=kb+(r&3)+8*(r>>2); if(kv>qrel)p0[r]=NEG; if(kv+32>qrel)p1[r]=NEG;}
}

constexpr int NSLOT=3, SLOTB=8192;
constexpr int LDS_K=0, LDS_V=NSLOT*SLOTB, LDS_WS=2*NSLOT*SLOTB, LDS_OST=LDS_WS+NW*64*4, LDS_BYTES=LDS_OST+NW*4096;
constexpr float C2=0.125f*1.4426950408889634f;
__device__ __forceinline__ void glds16(const void*gsrc,unsigned lds_dst){unsigned keep;
  asm volatile("s_mov_b32 %0, m0\n\ts_mov_b32 m0, %2\n\ts_nop 0\n\tglobal_load_lds_dwordx4 %1, off\n\ts_mov_b32 m0, %0":"=&s"(keep):"v"(gsrc),"s"(lds_dst):"memory");}
__device__ __forceinline__ float max3f(float a,float b,float c){float r;asm("v_max3_f32 %0, %1, %2, %3":"=v"(r):"v"(a),"v"(b),"v"(c));return r;}
__device__ __forceinline__ float max2f(float a,float b){float r;asm("v_max_f32_e32 %0, %1, %2":"=v"(r):"v"(a),"v"(b));return r;}
__device__ __forceinline__ float fadd_s(float a,float b){float r;asm("v_add_f32_e32 %0, %1, %2":"=v"(r):"v"(a),"v"(b));return r;}
__device__ __forceinline__ float fsub_s(float a,float b){float r;asm("v_sub_f32_e32 %0, %1, %2":"=v"(r):"v"(a),"v"(b));return r;}
typedef float f32x2_t __attribute__((ext_vector_type(2))); typedef __bf16 bf16x2_t __attribute__((ext_vector_type(2)));
__device__ __forceinline__ unsigned cvtpk_s(float lo,float hi){f32x2_t v={lo,hi};bf16x2_t b=__builtin_convertvector(v,bf16x2_t);return __builtin_bit_cast(unsigned,b);}
#define WAIT_BAR(N) asm volatile("s_waitcnt vmcnt(" #N ") lgkmcnt(0)\n\ts_barrier":::"memory")

__device__ __forceinline__ void qkt(f32x16&p0,f32x16&p1,const char*Kslot,const bf16x8*qr,const f32x16&negm,int r32,int hi){
  const char*kb=Kslot+hi*1024+r32*16;
  #pragma unroll
  for(int d0=0;d0<4;++d0){
    const bf16x8 b0=*reinterpret_cast<const bf16x8*>(kb+d0*2048);
    const bf16x8 b1=*reinterpret_cast<const bf16x8*>(kb+d0*2048+512);
    if(d0==0){p0=__builtin_amdgcn_mfma_f32_32x32x16_bf16(b0,qr[0],negm,0,0,0);p1=__builtin_amdgcn_mfma_f32_32x32x16_bf16(b1,qr[0],negm,0,0,0);}
    else{p0=__builtin_amdgcn_mfma_f32_32x32x16_bf16(b0,qr[d0],p0,0,0,0);p1=__builtin_amdgcn_mfma_f32_32x32x16_bf16(b1,qr[d0],p1,0,0,0);}}
}
typedef __attribute__((address_space(3))) const char* lds_cptr;
typedef short v4i16_t __attribute__((ext_vector_type(4)));
__device__ __forceinline__ void kload8(bf16x8*kf,lds_cptr kp){
  kf[0]=*(const __attribute__((address_space(3))) bf16x8*)(kp);      kf[1]=*(const __attribute__((address_space(3))) bf16x8*)(kp+512);
  kf[2]=*(const __attribute__((address_space(3))) bf16x8*)(kp+2048); kf[3]=*(const __attribute__((address_space(3))) bf16x8*)(kp+2560);
  kf[4]=*(const __attribute__((address_space(3))) bf16x8*)(kp+4096); kf[5]=*(const __attribute__((address_space(3))) bf16x8*)(kp+4608);
  kf[6]=*(const __attribute__((address_space(3))) bf16x8*)(kp+6144); kf[7]=*(const __attribute__((address_space(3))) bf16x8*)(kp+6656);
}
__device__ __forceinline__ void kload2(bf16x8*kf,lds_cptr kp,int j){ kf[2*j]=*(const __attribute__((address_space(3))) bf16x8*)(kp+j*2048); kf[2*j+1]=*(const __attribute__((address_space(3))) bf16x8*)(kp+j*2048+512); }
__device__ __forceinline__ s16x4 vtr(lds_cptr p){ return __builtin_bit_cast(s16x4,__builtin_amdgcn_ds_read_tr16_b64_v4i16((__attribute__((address_space(3))) v4i16_t*)p)); }
__device__ __forceinline__ float rowmax(const f32x16&p0,const f32x16&p1){
  float a=max3f(p0[0],p0[1],p1[0]),b=max3f(p0[2],p0[3],p1[1]);a=max3f(a,p1[2],p1[3]);
  #pragma unroll
  for(int r=4;r<16;r+=4){a=max3f(a,p0[r],p0[r+1]);b=max3f(b,p0[r+2],p0[r+3]);a=max3f(a,p1[r],p1[r+1]);b=max3f(b,p1[r+2],p1[r+3]);}
  const float m=max2f(a,b);
  auto rr=__builtin_amdgcn_permlane32_swap(__float_as_uint(m),__float_as_uint(m),false,false);
  return max2f(__uint_as_float(rr[0]),__uint_as_float(rr[1]));
}
__device__ __forceinline__ void pv(f32x16*o,int vb,bf16x8 pa0,bf16x8 pa1,bf16x8 pa2,bf16x8 pa3){
  #pragma unroll
  for(int d0=0;d0<2;++d0){s16x4 lo[4],hi[4];
    #pragma unroll
    for(int ks=0;ks<4;++ks){
      asm volatile("ds_read_b64_tr_b16 %0,%1 offset:%c2":"=&v"(lo[ks]):"v"(vb),"i"(d0*4096+ks*1024):"memory");
      asm volatile("ds_read_b64_tr_b16 %0,%1 offset:%c2":"=&v"(hi[ks]):"v"(vb),"i"(d0*4096+ks*1024+512):"memory");}
    asm volatile("s_waitcnt lgkmcnt(0)":::"memory");SBAR();
    #define PK(k) (bf16x8){lo[k][0],lo[k][1],lo[k][2],lo[k][3],hi[k][0],hi[k][1],hi[k][2],hi[k][3]}
    o[d0]=__builtin_amdgcn_mfma_f32_32x32x16_bf16(pa0,PK(0),o[d0],0,0,0);
    o[d0]=__builtin_amdgcn_mfma_f32_32x32x16_bf16(pa1,PK(1),o[d0],0,0,0);
    o[d0]=__builtin_amdgcn_mfma_f32_32x32x16_bf16(pa2,PK(2),o[d0],0,0,0);
    o[d0]=__builtin_amdgcn_mfma_f32_32x32x16_bf16(pa3,PK(3),o[d0],0,0,0);
    #undef PK
  }
}

#ifndef ATTN_STORE16
#define ATTN_STORE16(p,v) (*(u32x4*)(p)=(v))
#endif
template<int THRL> __device__ __forceinline__ void attn_unit(int b,int h,int qb,const bf16*Q,const bf16*__restrict__ K,const bf16*__restrict__ V,bf16*O,char*shm){
  const int tid=threadIdx.x,lane=tid&63,r32=lane&31,hi=lane>>5; const int wid=__builtin_amdgcn_readfirstlane(tid>>6);
  const long rowbase=(long)b*SEQ; const int q0=qb*QB;
  const bf16*Qw=Q+(rowbase+q0+wid*QBLK)*QPITCH+h*D;
  const bf16*Kh=K+rowbase*KVPITCH+(h>>2)*D,*Vh=V+rowbase*KVPITCH+(h>>2)*D;
  const unsigned lds0=(unsigned)(uintptr_t)shm;
  float*wsf=(float*)(shm+LDS_WS)+wid*64;
  const bf16*ksrc=Kh+(long)lane*KVPITCH+wid*8;
  const bf16*vsrc=Vh+(long)(16*(wid&3)+(lane>>2))*KVPITCH+(wid>>2)*32+(lane&3)*8;
  const unsigned kdst=lds0+LDS_K+wid*1024, vdst=lds0+LDS_V+wid*1024;
  #define DMA_K(t,slot) glds16(ksrc+(long)(t)*KVBLK*KVPITCH,(unsigned)__builtin_amdgcn_readfirstlane(kdst+(slot)))
  #define DMA_V(t,slot) glds16(vsrc+(long)(t)*KVBLK*KVPITCH,(unsigned)__builtin_amdgcn_readfirstlane(vdst+(slot)))
  const int vb0=(int)(lds0+LDS_V)+((lane>>4)&1)*32+(lane&3)*8+(4*hi+((lane&15)>>2))*64;
  const char*Kbase=shm+LDS_K; bf16x8 kf[8];
  const lds_cptr shm3=(lds_cptr)shm; const lds_cptr kp0=shm3+LDS_K+hi*1024+r32*16; const lds_cptr vp0=shm3+LDS_V+((lane>>4)&1)*32+(lane&3)*8+(4*hi+((lane&15)>>2))*64;
  const int NT=SEQ/KVBLK;
  DMA_K(0,0);DMA_V(0,0);DMA_K(1,SLOTB);
  bf16x8 qr[4];
  #pragma unroll
  for(int d0=0;d0<4;++d0)qr[d0]=*reinterpret_cast<const bf16x8*>(&Qw[(long)r32*QPITCH+d0*16+hi*8]);
  float mhat=0.f,l_reg=0.f;f32x16 o[2];o[0]=f32x16{};o[1]=f32x16{};f32x16 negm=f32x16{};asm volatile("":"+v"(negm));
  const int qrel=wid*QBLK+r32;
  #define CMASK(P0,P1,t) do{}while(0)
  bool resc=false;
  #define START(P0,P1) do{ const float rm=rowmax(P0,P1); resc=false; \
    { const float dl=rm; mhat=fadd_s(mhat,dl); \
      _Pragma("unroll") for(int r=0;r<16;++r){P0[r]=fsub_s(P0[r],dl);P1[r]=fsub_s(P1[r],dl);} \
      _Pragma("unroll") for(int r=0;r<16;++r)negm[r]=-mhat; asm volatile("":"+v"(negm)); } \
    _Pragma("unroll") for(int r=0;r<16;++r)P0[r]=__builtin_amdgcn_exp2f(P0[r]); }while(0)
  #define RESC() do{ if(resc){ asm volatile("s_waitcnt lgkmcnt(0)":::"memory"); \
      _Pragma("unroll") for(int d_=0;d_<2;++d_) _Pragma("unroll") for(int r=0;r<16;++r)o[d_][r]*=wsf[crow(r,hi)]; } }while(0)
  f32x16 pA0,pA1,pB0,pB1;
  int sl_prev=0,sl_cur=0,sl_next=SLOTB;
  #define ROT() do{sl_prev=sl_cur;sl_cur=sl_next;sl_next=(sl_next==(NSLOT-1)*SLOTB)?0:sl_next+SLOTB;}while(0)
  DMA_K(2,2*SLOTB);
  WAIT_BAR(3);
  qkt(pA0,pA1,Kbase,qr,negm,r32,hi);asm volatile("s_nop 15\n\ts_nop 7":"+v"(pA0),"+v"(pA1));CMASK(pA0,pA1,0);
  START(pA0,pA1);
  _Pragma("unroll") for(int r=0;r<16;++r)pA1[r]=__builtin_amdgcn_exp2f(pA1[r]);
  WAIT_BAR(0);
  DMA_K(3,0);DMA_V(1,SLOTB);
  ROT();
  kload8(kf,kp0+sl_cur);
  WAIT_BAR(2);
  s16x4 vlo[8],vhi[8]; u32x4 pw0,pw1,pw2,pw3;
  #define PKW(P,B) cvtpk_s(P[B],P[B+1])
  #define PAF(k) __builtin_bit_cast(bf16x8,pw##k)
  #define VFR(i) (bf16x8){vlo[i][0],vlo[i][1],vlo[i][2],vlo[i][3],vhi[i][0],vhi[i][1],vhi[i][2],vhi[i][3]}
  #define PIN(x) asm volatile("":"+v"(x))
  #define MX3(a,b,c) __builtin_fmaxf(__builtin_fmaxf((a),(b)),(c))
  #define GAPA(MF,A0,A1,A2,A3,W0,W1,PW) do{ MF; sacc+=A0; sacc+=A1; sacc+=A2; sacc+=A3; PIN(sacc); W0; W1; PIN(PW); SBAR(); }while(0)
  #define EX(v) __builtin_amdgcn_exp2f(v)
  #define GAPB(MF,X,B) do{ MF; X[B]=EX(X[B]); X[B+1]=EX(X[B+1]); X[B+2]=EX(X[B+2]); X[B+3]=EX(X[B+3]); PIN(X); SBAR(); }while(0)
  #define VRD(i) do{ vlo[i]=vtr(vp_+(((i)>>2)*4096+((i)&3)*1024)); vhi[i]=vtr(vp_+(((i)>>2)*4096+((i)&3)*1024+512)); }while(0)
  #define KRD(G,j) do{ if(G){ kload2(kf,kp0+sl_next,j); SBAR(); } }while(0)
  #define STEP(C0,C1,P0,P1,t,GK,GV,GL) do{ SBAR(); \
    const lds_cptr vp_=vp0+sl_prev; \
    VRD(0); SBAR(); float sacc=(P0[0]+P0[1]); \
    GAPA(C0=__builtin_amdgcn_mfma_f32_32x32x16_bf16(kf[0],qr[0],negm,0,0,0), P0[2],P0[3],P0[4],P0[5],     pw0[0]=PKW(P0,0), pw0[1]=PKW(P0,2), pw0); \
    VRD(4); SBAR(); GAPA(C1=__builtin_amdgcn_mfma_f32_32x32x16_bf16(kf[1],qr[0],negm,0,0,0), P0[6],P0[7],P0[8],P0[9],     pw0[2]=PKW(P0,4), pw0[3]=PKW(P0,6), pw0); \
    VRD(1); SBAR(); GAPA(C0=__builtin_amdgcn_mfma_f32_32x32x16_bf16(kf[2],qr[1],C0,0,0,0),   P0[10],P0[11],P0[12],P0[13], pw1[0]=PKW(P0,8), pw1[1]=PKW(P0,10), pw1); \
    VRD(5); SBAR(); GAPA(C1=__builtin_amdgcn_mfma_f32_32x32x16_bf16(kf[3],qr[1],C1,0,0,0),   P0[14],P0[15],P1[0],P1[1],   pw1[2]=PKW(P0,12),pw1[3]=PKW(P0,14), pw1); \
    VRD(2); SBAR(); GAPA(C0=__builtin_amdgcn_mfma_f32_32x32x16_bf16(kf[4],qr[2],C0,0,0,0),   P1[2],P1[3],P1[4],P1[5],     pw2[0]=PKW(P1,0), pw2[1]=PKW(P1,2), pw2); \
    VRD(6); SBAR(); GAPA(C1=__builtin_amdgcn_mfma_f32_32x32x16_bf16(kf[5],qr[2],C1,0,0,0),   P1[6],P1[7],P1[8],P1[9],     pw2[2]=PKW(P1,4), pw2[3]=PKW(P1,6), pw2); \
    VRD(3); SBAR(); GAPA(C0=__builtin_amdgcn_mfma_f32_32x32x16_bf16(kf[6],qr[3],C0,0,0,0),   P1[10],P1[11],P1[12],P1[13], pw3[0]=PKW(P1,8), pw3[1]=PKW(P1,10), pw3); \
    VRD(7); SBAR(); GAPA(C1=__builtin_amdgcn_mfma_f32_32x32x16_bf16(kf[7],qr[3],C1,0,0,0),   P1[14],P1[15],0.f,0.f,       pw3[2]=PKW(P1,12),pw3[3]=PKW(P1,14), pw3); \
    l_reg+=sacc; \
    if(GK){DMA_K((t)+3,sl_cur);} if(GV){DMA_V((t)+1,sl_next);} \
    CMASK(C0,C1,t); \
    { float a=MX3(C0[0],C0[1],C1[0]),b=MX3(C0[2],C0[3],C1[1]); a=MX3(a,C1[2],C1[3]); \
      _Pragma("unroll") for(int r=4;r<16;r+=4){a=MX3(a,C0[r],C0[r+1]);b=MX3(b,C0[r+2],C0[r+3]);a=MX3(a,C1[r],C1[r+1]);b=MX3(b,C1[r+2],C1[r+3]);} \
      float rm=__builtin_fmaxf(a,b); { auto rr=__builtin_amdgcn_permlane32_swap(__float_as_uint(rm),__float_as_uint(rm),false,false); rm=__builtin_fmaxf(__uint_as_float(rr[0]),__uint_as_float(rr[1])); } \
      resc=false; \
      if(__builtin_expect(__any(rm>(float)THRL),0)){ const float dl=__builtin_fmaxf(rm,0.f); mhat+=dl; \
        _Pragma("unroll") for(int r=0;r<16;++r){C0[r]-=dl;C1[r]-=dl;} \
        _Pragma("unroll") for(int r=0;r<16;++r)negm[r]=-mhat; asm volatile("":"+v"(negm)); \
        const float f=__builtin_amdgcn_exp2f(-dl); l_reg*=f; if(hi==0)wsf[r32]=f; resc=true; } } \
    SBAR(); \
    GAPB(o[0]=__builtin_amdgcn_mfma_f32_32x32x16_bf16(PAF(0),VFR(0),o[0],0,0,0), C0,0); \
    GAPB(o[1]=__builtin_amdgcn_mfma_f32_32x32x16_bf16(PAF(0),VFR(4),o[1],0,0,0), C0,4); \
    KRD(GL,0); GAPB(o[0]=__builtin_amdgcn_mfma_f32_32x32x16_bf16(PAF(1),VFR(1),o[0],0,0,0), C0,8); \
    KRD(GL,1); GAPB(o[1]=__builtin_amdgcn_mfma_f32_32x32x16_bf16(PAF(1),VFR(5),o[1],0,0,0), C0,12); \
    KRD(GL,2); GAPB(o[0]=__builtin_amdgcn_mfma_f32_32x32x16_bf16(PAF(2),VFR(2),o[0],0,0,0), C1,0); \
    KRD(GL,3); GAPB(o[1]=__builtin_amdgcn_mfma_f32_32x32x16_bf16(PAF(2),VFR(6),o[1],0,0,0), C1,4); \
    GAPB(o[0]=__builtin_amdgcn_mfma_f32_32x32x16_bf16(PAF(3),VFR(3),o[0],0,0,0), C1,8); \
    GAPB(o[1]=__builtin_amdgcn_mfma_f32_32x32x16_bf16(PAF(3),VFR(7),o[1],0,0,0), C1,12); \
    }while(0)
  int t=1;
  #undef CMASK
  #define CMASK(P0,P1,t) do{}while(0)
  for(;t+5<NT;t+=2){
    STEP(pB0,pB1,pA0,pA1,t,true,true,true);     WAIT_BAR(2); RESC(); ROT();
    STEP(pA0,pA1,pB0,pB1,t+1,true,true,true);   WAIT_BAR(2); RESC(); ROT();
  }
  #undef CMASK
  #define CMASK(P0,P1,t) do{}while(0)
  #define ENDW(tt) do{ if((tt)+3<NT){WAIT_BAR(2);} else if((tt)+2<NT){WAIT_BAR(1);} else {WAIT_BAR(0);} }while(0)
  for(;t+1<NT;t+=2){
    STEP(pB0,pB1,pA0,pA1,t,(t+3<NT),(t+1<NT),(t+1<NT));       ENDW(t);   RESC(); ROT();
    STEP(pA0,pA1,pB0,pB1,t+1,(t+4<NT),(t+2<NT),(t+2<NT));     ENDW(t+1); RESC(); ROT();
  }
  STEP(pB0,pB1,pA0,pA1,NT-1,false,false,false); RESC();
  { float sacc=pB0[0]+pB0[1]; _Pragma("unroll") for(int r=2;r<16;++r)sacc+=pB0[r]; _Pragma("unroll") for(int r=0;r<16;++r)sacc+=pB1[r]; l_reg+=sacc;
    pw0=(u32x4){PKW(pB0,0),PKW(pB0,2),PKW(pB0,4),PKW(pB0,6)};pw1=(u32x4){PKW(pB0,8),PKW(pB0,10),PKW(pB0,12),PKW(pB0,14)};pw2=(u32x4){PKW(pB1,0),PKW(pB1,2),PKW(pB1,4),PKW(pB1,6)};pw3=(u32x4){PKW(pB1,8),PKW(pB1,10),PKW(pB1,12),PKW(pB1,14)};
    SBAR(); pv(o,vb0+sl_cur,PAF(0),PAF(1),PAF(2),PAF(3)); }
  #undef PKW
  #undef PAF
  #undef VFR
  #undef PIN
  #undef MX3
  #undef GAPA
  #undef GAPB
  #undef EX
  #undef VRD
  #undef KRD
  #undef STEP
  #undef ENDW
  {auto rr=__builtin_amdgcn_permlane32_swap(__float_as_uint(l_reg),__float_as_uint(l_reg),false,false);l_reg=__uint_as_float(rr[0])+__uint_as_float(rr[1]);}
  if(hi==0)wsf[32+r32]=l_reg;asm volatile("s_waitcnt lgkmcnt(0)":::"memory");
  float rli[16];
  #pragma unroll
  for(int r=0;r<16;++r)rli[r]=__builtin_amdgcn_rcpf(wsf[32+crow(r,hi)]);
  bf16*Ow=O+(rowbase+q0+wid*QBLK)*OPITCH+h*D;
  { bf16*stg=(bf16*)(shm+LDS_OST)+wid*2048;
    #pragma unroll
    for(int r=0;r<16;++r){const int orow=crow(r,hi);
      #pragma unroll
      for(int d0=0;d0<2;++d0)stg[orow*64+d0*32+r32]=__float2bfloat16(o[d0][r]*rli[r]);}
    asm volatile("s_waitcnt lgkmcnt(0)":::"memory");
    #pragma unroll
    for(int i=0;i<4;++i){const int row=i*8+(lane>>3),ch=lane&7; const u32x4 v=*(const u32x4*)(stg+row*64+ch*8); ATTN_STORE16(Ow+(long)row*OPITCH+ch*8,v);} }
  asm volatile("s_waitcnt lgkmcnt(0)\n\ts_barrier":::"memory");
  #undef DMA_K
  #undef DMA_V
  #undef CMASK
  #undef START
  #undef RESC
  #undef ROT
}
constexpr int ATTN_LDS_BYTES=LDS_BYTES;
struct AttnTensors { const bf16* Q; const bf16* K; const bf16* V; bf16* O; };
struct AttnUnit { int bh; int qb; };
struct StaticOrder {
  int vcu;
  __device__ __forceinline__ explicit StaticOrder(int grid,int block):vcu((block%8)*(grid/8)+block/8){}
  __device__ __forceinline__ bool next(int i,AttnUnit&u)const{ if(i>=4)return false; const int s=vcu&7; u.bh=vcu>>3; u.qb=(i==0)?s:(i==1)?15-s:(i==2)?16+s:31-s; return true; }
  __device__ __forceinline__ void a_ready(const AttnUnit&)const{}
  __device__ __forceinline__ void done(const AttnUnit&)const{}
};
template<class Sched,int THRL=8> __device__ __forceinline__ void attn_phase(char*lds,const AttnTensors&T,const Sched&S){
  AttnUnit u;
  for(int i=0;S.next(i,u);++i){ S.a_ready(u); attn_unit<THRL>(u.bh/NHEAD,u.bh%NHEAD,u.qb,T.Q,T.K,T.V,T.O,lds); S.done(u); }
}
#undef SBAR
#undef WAIT_BAR
}

constexpr int NWAVES = 8;
#ifndef MK_N_LAUNCHES
#define MK_N_LAUNCHES 1
#endif
constexpr int N_LAUNCHES = MK_N_LAUNCHES;
constexpr int PER_PHASE = 7;

constexpr int BATCH = 4, T = 8192, D = 1024;
constexpr int M = BATCH * T;
constexpr int NIN = 1792;
constexpr int NPQ = 2048;
constexpr int NEXP = 16384;
constexpr float RMS_EPS = 1e-6f;

constexpr size_t MiB = 1u << 20;
constexpr size_t WS_CTL = 0, CTL_ZERO_BYTES = 1 * MiB;
constexpr size_t WS_WIN = 2 * MiB, WS_WOUT = 6 * MiB, WS_WQ = 8 * MiB;
constexpr size_t WS_KEYS = 12 * MiB, WS_ROPE = 13 * MiB, WS_SS = 14 * MiB;
constexpr size_t WS_UT = 16 * MiB, WS_VT = 48 * MiB;
constexpr size_t WS_XN = 80 * MiB;
constexpr size_t WS_Q = 144 * MiB, WS_K = 176 * MiB, WS_V = 184 * MiB, WS_H = 192 * MiB;
constexpr size_t WS_MIX = 224 * MiB;
constexpr size_t WS_QP = 288 * MiB;
constexpr size_t WS_IDX = 416 * MiB, WS_GATE = 424 * MiB, WS_END = 440 * MiB;
constexpr int CW_TMO = 0, CW_CODE = 1;
constexpr int CW_BAR = 4096;
constexpr int RING_OFF = 0, RING_BYTES = 131072;
constexpr int LDSCTL_OFF = RING_BYTES, MISC_OFF = LDSCTL_OFF + 320;
constexpr int LDS_BYTES = 147456;
static_assert(MISC_OFF + 128 <= LDS_BYTES, "LDS map");
#define GAS __attribute__((address_space(1)))
#define LAS __attribute__((address_space(3)))
typedef unsigned short bf16;
typedef unsigned v4u __attribute__((ext_vector_type(4)));
typedef float f32x4 __attribute__((ext_vector_type(4)));
typedef short bf16x8 __attribute__((ext_vector_type(8)));
typedef GAS unsigned gu32;
typedef GAS unsigned long long gu64;
#define RLX_AGENT __ATOMIC_RELAXED, __HIP_MEMORY_SCOPE_AGENT
#define LDS_WAIT() asm volatile("s_waitcnt lgkmcnt(0)" ::: "memory")
#define VM_WAIT() asm volatile("s_waitcnt vmcnt(0)" ::: "memory")
__device__ __forceinline__ unsigned long long rt() { return __builtin_amdgcn_s_memrealtime(); }
__device__ __forceinline__ unsigned f2bf(float f) { unsigned u = __builtin_bit_cast(unsigned, f); return (u + 0x7fffu + ((u >> 16) & 1u)) >> 16; }
__device__ __forceinline__ unsigned pk2(float lo, float hi) { return f2bf(lo) | (f2bf(hi) << 16); }

#define XB_TMO      128
#define XB_XCNT(j)  (256  + 64 * (j))
#define XB_XSUB(j)  (1280 + 64 * (j))
#define XB_XGEN(j)  (2304 + 64 * (j))
#define XB_TOP      3328
#define XB_TOPGEN   3392
#define XCD_BAR_WORDS 3456
#define XB_SPIN_CAP (1u << 18)

__device__ __forceinline__ unsigned xb_ld(unsigned* p)              { return __hip_atomic_load(p, __ATOMIC_RELAXED, __HIP_MEMORY_SCOPE_AGENT); }
__device__ __forceinline__ unsigned xb_add(unsigned* p, unsigned v) { return __hip_atomic_fetch_add(p, v, __ATOMIC_RELAXED, __HIP_MEMORY_SCOPE_AGENT); }
__device__ __forceinline__ unsigned xb_xcc_id() { return (unsigned)__builtin_amdgcn_s_getreg((3 << 11) | 20) & 0xFu; }
#define XB_SPIN(cond, bar) do { unsigned _sp = 0; while (cond) { __builtin_amdgcn_s_sleep(1); \
    if ((++_sp & 255u) == 0u) { if (xb_ld(&(bar)[XB_TMO])) break; if (_sp > XB_SPIN_CAP) { atomicAdd(&(bar)[XB_TMO], 1u); break; } } } } while (0)

struct XcdBarrier {
    unsigned* bar; unsigned x;
    volatile LAS unsigned* st;
};

__device__ __forceinline__ XcdBarrier xcd_barrier_post(unsigned* bar, volatile LAS unsigned* st) {
    XcdBarrier b; b.bar = bar; b.x = xb_xcc_id(); b.st = st;
    if (threadIdx.x == 0) (void)xb_add(&bar[XB_XCNT(b.x)], 1u);
    return b;
}
__device__ __forceinline__ void xcd_barrier_complete(unsigned* bar, unsigned x, unsigned& nloc, unsigned& nx) {
    const unsigned G = gridDim.x * gridDim.y * gridDim.z;
    unsigned sum, cnt, mine, sp = 0u;
    for (;;) {
        sum = 0u; cnt = 0u; mine = 0u;
#pragma unroll
        for (unsigned j = 0; j < 16; ++j) { const unsigned c = xb_ld(&bar[XB_XCNT(j)]); sum += c; cnt += (c > 0u) ? 1u : 0u; mine = (j == x) ? c : mine; }
        if (sum == G) break;
        __builtin_amdgcn_s_sleep(1);
        if ((++sp & 255u) == 0u) { if (xb_ld(&bar[XB_TMO])) break; if (sp > XB_SPIN_CAP) { atomicAdd(&bar[XB_TMO], 1u); break; } }
    }
    nloc = mine > 0u ? mine : 1u; nx = cnt > 0u ? cnt : 1u;
}

__device__ __forceinline__ void xcd_barrier(const XcdBarrier& b) {
    asm volatile("s_waitcnt vmcnt(0)" ::: "memory");
    __syncthreads();
    if (threadIdx.x == 0) {
        unsigned* bar = b.bar;
        __builtin_amdgcn_s_waitcnt(0);
        unsigned nloc = b.st[0], nx = b.st[1];
        if (nloc == 0u) { xcd_barrier_complete(bar, b.x, nloc, nx); b.st[0] = nloc; b.st[1] = nx; }
        const unsigned old = xb_add(&bar[XB_XSUB(b.x)], 1u);
        const unsigned gen = old / nloc;
        if (old + 1u == (gen + 1u) * nloc) {
            __builtin_amdgcn_fence(__ATOMIC_RELEASE, "agent");
            asm volatile("s_waitcnt vmcnt(0)" ::: "memory");
            const unsigned og = xb_add(&bar[XB_TOP], 1u);
            const unsigned tg = og / nx;
            if (og + 1u == (tg + 1u) * nx) xb_add(&bar[XB_TOPGEN], 1u);
            else XB_SPIN(xb_ld(&bar[XB_TOPGEN]) == tg, bar);
            __builtin_amdgcn_fence(__ATOMIC_ACQUIRE, "agent");
            xb_add(&bar[XB_XGEN(b.x)], 1u);
            asm volatile("s_waitcnt vmcnt(0)" ::: "memory");
        } else {
            XB_SPIN(xb_ld(&bar[XB_XGEN(b.x)]) == gen, bar);
            __builtin_amdgcn_fence(__ATOMIC_ACQUIRE, "agent");
            asm volatile("s_waitcnt vmcnt(0)" ::: "memory");
        }
    }
    __syncthreads();
}

struct Frame {
    LAS unsigned char* lds;
    volatile LAS unsigned* MISC;
    gu32* ctl;
    int tid, lane, wave;
    int vcu, G;
    const float* in[16]; float* out; unsigned char* ws;
};

__device__ __forceinline__ float wave_sum(float v) {
#pragma unroll
    for (int o = 1; o < 64; o <<= 1) v += __shfl_xor(v, o);
    return v;
}
__device__ __forceinline__ int win_src_col(int rho) {
    const int pn = rho >> 8, bj = (rho >> 7) & 1, wc = (rho >> 5) & 3, fq = (rho >> 3) & 3, n = (rho >> 2) & 1, e = rho & 3;
    if (pn < 2) return 64 * (4 * pn + wc) + 32 * bj + 16 * n + 4 * fq + e;
    if (pn == 2) { if (wc < 2) return 512 + 64 * wc + 32 * bj + 16 * n + 4 * fq + e; return 640 + 64 * (wc - 2) + 32 * bj + 8 * fq + 4 * n + e; }
    const int c = 128 * (pn - 3) + 32 * wc + 8 * fq + 4 * n + e;
    return (bj ? 1280 : 768) + c;
}
template <bool PERMW>
__device__ __forceinline__ void p0_transpose_item(const float* W, int K, int N, const float* ks, bf16* WT, LAS float* scr, int item, int lane) {
    const int nblk = N / 32, kb = item / nblk, nb = item % nblk, k0 = 64 * kb, n0 = 32 * nb;
    const int sc = PERMW ? win_src_col(n0 + (lane & 31)) : (n0 + (lane & 31));
#pragma unroll 8
    for (int i = 0; i < 32; ++i) { const int kk = 2 * i + (lane >> 5); float v = W[(size_t)(k0 + kk) * N + sc]; if (ks) v *= ks[k0 + kk]; scr[kk * 33 + (lane & 31)] = v; }
    LDS_WAIT(); asm volatile("" ::: "memory");
    const int c = lane & 7;
#pragma unroll
    for (int j = 0; j < 4; ++j) { const int n = (lane >> 3) + 8 * j; const LAS float* s = scr + (8 * c) * 33 + n;
        v4u o; o.x = pk2(s[0 * 33], s[1 * 33]); o.y = pk2(s[2 * 33], s[3 * 33]); o.z = pk2(s[4 * 33], s[5 * 33]); o.w = pk2(s[6 * 33], s[7 * 33]);
        *(GAS v4u*)(WT + (size_t)(n0 + n) * K + k0 + 8 * c) = o; }
    LDS_WAIT(); asm volatile("" ::: "memory");
}
__device__ __forceinline__ void rms_row_to_bf16(int lane, const float* xrow, const float* g, bf16* orow) {
    const GAS f32x4* xr = (const GAS f32x4*)xrow + lane; const GAS f32x4* gr = (const GAS f32x4*)g + lane;
    f32x4 v[4]; float s = 0.f;
#pragma unroll
    for (int j = 0; j < 4; ++j) { v[j] = xr[64 * j]; s += (v[j].x * v[j].x + v[j].y * v[j].y) + (v[j].z * v[j].z + v[j].w * v[j].w); }
    const float rstd = 1.f / sqrtf(wave_sum(s) * (1.f / D) + RMS_EPS);
    GAS unsigned long long* o8 = (GAS unsigned long long*)orow + lane;
#pragma unroll
    for (int j = 0; j < 4; ++j) { const f32x4 gg = gr[64 * j];
        o8[64 * j] = (unsigned long long)pk2(v[j].x * rstd * gg.x, v[j].y * rstd * gg.y) | ((unsigned long long)pk2(v[j].z * rstd * gg.z, v[j].w * rstd * gg.w) << 32); }
}
__device__ __forceinline__ void p0_prologue(Frame& F) {
    LAS float* scr = (LAS float*)(F.lds + RING_OFF + F.wave * 16384);
    const int gw = F.vcu * NWAVES + F.wave, NGW = F.G * NWAVES;
    const float* w_in = F.in[2]; const float* w_out = F.in[9]; const float* peer_wq = F.in[11]; const float* norm2_g = F.in[10];
    constexpr int I_IN = (D / 64) * (NIN / 32), I_OUT = (D / 64) * (D / 32), I_WQ = (D / 64) * (NPQ / 32);
    constexpr int NITEMS = I_IN + I_OUT + I_WQ;
    for (int it = gw; it < NITEMS; it += NGW) {
        int r = it;
        if (r < I_IN) { p0_transpose_item<true>(w_in, D, NIN, nullptr, (bf16*)(F.ws + WS_WIN), scr, r, F.lane); continue; } r -= I_IN;
        if (r < I_OUT) { p0_transpose_item<false>(w_out, D, D, nullptr, (bf16*)(F.ws + WS_WOUT), scr, r, F.lane); continue; } r -= I_OUT;
        p0_transpose_item<false>(peer_wq, D, NPQ, norm2_g, (bf16*)(F.ws + WS_WQ), scr, r, F.lane);
    }
    const int gt = F.vcu * (NWAVES * 64) + F.tid, NGT = F.G * NWAVES * 64;
    { const float* pk = F.in[12]; bf16* kb = (bf16*)(F.ws + WS_KEYS);
      for (int i = gt; i < 2 * 128 * 128 / 2; i += NGT) { const float a = pk[2 * i], b = pk[2 * i + 1]; ((GAS unsigned*)kb)[i] = pk2(a, b); } }
    { float* rt_ = (float*)(F.ws + WS_ROPE);
      for (int i = gt; i < 128 * 16; i += NGT) { const int pos = i >> 4, k = i & 15; const float inv = powf(10000.0f, -(float)k / 16.0f); const float ang = (float)pos * inv; float s, c; sincosf(ang, &s, &c); rt_[2 * i] = c; rt_[2 * i + 1] = s; } }
    { const float* pu = F.in[13]; const float* pv = F.in[14]; bf16* ut = (bf16*)(F.ws + WS_UT); bf16* vt = (bf16*)(F.ws + WS_VT);
      for (size_t i = gt; i < (size_t)NEXP * D / 8; i += NGT) {
          const int d0 = (int)((i * 8) & (D - 1));
          const f32x4 g0 = *(const GAS f32x4*)(norm2_g + d0), g1 = *(const GAS f32x4*)(norm2_g + d0 + 4);
          const f32x4 a0 = *(const GAS f32x4*)(pu + i * 8), a1 = *(const GAS f32x4*)(pu + i * 8 + 4);
          const f32x4 b0 = *(const GAS f32x4*)(pv + i * 8), b1 = *(const GAS f32x4*)(pv + i * 8 + 4);
          v4u o; o.x = pk2(a0.x * g0.x, a0.y * g0.y); o.y = pk2(a0.z * g0.z, a0.w * g0.w); o.z = pk2(a1.x * g1.x, a1.y * g1.y); o.w = pk2(a1.z * g1.z, a1.w * g1.w);
          *(GAS v4u*)(ut + i * 8) = o;
          v4u p; p.x = pk2(b0.x, b0.y); p.y = pk2(b0.z, b0.w); p.z = pk2(b1.x, b1.y); p.w = pk2(b1.z, b1.w);
          *(GAS v4u*)(vt + i * 8) = p; } }
    for (int m = gw; m < M; m += NGW) rms_row_to_bf16(F.lane, F.in[0] + (size_t)m * D, F.in[1], (bf16*)(F.ws + WS_XN) + (size_t)m * D);
}

__device__ __forceinline__ void conv_phase(Frame& F) {
    const bf16* H = (const bf16*)(F.ws + WS_H); bf16* MIX = (bf16*)(F.ws + WS_MIX);
    const float* cw = F.in[5]; const float* cb = F.in[6]; const float* lg = F.in[7]; const float* lb = F.in[8];
    LAS unsigned short* hs = (LAS unsigned short*)(F.lds + RING_OFF);
    LAS float* co = (LAS float*)(F.lds + RING_OFF + 63488);
    const int c = F.tid;
    float w[31];
#pragma unroll
    for (int j = 0; j < 31; ++j) w[j] = cw[j * 512 + c];
    const float bias = cb[c];
    constexpr int NT_ = M / 32;
    for (int tile = F.vcu; tile < NT_; tile += F.G) {
        const int t0 = tile * 32; const int tb = t0 & ~(T - 1);
        for (int i = F.tid; i < 62 * 64; i += NWAVES * 64) { const int r = i >> 6, ch = i & 63; const int tk = t0 - 15 + r;
            v4u v = (v4u){0u, 0u, 0u, 0u}; if (tk >= tb && tk < tb + T) v = *(const GAS v4u*)(H + (size_t)tk * 512 + ch * 8);
            *(LAS v4u*)(hs + r * 512 + ch * 8) = v; }
        __syncthreads();
#pragma unroll 1
        for (int g = 0; g < 4; ++g) {
            float hv[38];
#pragma unroll
            for (int r = 0; r < 38; ++r) hv[r] = __uint_as_float((unsigned)hs[(g * 8 + r) * 512 + c] << 16);
#pragma unroll
            for (int tt = 0; tt < 8; ++tt) { float a = bias;
#pragma unroll
                for (int j = 0; j < 31; ++j) a += w[j] * hv[tt + j];
                co[(g * 8 + tt) * 512 + c] = a; }
        }
        __syncthreads();
#pragma unroll 1
        for (int q = 0; q < 4; ++q) { const int tt = F.wave * 4 + q;
            const f32x4 a = *(const LAS f32x4*)(co + tt * 512 + 8 * F.lane), b = *(const LAS f32x4*)(co + tt * 512 + 8 * F.lane + 4);
            const float mean = wave_sum((a.x + a.y) + (a.z + a.w) + (b.x + b.y) + (b.z + b.w)) * (1.f / 512.f);
            const f32x4 da = a - mean, db = b - mean;
            const float var = wave_sum((da.x * da.x + da.y * da.y) + (da.z * da.z + da.w * da.w) + (db.x * db.x + db.y * db.y) + (db.z * db.z + db.w * db.w)) * (1.f / 512.f);
            const float rstd = 1.f / sqrtf(var + RMS_EPS);
            const f32x4 g0 = *(const GAS f32x4*)(lg + 8 * F.lane), g1 = *(const GAS f32x4*)(lg + 8 * F.lane + 4), b0 = *(const GAS f32x4*)(lb + 8 * F.lane), b1 = *(const GAS f32x4*)(lb + 8 * F.lane + 4);
            f32x4 y0 = da * rstd * g0 + b0, y1 = db * rstd * g1 + b1;
#pragma unroll
            for (int e = 0; e < 4; ++e) { y0[e] = y0[e] * __builtin_amdgcn_rcpf(1.f + __builtin_amdgcn_exp2f(-1.4426950408889634f * y0[e])); y1[e] = y1[e] * __builtin_amdgcn_rcpf(1.f + __builtin_amdgcn_exp2f(-1.4426950408889634f * y1[e])); }
            v4u o; o.x = pk2(y0.x, y0.y); o.y = pk2(y0.z, y0.w); o.z = pk2(y1.x, y1.y); o.w = pk2(y1.z, y1.w);
            *(GAS v4u*)(MIX + (size_t)(t0 + tt) * 1024 + 512 + 8 * F.lane) = o; }
        __syncthreads();
    }
}

__device__ __forceinline__ unsigned f2sort(float x) { const unsigned u = __float_as_uint(x); return (u & 0x80000000u) ? ~u : (u | 0x80000000u); }
__device__ __forceinline__ float sort2f(unsigned s) { const unsigned u = (s & 0x80000000u) ? (s & 0x7fffffffu) : ~s; return __uint_as_float(u); }
template <bool DESC> __device__ __forceinline__ void ce(unsigned& a, unsigned& b) { const unsigned hi = a > b ? a : b, lo = a > b ? b : a; if (DESC) { a = hi; b = lo; } else { a = lo; b = hi; } }
template <int K, int J, bool DESC> __device__ __forceinline__ void bst(unsigned (&a)[16]) {
#pragma unroll
    for (int i = 0; i < 16; ++i) { const int l = i ^ J; if (l > i) { if (((i & K) == 0) == DESC) ce<true>(a[i], a[l]); else ce<false>(a[i], a[l]); } }
}
template <bool DESC> __device__ __forceinline__ void sort16(unsigned (&a)[16]) { bst<2, 1, DESC>(a); bst<4, 2, DESC>(a); bst<4, 1, DESC>(a); bst<8, 4, DESC>(a); bst<8, 2, DESC>(a); bst<8, 1, DESC>(a); bst<16, 8, DESC>(a); bst<16, 4, DESC>(a); bst<16, 2, DESC>(a); bst<16, 1, DESC>(a); }
template <bool DESC> __device__ __forceinline__ void merge16(unsigned (&a)[16]) { bst<16, 8, DESC>(a); bst<16, 4, DESC>(a); bst<16, 2, DESC>(a); bst<16, 1, DESC>(a); }
__device__ __forceinline__ void max16(unsigned (&a)[16], const unsigned (&b)[16]) {
#pragma unroll
    for (int i = 0; i < 16; ++i) a[i] = a[i] > b[i] ? a[i] : b[i];
}
__device__ __forceinline__ void top16_of_128(unsigned (&g)[8][16]) {
    sort16<true>(g[0]); sort16<false>(g[1]); sort16<true>(g[2]); sort16<false>(g[3]); sort16<true>(g[4]); sort16<false>(g[5]); sort16<true>(g[6]); sort16<false>(g[7]);
    max16(g[0], g[1]); merge16<true>(g[0]); max16(g[2], g[3]); merge16<false>(g[2]); max16(g[4], g[5]); merge16<true>(g[4]); max16(g[6], g[7]); merge16<false>(g[6]);
    max16(g[0], g[2]); merge16<true>(g[0]); max16(g[4], g[6]); merge16<false>(g[4]);
    max16(g[0], g[4]); merge16<true>(g[0]);
}
__device__ __forceinline__ void top16_of_64(unsigned (&g)[4][16]) {
    sort16<true>(g[0]); sort16<false>(g[1]); sort16<true>(g[2]); sort16<false>(g[3]);
    max16(g[0], g[1]); merge16<true>(g[0]); max16(g[2], g[3]); merge16<false>(g[2]);
    max16(g[0], g[2]); merge16<true>(g[0]);
}

constexpr int P5_KEYS_BYTES = 65536, P5_SCR_OFF = 65536;
__device__ __forceinline__ void topk_phase(Frame& F) {
    typedef float f32x16 __attribute__((ext_vector_type(16)));
    const bf16* QP = (const bf16*)(F.ws + WS_QP); const bf16* KEYS = (const bf16*)(F.ws + WS_KEYS);
    unsigned short* IDX = (unsigned short*)(F.ws + WS_IDX); float* GATE = (float*)(F.ws + WS_GATE);
    for (int i = F.tid; i < 256 * 16; i += NWAVES * 64) { const int row = i >> 4, ch = i & 15;
        const v4u v = *(const GAS v4u*)(KEYS + row * 128 + ch * 8); *(LAS v4u*)(F.lds + RING_OFF + row * 256 + ((ch ^ (row & 15)) << 4)) = v; }
    __syncthreads();
    const int lane = F.lane, r32 = lane & 31, hi = lane >> 5, h = F.wave;
    LAS unsigned char* scr = F.lds + RING_OFF + P5_SCR_OFF + F.wave * 2048 + lane * 32;
    for (int grp = F.vcu; grp < M / 32; grp += F.G) {
        const int tok = grp * 32 + r32;
        bf16x8 qf[2][8];
#pragma unroll
        for (int s = 0; s < 2; ++s)
#pragma unroll
            for (int ks = 0; ks < 8; ++ks) qf[s][ks] = *(const GAS bf16x8*)(QP + (size_t)tok * NPQ + 256 * h + 128 * s + 16 * ks + 8 * hi);
        f32x16 sc[2][4];
#pragma unroll
        for (int s = 0; s < 2; ++s)
#pragma unroll
            for (int kb = 0; kb < 4; ++kb) {
                f32x16 a = {};
                const int row = s * 128 + kb * 32 + r32;
#pragma unroll
                for (int ks = 0; ks < 8; ++ks) {
                    const bf16x8 kf = *(const LAS bf16x8*)(F.lds + RING_OFF + row * 256 + (((2 * ks + hi) ^ (row & 15)) << 4));
                    a = __builtin_amdgcn_mfma_f32_32x32x16_bf16(kf, qf[s][ks], a, 0, 0, 0);
                }
                sc[s][kb] = a;
            }
        unsigned g[8][16];
#pragma unroll
        for (int kb = 0; kb < 4; ++kb)
#pragma unroll
            for (int r = 0; r < 16; ++r) {
                auto rr = __builtin_amdgcn_permlane32_swap(__float_as_uint(sc[0][kb][r]), __float_as_uint(sc[1][kb][r]), false, false);
                const int key0 = 32 * kb + (r & 3) + 8 * (r >> 2);
                g[2 * kb][r] = (f2sort(__uint_as_float(rr[0])) & ~127u) | (unsigned)(127 - key0);
                g[2 * kb + 1][r] = (f2sort(__uint_as_float(rr[1])) & ~127u) | (unsigned)(127 - (key0 + 4));
            }
        top16_of_128(g);
        unsigned s1[16], s2[16];
#pragma unroll
        for (int i = 0; i < 16; ++i) { auto rr = __builtin_amdgcn_permlane32_swap(g[0][i], g[0][i], false, false); s1[i] = rr[0]; s2[i] = rr[1]; }
        {
            unsigned w1[4], w2[4];
#pragma unroll
            for (int q = 0; q < 4; ++q) {
                w1[q] = (127u - (s1[4 * q] & 127u)) | ((127u - (s1[4 * q + 1] & 127u)) << 8) | ((127u - (s1[4 * q + 2] & 127u)) << 16) | ((127u - (s1[4 * q + 3] & 127u)) << 24);
                w2[q] = (127u - (s2[4 * q] & 127u)) | ((127u - (s2[4 * q + 1] & 127u)) << 8) | ((127u - (s2[4 * q + 2] & 127u)) << 16) | ((127u - (s2[4 * q + 3] & 127u)) << 24);
            }
            *(LAS v4u*)(scr) = (v4u){w1[0], w1[1], w1[2], w1[3]}; *(LAS v4u*)(scr + 16) = (v4u){w2[0], w2[1], w2[2], w2[3]};
        }
        float v1[16], v2[16];
#pragma unroll
        for (int i = 0; i < 16; ++i) { v1[i] = sort2f(s1[i] & ~127u); v2[i] = sort2f(s2[i] & ~127u); }
        unsigned c[4][16];
        {
            int n = 0;
#pragma unroll
            for (int a = 0; a < 16; ++a)
#pragma unroll
                for (int b = 0; b < 16; ++b)
                    if ((a + 1) * (b + 1) <= 16) { c[n >> 4][n & 15] = (f2sort(v1[a] + v2[b]) & ~255u) | (unsigned)(255 - (16 * a + b)); ++n; }
#pragma unroll
            for (int q = 50; q < 64; ++q) c[q >> 4][q & 15] = 0u;
        }
        top16_of_64(c);
        asm volatile("s_waitcnt lgkmcnt(0)" ::: "memory");
        float ts[16]; unsigned ex[16];
#pragma unroll
        for (int k = 0; k < 16; ++k) {
            const unsigned ab = 255u - (c[0][k] & 255u); const unsigned a = ab >> 4, b = ab & 15u;
            const unsigned i1 = *(const LAS unsigned char*)(scr + a), i2 = *(const LAS unsigned char*)(scr + 16 + b);
            ex[k] = i1 * 128u + i2; ts[k] = sort2f(c[0][k] & ~255u);
        }
        float den = 0.f; const float tmax = ts[0];
#pragma unroll
        for (int k = 0; k < 16; ++k) { ts[k] = __builtin_amdgcn_exp2f((ts[k] - tmax) * 1.4426950408889634f); den += ts[k]; }
        const float rden = __builtin_amdgcn_rcpf(den);
        unsigned eo[8]; float go[8];
#pragma unroll
        for (int k = 0; k < 8; ++k) { eo[k] = hi ? ex[k + 8] : ex[k]; go[k] = (hi ? ts[k + 8] : ts[k]) * rden; }
        const size_t ob = (size_t)tok * 128 + h * 16 + hi * 8;
        *(GAS v4u*)(IDX + ob) = (v4u){eo[0] | (eo[1] << 16), eo[2] | (eo[3] << 16), eo[4] | (eo[5] << 16), eo[6] | (eo[7] << 16)};
        *(GAS f32x4*)(GATE + ob) = (f32x4){go[0], go[1], go[2], go[3]}; *(GAS f32x4*)(GATE + ob + 4) = (f32x4){go[4], go[5], go[6], go[7]};
    }
    __syncthreads();
}

typedef __bf16 bf16x2_t __attribute__((ext_vector_type(2)));
__device__ __forceinline__ float dot2bf(unsigned a, unsigned b, float acc) { return __builtin_amdgcn_fdot2_f32_bf16(__builtin_bit_cast(bf16x2_t, a), __builtin_bit_cast(bf16x2_t, b), acc, false); }
__device__ __forceinline__ float dot8(const v4u a, const v4u b, float acc) { acc = dot2bf(a.x, b.x, acc); acc = dot2bf(a.y, b.y, acc); acc = dot2bf(a.z, b.z, acc); return dot2bf(a.w, b.w, acc); }
__device__ __forceinline__ void peer_phase(Frame& F) {
    const bf16* X1B = (const bf16*)(F.ws + WS_XN); const bf16* UT = (const bf16*)(F.ws + WS_UT); const bf16* VT = (const bf16*)(F.ws + WS_VT);
    const unsigned short* IDX = (const unsigned short*)(F.ws + WS_IDX); const float* GATE = (const float*)(F.ws + WS_GATE); const float* SS = (const float*)(F.ws + WS_SS);
    const float* fg = F.in[15]; float* X1 = F.out;
    const int lane = F.lane; const int gw = F.vcu * NWAVES + F.wave, NGW = F.G * NWAVES;
    for (int tok = gw; tok < M; tok += NGW) {
        const v4u xa = *(const GAS v4u*)(X1B + (size_t)tok * D + 16 * lane), xb = *(const GAS v4u*)(X1B + (size_t)tok * D + 16 * lane + 8);
        float rstd2;
        { const float sv = (lane < 16) ? SS[(size_t)tok * 16 + lane] : 0.f; rstd2 = 1.f / sqrtf(wave_sum(sv) * (1.f / D) + RMS_EPS); }
        float acc[16];
#pragma unroll
        for (int i = 0; i < 16; ++i) acc[i] = 0.f;
#pragma unroll 1
        for (int hd = 0; hd < 8; ++hd) {
            const int my_e = (int)IDX[(size_t)tok * 128 + hd * 16 + (lane >> 2)];
            const float my_g = GATE[(size_t)tok * 128 + hd * 16 + (lane >> 2)];
            v4u ua[16], ub[16];
#pragma unroll
            for (int j = 0; j < 16; ++j) { const int e = __builtin_amdgcn_readlane(my_e, 4 * j); const GAS v4u* p = (const GAS v4u*)(UT + (size_t)e * D + 16 * lane); ua[j] = p[0]; ub[j] = p[1]; }
            float d[16];
#pragma unroll
            for (int j = 0; j < 16; ++j) d[j] = dot8(ub[j], xb, dot8(ua[j], xa, 0.f));
#pragma unroll
            for (int j = 0; j < 8; ++j) { auto rr = __builtin_amdgcn_permlane32_swap(__float_as_uint(d[j]), __float_as_uint(d[j + 8]), false, false); d[j] = __uint_as_float(rr[0]) + __uint_as_float(rr[1]); }
            { const bool up = (lane & 16) != 0;
#pragma unroll
              for (int j = 0; j < 4; ++j) { const float keep = up ? d[j + 4] : d[j], send = up ? d[j] : d[j + 4]; d[j] = keep + __shfl_xor(send, 16); } }
            { const bool up = (lane & 8) != 0;
#pragma unroll
              for (int j = 0; j < 2; ++j) { const float keep = up ? d[j + 2] : d[j], send = up ? d[j] : d[j + 2]; d[j] = keep + __shfl_xor(send, 8); } }
            { const bool up = (lane & 4) != 0; const float keep = up ? d[1] : d[0], send = up ? d[0] : d[1]; d[0] = keep + __shfl_xor(send, 4); }
            d[0] += __shfl_xor(d[0], 2); d[0] += __shfl_xor(d[0], 1);
            const float z = d[0] * rstd2;
            const float hv = z * __builtin_amdgcn_rcpf(1.f + __builtin_amdgcn_exp2f(-1.4426950408889634f * 1.5957691216057308f * (z + 0.044715f * z * z * z)));
            const unsigned wpk = pk2(my_g * hv, 0.f);
#pragma unroll
            for (int j = 0; j < 16; ++j) { const int e = __builtin_amdgcn_readlane(my_e, 4 * j); const GAS v4u* p = (const GAS v4u*)(VT + (size_t)e * D + 16 * lane); ua[j] = p[0]; ub[j] = p[1]; }
#pragma unroll
            for (int j = 0; j < 16; ++j) {
                const unsigned wlo = (unsigned)__builtin_amdgcn_readlane((int)wpk, 4 * j), whi = wlo << 16;
                acc[0] = dot2bf(ua[j].x, wlo, acc[0]); acc[1] = dot2bf(ua[j].x, whi, acc[1]); acc[2] = dot2bf(ua[j].y, wlo, acc[2]); acc[3] = dot2bf(ua[j].y, whi, acc[3]);
                acc[4] = dot2bf(ua[j].z, wlo, acc[4]); acc[5] = dot2bf(ua[j].z, whi, acc[5]); acc[6] = dot2bf(ua[j].w, wlo, acc[6]); acc[7] = dot2bf(ua[j].w, whi, acc[7]);
                acc[8] = dot2bf(ub[j].x, wlo, acc[8]); acc[9] = dot2bf(ub[j].x, whi, acc[9]); acc[10] = dot2bf(ub[j].y, wlo, acc[10]); acc[11] = dot2bf(ub[j].y, whi, acc[11]);
                acc[12] = dot2bf(ub[j].z, wlo, acc[12]); acc[13] = dot2bf(ub[j].z, whi, acc[13]); acc[14] = dot2bf(ub[j].w, wlo, acc[14]); acc[15] = dot2bf(ub[j].w, whi, acc[15]);
            }
        }
        GAS f32x4* xr = (GAS f32x4*)(X1 + (size_t)tok * D + 16 * lane); const GAS f32x4* gr = (const GAS f32x4*)(fg + 16 * lane);
        f32x4 xv[4]; float ss = 0.f;
#pragma unroll
        for (int q = 0; q < 4; ++q) { xv[q] = xr[q]; xv[q].x += acc[4 * q]; xv[q].y += acc[4 * q + 1]; xv[q].z += acc[4 * q + 2]; xv[q].w += acc[4 * q + 3];
            ss += (xv[q].x * xv[q].x + xv[q].y * xv[q].y) + (xv[q].z * xv[q].z + xv[q].w * xv[q].w); }
        const float rstd = 1.f / sqrtf(wave_sum(ss) * (1.f / D) + RMS_EPS);
#pragma unroll
        for (int q = 0; q < 4; ++q) { const f32x4 gg = gr[q]; xr[q] = xv[q] * rstd * gg; }
    }
}

struct Args { const float* in[16]; float* out; unsigned char* ws; int ph_lo, ph_hi, li, pad; };
__global__ void __launch_bounds__(NWAVES * 64, 2) mk_fwd(Args args) {
    extern __shared__ __attribute__((aligned(16))) unsigned char lds[];
    Frame F;
    F.lds = (LAS unsigned char*)lds;
    F.MISC = (volatile LAS unsigned*)(F.lds + MISC_OFF);
    F.tid = threadIdx.x; F.lane = F.tid & 63; F.wave = __builtin_amdgcn_readfirstlane(F.tid >> 6);
    F.G = gridDim.x; { const int bx = blockIdx.x; F.vcu = (F.G % 8 == 0) ? (bx % 8) * (F.G / 8) + bx / 8 : bx; }
#define GRID_BAR(seam) do { if (N_LAUNCHES == PER_PHASE) { if (F.tid == 0) __hip_atomic_store(F.ctl + CW_TMO, 0xBADBA0u | (unsigned)(seam), RLX_AGENT); } \
    else { xcd_barrier(bar); } } while (0)
    unsigned char* ws = args.ws;
    F.ctl = (gu32*)(ws + WS_CTL); F.ws = ws; F.out = args.out;
#pragma unroll
    for (int i = 0; i < 16; ++i) F.in[i] = args.in[i];
    for (int u = F.tid; u < (LDS_BYTES - LDSCTL_OFF) / 4; u += NWAVES * 64) ((LAS unsigned*)(F.lds + LDSCTL_OFF))[u] = 0u;
    __syncthreads();
    XcdBarrier bar; bar.bar = (unsigned*)(F.ctl + CW_BAR); bar.x = 0; bar.st = nullptr;
    if (N_LAUNCHES != PER_PHASE) bar = xcd_barrier_post((unsigned*)(F.ctl + CW_BAR), F.MISC + 8);

    const int lo = args.ph_lo, hi = args.ph_hi;
#define IN(k) (lo <= (k) && (k) < hi)
#define BOTH(k) (IN(k) && IN((k) + 1))

    if (IN(0)) { p0_prologue(F); if (BOTH(0)) GRID_BAR(0); }

    if (IN(1)) {
        pg8::Gemm g{(const pg8::bf16_t*)(ws + WS_XN), (const pg8::bf16_t*)(ws + WS_WIN), M, NIN, D}; pg8::StaticOrder S; S.init(M, NIN, F.G, (int)blockIdx.x);
        pg8::EpiP1 E{(pg8::bf16_t*)(ws + WS_Q), (pg8::bf16_t*)(ws + WS_K), (pg8::bf16_t*)(ws + WS_V), (pg8::bf16_t*)(ws + WS_H), F.in[3], F.in[4], (const float*)(ws + WS_ROPE), attn_body::C2};
        pg8::gemm_phase<pg8::EpiP1, pg8::StaticOrder, PG8_ALIGN, PG8_SP2>(F.lds + RING_OFF, g, S, E);
        if (BOTH(1)) GRID_BAR(1);
    }

    if (IN(2)) {
        conv_phase(F);
        const attn_body::AttnTensors AT{(const attn_body::bf16*)(ws + WS_Q), (const attn_body::bf16*)(ws + WS_K), (const attn_body::bf16*)(ws + WS_V), (attn_body::bf16*)(ws + WS_MIX)};
        const attn_body::StaticOrder S((int)F.G, (int)blockIdx.x);
        attn_body::attn_phase<attn_body::StaticOrder>((char*)lds + RING_OFF, AT, S);
        if (BOTH(2)) GRID_BAR(2);
    }

    if (IN(3)) {
        pg8::Gemm g{(const pg8::bf16_t*)(ws + WS_MIX), (const pg8::bf16_t*)(ws + WS_WOUT), M, D, D}; pg8::StaticOrder S; S.init(M, D, F.G, (int)blockIdx.x);
        pg8::EpiP3 E{F.in[0], F.out, (pg8::bf16_t*)(ws + WS_XN), (float*)(ws + WS_SS)};
        pg8::gemm_phase<pg8::EpiP3, pg8::StaticOrder, PG8_ALIGN, PG8_SP2>(F.lds + RING_OFF, g, S, E);
        if (BOTH(3)) GRID_BAR(3);
    }

    if (IN(4)) {
        pg8::Gemm g{(const pg8::bf16_t*)(ws + WS_XN), (const pg8::bf16_t*)(ws + WS_WQ), M, NPQ, D}; pg8::StaticOrder S; S.init(M, NPQ, F.G, (int)blockIdx.x);
        pg8::EpiP4 E{(pg8::bf16_t*)(ws + WS_QP), (const float*)(ws + WS_SS)};
        pg8::gemm_phase<pg8::EpiP4, pg8::StaticOrder, PG8_ALIGN, PG8_SP2>(F.lds + RING_OFF, g, S, E);
        if (BOTH(4)) GRID_BAR(4);
    }

    if (IN(5)) { topk_phase(F); if (BOTH(5)) GRID_BAR(5); }

    if (IN(6)) { peer_phase(F); }
#undef IN
#undef BOTH
}

extern "C" void kernel_launch(void* const* d_in, const int* in_sizes, int n_in, void* d_out, int out_size, void* d_ws, size_t ws_size, hipStream_t stream) {
    static int grid = 0;
    if (grid == 0) {
        if (n_in != 16 || in_sizes[0] != M * D || out_size != M * D || ws_size < WS_END) { fprintf(stderr, "kernel_launch: built for 16 inputs, x and out of %d floats, >= %zu bytes of workspace; got n_in %d, in0 %d, out %d, ws %zu; nothing launched\n", M * D, (size_t)WS_END, n_in, n_in > 0 ? in_sizes[0] : -1, out_size, ws_size); grid = -1; return; }
        int dev = 0, cus = 0, per_cu = 0;
        if (hipGetDevice(&dev) != hipSuccess || hipDeviceGetAttribute(&cus, hipDeviceAttributeMultiprocessorCount, dev) != hipSuccess) { fprintf(stderr, "kernel_launch: hipGetDevice / hipDeviceGetAttribute failed; nothing launched\n"); grid = -1; return; }
        if (hipFuncSetAttribute((const void*)mk_fwd, hipFuncAttributeMaxDynamicSharedMemorySize, LDS_BYTES) != hipSuccess) { fprintf(stderr, "kernel_launch: hipFuncSetAttribute failed\n"); grid = -1; return; }
        if (hipOccupancyMaxActiveBlocksPerMultiprocessor(&per_cu, (const void*)mk_fwd, NWAVES * 64, LDS_BYTES) != hipSuccess || per_cu < 1)
            fprintf(stderr, "kernel_launch: note: the occupancy query reports %d workgroups per CU\n", per_cu);
        (void)hipGetLastError();
        grid = cus;
        if (grid % 8 != 0 || grid > 256) { fprintf(stderr, "kernel_launch: unexpected CU count %d\n", grid); }
    }
    if (grid < 0) return;
    if (hipMemsetAsync((char*)d_ws + WS_CTL, 0, CTL_ZERO_BYTES, stream) != hipSuccess) { fprintf(stderr, "kernel_launch: hipMemsetAsync of the control words failed; nothing launched\n"); return; }
    Args a{};
    for (int i = 0; i < 16; ++i) a.in[i] = (const float*)d_in[i];
    a.out = (float*)d_out; a.ws = (unsigned char*)d_ws;
    for (int li = 0; li < N_LAUNCHES; ++li) {
        a.ph_lo = (N_LAUNCHES == PER_PHASE) ? li : 0; a.ph_hi = (N_LAUNCHES == PER_PHASE) ? li + 1 : PER_PHASE; a.li = li;
        hipLaunchKernelGGL(mk_fwd, dim3(grid), dim3(NWAVES * 64), LDS_BYTES, stream, a);
        const hipError_t le = hipPeekAtLastError();
        if (le != hipSuccess) { fprintf(stderr, "kernel_launch: launch %d failed: %s\n", li, hipGetErrorName(le)); break; }
    }
}
```

```cpp
#include <hip/hip_runtime.h>
#include <cstdio>
#include <cstdint>
namespace pg8 {
#define PG8_LAS __attribute__((address_space(3)))
typedef unsigned short bf16_t;
typedef short bf16x8 __attribute__((ext_vector_type(8)));
typedef float f32x4 __attribute__((ext_vector_type(4)));
typedef unsigned u32x4 __attribute__((ext_vector_type(4)));
constexpr int BM = 256, BK = 64, HALF = 128, HTB = HALF * BK * 2  , STAGE_BYTES = 8 * HTB, NXCD = 8, WGM = 8;

__host__ __device__ __forceinline__ int lds_byte(int r, int c) { const int st = (r >> 4) * 2 + (c >> 5), rr = r & 15, cc = c & 31, ob = rr * 64 + cc * 2; return st * 1024 + (ob ^ (((ob >> 9) & 1) << 5)); }
__host__ __device__ __forceinline__ void stage_rc(int b, int& R, int& C) { const int st = b / 1024, sb = b % 1024, swz = sb ^ (((sb >> 9) & 1) << 5); R = (st >> 1) * 16 + swz / 64; C = (st & 1) * 32 + (swz % 64) / 2; }
__host__ __device__ __forceinline__ int perm32(int rho) { const int n = rho >> 4, i = rho & 15; return 8 * (i >> 2) + 4 * n + (i & 3); }

struct Unit { int pm, pn; };
struct Gemm { const bf16_t* A; const bf16_t* Bt; int M, N, K; };

struct StaticOrder {
    int nM, nN, nwg, G, c;
    __host__ __device__ void init(int M, int N, int G_, int c_) { nM = M / BM; nN = N / BM; nwg = nM * nN; G = G_; c = c_; }
    __host__ __device__ bool next(int i, Unit& u) const {
        const long L = (long)i * G + c; if (L >= nwg) return false;
        int wgid = (int)L; { const int q = nwg / NXCD, r = nwg % NXCD, xcd = wgid % NXCD, off = wgid / NXCD; wgid = (xcd < r ? xcd * (q + 1) : r * (q + 1) + (xcd - r) * q) + off; }
        const int nig = WGM * nN, gid = wgid / nig, fm = gid * WGM, gsz = (nM - fm) < WGM ? (nM - fm) : WGM;
        u.pm = fm + ((wgid % nig) % gsz); u.pn = (wgid % nig) / gsz; return true;
    }
    __device__ __forceinline__ void a_ready(const Unit&) const {}
    __device__ __forceinline__ void done(const Unit&) const {}
};


__device__ __forceinline__ unsigned cvt_pk_bf16(float lo, float hi) { unsigned r; asm volatile("v_cvt_pk_bf16_f32 %0, %1, %2" : "=v"(r) : "v"(lo), "v"(hi)); return r; }
typedef unsigned u32x2 __attribute__((ext_vector_type(2)));
__device__ __forceinline__ u32x4 pack8(const f32x4 a, const f32x4 b) { u32x4 w; w.x = cvt_pk_bf16(a[0], a[1]); w.y = cvt_pk_bf16(a[2], a[3]); w.z = cvt_pk_bf16(b[0], b[1]); w.w = cvt_pk_bf16(b[2], b[3]); return w; }

#ifndef WT_STORES
#define WT_STORES 0
#endif
struct WsSt { __amdgpu_buffer_rsrc_t rs; unsigned char* base;
    __device__ __forceinline__ void st16(size_t off, const u32x4 v) const {
#if WT_STORES
        __builtin_amdgcn_raw_buffer_store_b128(v, rs, (int)(unsigned)off, 0, 16);
#else
        *(u32x4*)(base + off) = v;
#endif
    } };
struct EpiP1 {
    static constexpr bool PERM = true, AFTER_DRAIN = false;
    WsSt W; size_t oQ, oK, oV, oH; const float *qg, *kg; const float* rope; float qscale;
    __device__ __forceinline__ void operator()(const f32x4 (&acc)[2][2][4][2], const Unit& u, int wr, int wc, int fr, int fq) const {
        const int row0 = u.pm * BM + wr * 64 + fr;
        if (u.pn < 2 || (u.pn == 2 && wc < 2)) {
            const bool isq = u.pn < 2;
            const float* g = isq ? qg : kg;
            f32x4 gv[2][2];
#pragma unroll
            for (int bj = 0; bj < 2; ++bj)
#pragma unroll
                for (int n = 0; n < 2; ++n) gv[bj][n] = *(const f32x4*)(g + 32 * bj + 16 * n + 4 * fq);
            const float sc = isq ? qscale : 1.f;
            const size_t base = isq ? (oQ + (size_t)(4 * u.pn + wc) * 64) : (oK + (size_t)wc * 64);
            const int pitch = isq ? 512 : 128;
            f32x4 rA[2][2], rB[4][2];
#pragma unroll
            for (int ai = 0; ai < 2; ++ai) { const int pos = ((row0 + ai * HALF) & 8191) >> 6; const f32x4* rp = (const f32x4*)(rope + (pos * 16 + 4 * fq) * 2); rA[ai][0] = rp[0]; rA[ai][1] = rp[1]; }
#pragma unroll
            for (int m = 0; m < 4; ++m) { const int pos = (row0 + m * 16) & 63; const f32x4* rp = (const f32x4*)(rope + (pos * 16 + 4 * fq) * 2); rB[m][0] = rp[0]; rB[m][1] = rp[1]; }
#pragma unroll
            for (int ai = 0; ai < 2; ++ai)
#pragma unroll
                for (int m = 0; m < 4; ++m) {
                    const int row = row0 + ai * HALF + m * 16;
                    float ss = 0.f;
#pragma unroll
                    for (int bj = 0; bj < 2; ++bj)
#pragma unroll
                        for (int n = 0; n < 2; ++n) { const f32x4 v = acc[ai][bj][m][n]; ss += (v[0] * v[0] + v[1] * v[1]) + (v[2] * v[2] + v[3] * v[3]); }
                    ss += __shfl_xor(ss, 16); ss += __shfl_xor(ss, 32);
                    const float rstd = __builtin_amdgcn_rsqf(ss * (1.0f / 64.0f) + 1e-6f) * sc;
#pragma unroll
                    for (int bj = 0; bj < 2; ++bj) {
                        const f32x4 r01 = bj ? rB[m][0] : rA[ai][0], r23 = bj ? rB[m][1] : rA[ai][1];
                        const f32x4 x1 = acc[ai][bj][m][0] * gv[bj][0] * rstd, x2 = acc[ai][bj][m][1] * gv[bj][1] * rstd;
                        const f32x4 cs = (f32x4){r01[0], r01[2], r23[0], r23[2]}, sn = (f32x4){r01[1], r01[3], r23[1], r23[3]};
                        const f32x4 o1 = x1 * cs - x2 * sn, o2 = x2 * cs + x1 * sn;
                        u32x2 w8; { int lo = 0, hi_ = 0;
                            lo = __builtin_amdgcn_cvt_pk_fp8_f32(o1[0], o1[1], lo, false); lo = __builtin_amdgcn_cvt_pk_fp8_f32(o1[2], o1[3], lo, true);
                            hi_ = __builtin_amdgcn_cvt_pk_fp8_f32(o2[0], o2[1], hi_, false); hi_ = __builtin_amdgcn_cvt_pk_fp8_f32(o2[2], o2[3], hi_, true); w8.x = (unsigned)lo; w8.y = (unsigned)hi_; }
                        *(u32x2*)(W.base + base + (size_t)row * pitch + 32 * bj + 8 * fq) = w8;
                    }
                }
        } else if (u.pn == 2) {
            const size_t base = oV + (size_t)(wc - 2) * 128;
#pragma unroll
            for (int ai = 0; ai < 2; ++ai)
#pragma unroll
                for (int m = 0; m < 4; ++m) {
                    const int row = row0 + ai * HALF + m * 16;
#pragma unroll
                    for (int bj = 0; bj < 2; ++bj) W.st16(base + ((size_t)row * 128 + 32 * bj + 8 * fq) * 2, pack8(acc[ai][bj][m][0], acc[ai][bj][m][1]));
                }
        } else {
            const size_t base = oH + (size_t)((u.pn - 3) * 128 + wc * 32 + 8 * fq) * 2;
#pragma unroll
            for (int ai = 0; ai < 2; ++ai)
#pragma unroll
                for (int m = 0; m < 4; ++m) {
                    const int row = row0 + ai * HALF + m * 16;
                    f32x4 o[2];
#pragma unroll
                    for (int n = 0; n < 2; ++n) { const f32x4 a = acc[ai][0][m][n], b = acc[ai][1][m][n];
#pragma unroll
                        for (int e = 0; e < 4; ++e) o[n][e] = a[e] * __builtin_amdgcn_rcpf(1.0f + __builtin_amdgcn_exp2f(-1.4426950408889634f * b[e])); }
                    W.st16(base + (size_t)row * 1024, pack8(o[0], o[1]));
                }
        }
    }
};

struct EpiP3 {
    static constexpr bool PERM = true, AFTER_DRAIN = false;
    WsSt W; size_t oX; bf16_t* X1B; const float* rsi; const float* ig1; float* SS;
    __device__ __forceinline__ void operator()(const f32x4 (&acc)[2][2][4][2], const Unit& u, int wr, int wc, int fr, int fq) const {
        const int row0 = u.pm * BM + wr * 64 + fr, col0 = u.pn * BM + wc * 32 + 8 * fq;
        f32x4 ig[2][2];
#pragma unroll
        for (int bj = 0; bj < 2; ++bj)
#pragma unroll
            for (int n = 0; n < 2; ++n) ig[bj][n] = *(const f32x4*)(ig1 + col0 + bj * HALF + 4 * n);
#pragma unroll
        for (int ai = 0; ai < 2; ++ai) {
        u32x4 xw[2][4][2]; float ri[2][4];
#pragma unroll
            for (int m = 0; m < 4; ++m) { const int row = row0 + ai * HALF + m * 16; const size_t off = (size_t)row * 1024 + col0;
                ri[ai][m] = rsi[row];
#pragma unroll
                for (int bj = 0; bj < 2; ++bj) xw[ai][m][bj] = *(const u32x4*)(X1B + off + bj * HALF); }
            asm volatile("" ::: "memory");
#pragma unroll
            for (int m = 0; m < 4; ++m) {
                const int row = row0 + ai * HALF + m * 16; const size_t off = (size_t)row * 1024 + col0;
                float ss = 0.f;
#pragma unroll
                for (int bj = 0; bj < 2; ++bj) {
                    const u32x4 w_ = xw[ai][m][bj];
                    const f32x4 xa = (f32x4){__uint_as_float(w_.x << 16), __uint_as_float(w_.x & 0xffff0000u), __uint_as_float(w_.y << 16), __uint_as_float(w_.y & 0xffff0000u)};
                    const f32x4 xb = (f32x4){__uint_as_float(w_.z << 16), __uint_as_float(w_.z & 0xffff0000u), __uint_as_float(w_.w << 16), __uint_as_float(w_.w & 0xffff0000u)};
                    const f32x4 v0 = acc[ai][bj][m][0] + xa * ig[bj][0] * ri[ai][m], v1 = acc[ai][bj][m][1] + xb * ig[bj][1] * ri[ai][m];
                    W.st16(oX + (off + bj * HALF) * 2, pack8(v0, v1));
                    ss += (v0[0] * v0[0] + v0[1] * v0[1]) + (v0[2] * v0[2] + v0[3] * v0[3]) + (v1[0] * v1[0] + v1[1] * v1[1]) + (v1[2] * v1[2] + v1[3] * v1[3]);
                }
                ss += __shfl_xor(ss, 16); ss += __shfl_xor(ss, 32);
                if (fq == 0) SS[(size_t)row * 16 + u.pn * 4 + wc] = ss;
            }
        }
    }
};

struct EpiP4 {
    static constexpr bool PERM = true, AFTER_DRAIN = false;
    WsSt W; size_t oQP; const float* SS;
    __device__ __forceinline__ void operator()(const f32x4 (&acc)[2][2][4][2], const Unit& u, int wr, int wc, int fr, int fq) const {
        const int row0 = u.pm * BM + wr * 64 + fr, col0 = u.pn * BM + wc * 32 + 8 * fq;
        f32x4 sv[2][4];
#pragma unroll
        for (int ai = 0; ai < 2; ++ai)
#pragma unroll
            for (int m = 0; m < 4; ++m) sv[ai][m] = *(const f32x4*)(SS + (size_t)(row0 + ai * HALF + m * 16) * 16 + 4 * fq);
#pragma unroll
        for (int ai = 0; ai < 2; ++ai)
#pragma unroll
            for (int m = 0; m < 4; ++m) {
                const int row = row0 + ai * HALF + m * 16;
                float s = (sv[ai][m][0] + sv[ai][m][1]) + (sv[ai][m][2] + sv[ai][m][3]);
                s += __shfl_xor(s, 16); s += __shfl_xor(s, 32);
                const float rstd = __builtin_amdgcn_rsqf(s * (1.0f / 1024.0f) + 1e-6f);
#pragma unroll
                for (int bj = 0; bj < 2; ++bj)
                    W.st16(oQP + ((size_t)row * 2048 + col0 + bj * HALF) * 2, pack8(acc[ai][bj][m][0] * rstd, acc[ai][bj][m][1] * rstd));
            }
    }
};
template <class Epi, class Sched, bool ALIGN_EPI = false, bool SP2 = false>
__device__ __forceinline__ void gemm_phase(PG8_LAS unsigned char* lds, const Gemm g, const Sched& S, const Epi& E) {
    const int tid = threadIdx.x, wid = __builtin_amdgcn_readfirstlane(tid >> 6), lane = tid & 63, wr = wid >> 2, wc = wid & 3, fr = lane & 15, fq = lane >> 4;
    const int K = g.K, nt = K / BK;
    unsigned voffA[2], voffB[2];
#pragma unroll
    for (int i = 0; i < 2; ++i) { int R, C; stage_rc(tid * 16 + i * 8192, R, C); const int Rb = Epi::PERM ? ((R & ~31) + perm32(R & 31)) : R;
        voffA[i] = (unsigned)(R * K + C) * 2u; voffB[i] = (unsigned)(Rb * K + C) * 2u; }
    const size_t kstep = (size_t)(BK * 2);
    const size_t hstep = (size_t)HALF * K * 2;
    const size_t tstep = 2 * hstep;
    const unsigned ldsw = (unsigned)wid * 1024u;
    const int aoff = lds_byte(wr * 64 + fr, fq * 8), boff = lds_byte(wc * 32 + fr, fq * 8);
#define PG8_SA(b, h) (((b) * 2 + (h)) * HTB)
#define PG8_SB(b, h) ((4 + (b) * 2 + (h)) * HTB)
#define PG8_STAGE(bufoff, gbase, voff) do { _Pragma("unroll") for (int _i = 0; _i < 2; ++_i) \
        __builtin_amdgcn_global_load_lds((const unsigned*)((const char*)(gbase) + (voff)[_i]), (PG8_LAS unsigned*)(lds + (bufoff) + ldsw + _i * 8192), 16, 0, 0); } while (0)
#define PG8_LDA(dst, b, h) do { _Pragma("unroll") for (int m = 0; m < 4; ++m) _Pragma("unroll") for (int k = 0; k < 2; ++k) dst[m][k] = *(const PG8_LAS bf16x8*)(lds + PG8_SA(b, h) + aoff + m * 2048 + k * 1024); } while (0)
#define PG8_LDB(dst, b, h) do { _Pragma("unroll") for (int n = 0; n < 2; ++n) _Pragma("unroll") for (int k = 0; k < 2; ++k) dst[n][k] = *(const PG8_LAS bf16x8*)(lds + PG8_SB(b, h) + boff + n * 2048 + k * 1024); } while (0)
#define PG8_MMA(ai, bj, At, Bt) do { __builtin_amdgcn_s_setprio(1); _Pragma("unroll") for (int m = 0; m < 4; ++m) _Pragma("unroll") for (int n = 0; n < 2; ++n) _Pragma("unroll") for (int k = 0; k < 2; ++k) \
        acc[ai][bj][m][n] = __builtin_amdgcn_mfma_f32_16x16x32_bf16(Bt[n][k], At[m][k], acc[ai][bj][m][n], 0, 0, 0); __builtin_amdgcn_s_setprio(0); } while (0)
#define PG8_WAIT_V(n) asm volatile("s_waitcnt vmcnt(" #n ")" ::: "memory")
#define PG8_WAIT_L(n) asm volatile("s_waitcnt lgkmcnt(" #n ")" ::: "memory")
#define PG8_BAR __builtin_amdgcn_s_barrier()
#define PG8_SCHED __builtin_amdgcn_sched_barrier(0)
    Unit cur, nxt; int ui = 0;
    if (!S.next(0, cur)) return;
    f32x4 acc[2][2][4][2];
#pragma unroll
    for (int a = 0; a < 2; ++a)
#pragma unroll
        for (int b = 0; b < 2; ++b)
#pragma unroll
            for (int m = 0; m < 4; ++m)
#pragma unroll
                for (int n = 0; n < 2; ++n) acc[a][b][m][n] = (f32x4){0.f, 0.f, 0.f, 0.f};
    bf16x8 At[4][2], B0[2][2], B1[2][2];
    const char* cA = (const char*)g.A + (size_t)cur.pm * tstep; const char* cB = (const char*)g.Bt + (size_t)cur.pn * tstep;
    S.a_ready(cur);
    if constexpr (SP2) {
        PG8_STAGE(PG8_SB(0, 0), cB, voffB); PG8_STAGE(PG8_SB(0, 1), cB + hstep, voffB); PG8_STAGE(PG8_SA(0, 0), cA, voffA); PG8_STAGE(PG8_SA(0, 1), cA + hstep, voffA);
        if (wr == 1) PG8_BAR;
        PG8_WAIT_V(2); PG8_BAR;
        PG8_STAGE(PG8_SB(1, 0), cB + kstep, voffB); PG8_STAGE(PG8_SA(1, 0), cA + kstep, voffA); PG8_STAGE(PG8_SB(1, 1), cB + hstep + kstep, voffB);
        PG8_WAIT_V(6); PG8_BAR;
    } else {
        PG8_STAGE(PG8_SB(0, 0), cB, voffB); PG8_STAGE(PG8_SA(0, 0), cA, voffA); PG8_STAGE(PG8_SB(0, 1), cB + hstep, voffB); PG8_STAGE(PG8_SA(0, 1), cA + hstep, voffA);
        if (wr == 1) PG8_BAR;
        PG8_WAIT_V(4); PG8_BAR;
        PG8_STAGE(PG8_SB(1, 0), cB + kstep, voffB); PG8_STAGE(PG8_SA(1, 0), cA + kstep, voffA); PG8_STAGE(PG8_SB(1, 1), cB + hstep + kstep, voffB);
        PG8_WAIT_V(6); PG8_BAR;
    }
    for (;;) {
        const bool has_next = S.next(ui + 1, nxt);
        const char* nA = has_next ? (const char*)g.A + (size_t)nxt.pm * tstep : cA; const char* nB = has_next ? (const char*)g.Bt + (size_t)nxt.pn * tstep : cB;
        for (int t = 0; t < nt; t += 2) {
            const bool last = (t == nt - 2);
            const char* a1 = cA + (size_t)(t + 1) * kstep;
            const char* a2 = last ? nA : cA + (size_t)(t + 2) * kstep; const char* b2 = last ? nB : cB + (size_t)(t + 2) * kstep;
            const char* a3 = a2 + kstep; const char* b3 = b2 + kstep;
            if (last && has_next) S.a_ready(nxt);
            if constexpr (SP2) {
            PG8_LDB(B0, 0, 0); PG8_LDB(B1, 0, 1); PG8_SCHED; PG8_LDA(At, 0, 0); PG8_STAGE(PG8_SA(1, 1), a1 + hstep, voffA);
            PG8_WAIT_V(8); PG8_WAIT_L(0); PG8_BAR; PG8_MMA(0, 0, At, B0); PG8_MMA(0, 1, At, B1); PG8_BAR; PG8_SCHED;
            PG8_LDA(At, 0, 1); PG8_STAGE(PG8_SB(0, 0), b2, voffB); PG8_STAGE(PG8_SB(0, 1), b2 + hstep, voffB); PG8_STAGE(PG8_SA(0, 0), a2, voffA);
            PG8_WAIT_V(8); PG8_WAIT_L(0); PG8_BAR; PG8_MMA(1, 0, At, B0); PG8_MMA(1, 1, At, B1); PG8_BAR; PG8_SCHED;
            PG8_LDB(B0, 1, 0); PG8_LDB(B1, 1, 1); PG8_SCHED; PG8_LDA(At, 1, 0); PG8_STAGE(PG8_SA(0, 1), a2 + hstep, voffA);
            PG8_WAIT_V(8); PG8_WAIT_L(0); PG8_BAR; PG8_MMA(0, 0, At, B0); PG8_MMA(0, 1, At, B1); PG8_BAR; PG8_SCHED;
            PG8_LDA(At, 1, 1); PG8_STAGE(PG8_SB(1, 0), b3, voffB); PG8_STAGE(PG8_SB(1, 1), b3 + hstep, voffB); PG8_STAGE(PG8_SA(1, 0), a3, voffA);
            PG8_WAIT_V(8); PG8_WAIT_L(0); PG8_BAR; PG8_MMA(1, 0, At, B0); PG8_MMA(1, 1, At, B1); PG8_BAR; PG8_SCHED;
            } else {
            PG8_LDB(B0, 0, 0); PG8_SCHED; PG8_LDA(At, 0, 0); PG8_STAGE(PG8_SA(1, 1), a1 + hstep, voffA);
            PG8_WAIT_L(8); PG8_BAR; PG8_WAIT_L(0); PG8_MMA(0, 0, At, B0); PG8_BAR; PG8_SCHED;
            PG8_LDB(B1, 0, 1); PG8_STAGE(PG8_SB(0, 0), b2, voffB);
            PG8_BAR; PG8_WAIT_L(0); PG8_MMA(0, 1, At, B1); PG8_BAR;
            PG8_LDA(At, 0, 1); PG8_STAGE(PG8_SA(0, 0), a2, voffA);
            PG8_BAR; PG8_WAIT_L(0); PG8_MMA(1, 0, At, B0); PG8_BAR; PG8_SCHED;
            PG8_STAGE(PG8_SB(0, 1), b2 + hstep, voffB);
            PG8_WAIT_V(6); PG8_BAR; PG8_MMA(1, 1, At, B1); PG8_BAR;
            PG8_LDB(B0, 1, 0); PG8_SCHED; PG8_LDA(At, 1, 0); PG8_STAGE(PG8_SA(0, 1), a2 + hstep, voffA);
            PG8_WAIT_L(8); PG8_BAR; PG8_WAIT_L(0); PG8_MMA(0, 0, At, B0); PG8_BAR; PG8_SCHED;
            PG8_LDB(B1, 1, 1); PG8_STAGE(PG8_SB(1, 0), b3, voffB);
            PG8_BAR; PG8_WAIT_L(0); PG8_MMA(0, 1, At, B1); PG8_BAR;
            PG8_LDA(At, 1, 1); PG8_STAGE(PG8_SA(1, 0), a3, voffA);
            PG8_BAR; PG8_WAIT_L(0); PG8_MMA(1, 0, At, B0); PG8_BAR; PG8_SCHED;
            PG8_STAGE(PG8_SB(1, 1), b3 + hstep, voffB);
            PG8_WAIT_V(6); PG8_BAR; PG8_MMA(1, 1, At, B1); PG8_BAR;
            }
        }
        if constexpr (ALIGN_EPI) { if (wr == 0) PG8_BAR; }
        if constexpr (!Epi::AFTER_DRAIN) { E(acc, cur, wr, wc, fr, fq); S.done(cur); }
        if (!has_next) break;
#pragma unroll
        for (int a = 0; a < 2; ++a)
#pragma unroll
            for (int b = 0; b < 2; ++b)
#pragma unroll
                for (int m = 0; m < 4; ++m)
#pragma unroll
                    for (int n = 0; n < 2; ++n) acc[a][b][m][n] = (f32x4){0.f, 0.f, 0.f, 0.f};
        cur = nxt; cA = nA; cB = nB; ++ui;
        if constexpr (ALIGN_EPI) { if (wr == 1) PG8_BAR; }
    }
    PG8_WAIT_V(0);
    if constexpr (!ALIGN_EPI) { if (wr == 0) PG8_BAR; }
    PG8_BAR;
    if constexpr (Epi::AFTER_DRAIN) { E.fused(acc, cur, wr, wc, fr, fq, lds, wid, lane); S.done(cur); }
#undef PG8_SA
#undef PG8_SB
#undef PG8_STAGE
#undef PG8_LDA
#undef PG8_LDB
#undef PG8_MMA
#undef PG8_WAIT_V
#undef PG8_WAIT_L
#undef PG8_BAR
#undef PG8_SCHED
}
}
#ifndef PG8_SP2
#define PG8_SP2 true
#endif
#ifndef PG8_ALIGN
#define PG8_ALIGN true
#endif
#include <hip/hip_bf16.h>
#include <cmath>
namespace attn_body {
using bf16=__hip_bfloat16;
using bf16x8=__attribute__((ext_vector_type(8)))short;
using s16x4=__attribute__((ext_vector_type(4)))short;
using f32x16=__attribute__((ext_vector_type(16)))float;
using u32x4=__attribute__((ext_vector_type(4)))unsigned;
constexpr int BATCH=4,NHEAD=8,SEQ=8192,D=64,QPITCH=512,KVPITCH=128,OPITCH=1024;
constexpr int NW=8,QBLK=32,QB=QBLK*NW,KVBLK=64,NQB=SEQ/QB;
constexpr int ATTN_UNIT_ROWS=QB;
__device__ __forceinline__ int crow(int r,int hi){return (r&3)+8*(r>>2)+4*hi;}
#define SBAR() __builtin_amdgcn_sched_barrier(0)
__device__ __forceinline__ void cmask(f32x16&p0,f32x16&p1,int jb,int qrel,int hi){
  const float NEG=-INFINITY; int kb=64*jb+4*hi;
  #pragma unroll
  for(int r=0;r<16;++r){int kv=kb+(r&3)+8*(r>>2); if(kv>qrel)p0[r]=NEG; if(kv+32>qrel)p1[r]=NEG;}
}

constexpr int NSLOT=3, SLOTB=8192;
constexpr int LDS_K=0, LDS_V=NSLOT*SLOTB, LDS_WS=2*NSLOT*SLOTB, LDS_OST=LDS_WS+NW*64*4, LDS_BYTES=LDS_OST+NW*4096;
constexpr float C2=0.125f*1.4426950408889634f;
__device__ __forceinline__ void glds16(const void*gsrc,unsigned lds_dst){unsigned keep;
  asm volatile("s_mov_b32 %0, m0\n\ts_mov_b32 m0, %2\n\ts_nop 0\n\tglobal_load_lds_dwordx4 %1, off\n\ts_mov_b32 m0, %0":"=&s"(keep):"v"(gsrc),"s"(lds_dst):"memory");}
__device__ __forceinline__ float max3f(float a,float b,float c){float r;asm("v_max3_f32 %0, %1, %2, %3":"=v"(r):"v"(a),"v"(b),"v"(c));return r;}
__device__ __forceinline__ float max2f(float a,float b){float r;asm("v_max_f32_e32 %0, %1, %2":"=v"(r):"v"(a),"v"(b));return r;}
__device__ __forceinline__ float fadd_s(float a,float b){float r;asm("v_add_f32_e32 %0, %1, %2":"=v"(r):"v"(a),"v"(b));return r;}
__device__ __forceinline__ float fsub_s(float a,float b){float r;asm("v_sub_f32_e32 %0, %1, %2":"=v"(r):"v"(a),"v"(b));return r;}
typedef float f32x2_t __attribute__((ext_vector_type(2))); typedef __bf16 bf16x2_t __attribute__((ext_vector_type(2)));
__device__ __forceinline__ unsigned cvtpk_s(float lo,float hi){f32x2_t v={lo,hi};bf16x2_t b=__builtin_convertvector(v,bf16x2_t);return __builtin_bit_cast(unsigned,b);}
#define WAIT_BAR(N) asm volatile("s_waitcnt lgkmcnt(0)\n\ts_barrier":::"memory")
#define WAIT_BARC(N,NV) do{ if(kwave){WAIT_BAR(N);}else{WAIT_BAR(NV);} }while(0)

typedef int v8i_t __attribute__((ext_vector_type(8))); typedef int v4i_t __attribute__((ext_vector_type(4)));
__device__ __forceinline__ v8i_t cat8(const v4i_t a,const v4i_t b){return (v8i_t){a.x,a.y,a.z,a.w,b.x,b.y,b.z,b.w};}
__device__ __forceinline__ f32x16 qk8(const v8i_t kf,const v8i_t qf,const f32x16 c){return __builtin_amdgcn_mfma_scale_f32_32x32x64_f8f6f4(kf,qf,c,0,0,0,0,0,0);}
__device__ __forceinline__ void qkt(f32x16&p0,f32x16&p1,const char*Kslot,const v8i_t qr,const f32x16&negm,int r32,int hi){
  const char*kb=Kslot+hi*2048+r32*16;
  const v4i_t a0=*reinterpret_cast<const v4i_t*>(kb),a1=*reinterpret_cast<const v4i_t*>(kb+1024),b0=*reinterpret_cast<const v4i_t*>(kb+512),b1=*reinterpret_cast<const v4i_t*>(kb+1536);
  p0=qk8(cat8(a0,a1),qr,negm);p1=qk8(cat8(b0,b1),qr,negm);
}
typedef __attribute__((address_space(3))) const char* lds_cptr;
typedef short v4i16_t __attribute__((ext_vector_type(4)));
typedef __attribute__((address_space(3))) const v4i_t* lds_v4p;
__device__ __forceinline__ void kload2(v8i_t*kf,lds_cptr kp,int j){ kf[j]=cat8(*(lds_v4p)(kp+j*512),*(lds_v4p)(kp+j*512+1024)); }
__device__ __forceinline__ void kload8(v8i_t*kf,lds_cptr kp){ kload2(kf,kp,0); kload2(kf,kp,1); }
__device__ __forceinline__ s16x4 vtr(lds_cptr p){ return __builtin_bit_cast(s16x4,__builtin_amdgcn_ds_read_tr16_b64_v4i16((__attribute__((address_space(3))) v4i16_t*)p)); }
__device__ __forceinline__ float rowmax(const f32x16&p0,const f32x16&p1){
  float a=max3f(p0[0],p0[1],p1[0]),b=max3f(p0[2],p0[3],p1[1]);a=max3f(a,p1[2],p1[3]);
  #pragma unroll
  for(int r=4;r<16;r+=4){a=max3f(a,p0[r],p0[r+1]);b=max3f(b,p0[r+2],p0[r+3]);a=max3f(a,p1[r],p1[r+1]);b=max3f(b,p1[r+2],p1[r+3]);}
  const float m=max2f(a,b);
  auto rr=__builtin_amdgcn_permlane32_swap(__float_as_uint(m),__float_as_uint(m),false,false);
  return max2f(__uint_as_float(rr[0]),__uint_as_float(rr[1]));
}
__device__ __forceinline__ f32x16 pv8(const v8i_t pa,const v8i_t vb,const f32x16 c){return __builtin_amdgcn_mfma_scale_f32_32x32x64_f8f6f4(pa,vb,c,1,0,0,0,0,0);}
#define PKASM(w,a,b,c,d) do{ int t_; asm volatile("v_cvt_pkrtz_f16_f32 %0, %2, %3\n\tv_cvt_pkrtz_f16_f32 %1, %4, %5\n\tv_perm_b32 %0, %1, %0, %6":"=&v"(w),"=&v"(t_):"v"(a),"v"(b),"v"(c),"v"(d),"s"(0x07050301)); }while(0)
#define PKASML(w,a,b,c,d) do{ int t_; asm volatile("v_cvt_pkrtz_f16_f32 %0, %2, %3\n\tv_cvt_pkrtz_f16_f32 %1, %4, %5\n\tv_perm_b32 %0, %1, %0, %6\n\ts_nop 1":"=&v"(w),"=&v"(t_):"v"(a),"v"(b),"v"(c),"v"(d),"s"(0x07050301)); }while(0)
__device__ __forceinline__ int pk8(float a,float b,float c,float d){int w=0;w=__builtin_amdgcn_cvt_pk_bf8_f32(a,b,w,false);w=__builtin_amdgcn_cvt_pk_bf8_f32(c,d,w,true);return w;}
__device__ __forceinline__ void pv(f32x16*o,lds_cptr vp,const v8i_t pw){
  const v8i_t v0=cat8(*(lds_v4p)(vp),*(lds_v4p)(vp+1024)),v1=cat8(*(lds_v4p)(vp+512),*(lds_v4p)(vp+1536));
  o[0]=pv8(pw,v0,o[0]);o[1]=pv8(pw,v1,o[1]);
}
#ifndef ATTN_STORE16
#define ATTN_STORE16(p,v) (*(u32x4*)(p)=(v))
#endif
template<int THRL> __device__ __forceinline__ void attn_unit(int b,int h,int qb,const bf16*Q,const bf16*__restrict__ K,const bf16*__restrict__ V,bf16*O,char*shm){
  const int tid=threadIdx.x,lane=tid&63,r32=lane&31,hi=lane>>5; const int wid=__builtin_amdgcn_readfirstlane(tid>>6);
  const long rowbase=(long)b*SEQ; const int q0=qb*QB;
  const unsigned lds0=(unsigned)(uintptr_t)shm;
  float*wsf=(float*)(shm+LDS_WS)+wid*64;
  const bool kwave=wid<4;
  const unsigned char*ksrc=(const unsigned char*)K+(rowbase*128+(h>>2)*64)+(long)lane*128+(wid&3)*16;
  const unsigned char*vsrc=(const unsigned char*)V+((size_t)((b*2+(h>>2))*(SEQ/KVBLK))*4096)+(long)lane*64+(wid&3)*16;
  const unsigned char*ssrc=kwave?ksrc:vsrc; const long sstep=kwave?(long)KVBLK*128:4096L;
  typedef __attribute__((address_space(3))) u32x4* lds_w4p; const lds_w4p sdst=(lds_w4p)((__attribute__((address_space(3))) char*)shm+(kwave?LDS_K:LDS_V)+(wid&3)*1024+lane*16);
  #define LDT(t) (*reinterpret_cast<const u32x4*>(ssrc+(long)(t)*sstep))
  #define WRT(slot,reg) (*(lds_w4p)((__attribute__((address_space(3))) char*)sdst+(slot))=(reg))
  const char*Kbase=shm+LDS_K; v8i_t kf[2];
  const lds_cptr shm3=(lds_cptr)shm; const lds_cptr kp0=shm3+LDS_K+hi*2048+r32*16; const lds_cptr vp0=shm3+LDS_V+hi*2048+r32*16;
  const int NT=SEQ/KVBLK;
  u32x4 st0=LDT(0),st1=LDT(1),st2=LDT(kwave?2:1),st3=LDT(kwave?3:1),stn;
  v8i_t qr;{const unsigned char*q8=(const unsigned char*)Q+((rowbase+q0+wid*QBLK+r32)*512+h*64+hi*32);qr=cat8(*reinterpret_cast<const v4i_t*>(q8),*reinterpret_cast<const v4i_t*>(q8+16));}
  float mhat=0.f,l_reg=0.f;f32x16 o[2];o[0]=f32x16{};o[1]=f32x16{};f32x16 negm=f32x16{};asm volatile("":"+v"(negm));
  const int qrel=wid*QBLK+r32;
  #define CMASK(P0,P1,t) do{}while(0)
  bool resc=false;
  #define START(P0,P1) do{ const float rm=rowmax(P0,P1); resc=false; \
    { const float dl=rm; mhat=fadd_s(mhat,dl); \
      _Pragma("unroll") for(int r=0;r<16;++r){P0[r]=fsub_s(P0[r],dl);P1[r]=fsub_s(P1[r],dl);} \
      _Pragma("unroll") for(int r=0;r<16;++r)negm[r]=-mhat; asm volatile("":"+v"(negm)); } \
    _Pragma("unroll") for(int r=0;r<16;++r)P0[r]=__builtin_amdgcn_exp2f(P0[r]); }while(0)
  #define RESC() do{ if(resc){ asm volatile("s_waitcnt lgkmcnt(0)":::"memory"); \
      _Pragma("unroll") for(int d_=0;d_<2;++d_) _Pragma("unroll") for(int r=0;r<16;++r)o[d_][r]*=wsf[crow(r,hi)]; } }while(0)
  f32x16 pA0,pA1,pB0,pB1;
  int sl_prev=0,sl_cur=0,sl_next=SLOTB;
  #define ROT() do{sl_prev=sl_cur;sl_cur=sl_next;sl_next=(sl_next==(NSLOT-1)*SLOTB)?0:sl_next+SLOTB;}while(0)
  WRT(0,st0); if(kwave){WRT(SLOTB,st1);WRT(2*SLOTB,st2);}
  WAIT_BARC(3,0);
  qkt(pA0,pA1,Kbase,qr,negm,r32,hi);asm volatile("s_nop 15\n\ts_nop 7":"+v"(pA0),"+v"(pA1));CMASK(pA0,pA1,0);
  START(pA0,pA1);
  _Pragma("unroll") for(int r=0;r<16;++r)pA1[r]=__builtin_amdgcn_exp2f(pA1[r]);
  WAIT_BAR(0);
  if(kwave){WRT(0,st3);stn=LDT(4);}else{WRT(SLOTB,st1);stn=LDT(2);}
  ROT();
  kload8(kf,kp0+sl_cur);
  WAIT_BAR(1);
  v8i_t vf[2]; v8i_t pw8;
  #define PKW4(P,B) pk8(P[B],P[B+1],P[B+2],P[B+3])
  #define PIN(x) asm volatile("":"+v"(x))
  #define MX3(a,b,c) __builtin_fmaxf(__builtin_fmaxf((a),(b)),(c))
  #define GAPA(MF,A0,A1,A2,A3,W0,W1,PW) do{ MF; sacc+=A0; sacc+=A1; sacc+=A2; sacc+=A3; PIN(sacc); W0; W1; PIN(PW); SBAR(); }while(0)
  #define EX(v) __builtin_amdgcn_exp2f(v)
  #define GAPB(MF,X,B) do{ MF; X[B]=EX(X[B]); X[B+1]=EX(X[B+1]); X[B+2]=EX(X[B+2]); X[B+3]=EX(X[B+3]); PIN(X); SBAR(); }while(0)
  #define VRD8(j) do{ vf[j]=cat8(*(lds_v4p)(vp_+(j)*512),*(lds_v4p)(vp_+(j)*512+1024)); }while(0)
  #define KRD(G,j) do{ if(G){ kload2(kf,kp0+sl_next,j); SBAR(); } }while(0)
  #define STEP(C0,C1,P0,P1,t,GK,GV,GL) do{ SBAR(); \
    const lds_cptr vp_=vp0+sl_prev; \
    VRD8(0); SBAR(); float sacc=(P0[0]+P0[1]); \
    GAPA(C0=qk8(kf[0],qr,negm), P0[2],P0[3],P0[4],P0[5],     pw8[0]=PKW4(P0,0), (void)0, pw8); \
    VRD8(1); SBAR(); GAPA(C1=qk8(kf[1],qr,negm), P0[6],P0[7],P0[8],P0[9],     pw8[1]=PKW4(P0,4), (void)0, pw8); \
    GAPA((void)0,   P0[10],P0[11],P0[12],P0[13], pw8[2]=PKW4(P0,8), (void)0, pw8); \
    GAPA((void)0,   P0[14],P0[15],P1[0],P1[1],   pw8[3]=PKW4(P0,12), (void)0, pw8); \
    GAPA((void)0,   P1[2],P1[3],P1[4],P1[5],     pw8[4]=PKW4(P1,0), (void)0, pw8); \
    GAPA((void)0,   P1[6],P1[7],P1[8],P1[9],     pw8[5]=PKW4(P1,4), (void)0, pw8); \
    GAPA((void)0,   P1[10],P1[11],P1[12],P1[13], pw8[6]=PKW4(P1,8), (void)0, pw8); \
    GAPA((void)0,   P1[14],P1[15],0.f,0.f,       pw8[7]=PKW4(P1,12), (void)0, pw8); \
    l_reg+=sacc; \
    if(kwave){ if(GK){ WRT(sl_cur,stn); if((t)+4<NT) stn=LDT((t)+4); } } else { if(GV){ WRT(sl_next,stn); if((t)+2<NT) stn=LDT((t)+2); } } \
    CMASK(C0,C1,t); \
    { float a=MX3(C0[0],C0[1],C1[0]),b=MX3(C0[2],C0[3],C1[1]); a=MX3(a,C1[2],C1[3]); \
      _Pragma("unroll") for(int r=4;r<16;r+=4){a=MX3(a,C0[r],C0[r+1]);b=MX3(b,C0[r+2],C0[r+3]);a=MX3(a,C1[r],C1[r+1]);b=MX3(b,C1[r+2],C1[r+3]);} \
      float rm=__builtin_fmaxf(a,b); { auto rr=__builtin_amdgcn_permlane32_swap(__float_as_uint(rm),__float_as_uint(rm),false,false); rm=__builtin_fmaxf(__uint_as_float(rr[0]),__uint_as_float(rr[1])); } \
      resc=false; \
      if(__builtin_expect(__any(rm>(float)THRL),0)){ const float dl=__builtin_fmaxf(rm,0.f); mhat+=dl; \
        _Pragma("unroll") for(int r=0;r<16;++r){C0[r]-=dl;C1[r]-=dl;} \
        _Pragma("unroll") for(int r=0;r<16;++r)negm[r]=-mhat; asm volatile("":"+v"(negm)); \
        const float f=__builtin_amdgcn_exp2f(-dl); l_reg*=f; if(hi==0)wsf[r32]=f; resc=true; } } \
    SBAR(); \
    GAPB(o[0]=pv8(pw8,vf[0],o[0]), C0,0); \
    GAPB(o[1]=pv8(pw8,vf[1],o[1]), C0,4); \
    KRD(GL,0); GAPB((void)0, C0,8); \
    KRD(GL,1); GAPB((void)0, C0,12); \
    GAPB((void)0, C1,0); \
    GAPB((void)0, C1,4); \
    GAPB((void)0, C1,8); \
    GAPB((void)0, C1,12); \
    }while(0)
  int t=1;
  #undef CMASK
  #define CMASK(P0,P1,t) do{}while(0)
  for(;t+5<NT;t+=2){
    STEP(pB0,pB1,pA0,pA1,t,true,true,true);     WAIT_BAR(1); RESC(); ROT();
    STEP(pA0,pA1,pB0,pB1,t+1,true,true,true);   WAIT_BAR(1); RESC(); ROT();
  }
  #undef CMASK
  #define CMASK(P0,P1,t) do{}while(0)
  #define ENDW(tt) do{ if((tt)+3<NT){WAIT_BAR(1);} else if((tt)+2<NT){WAIT_BARC(0,1);} else {WAIT_BAR(0);} }while(0)
  for(;t+1<NT;t+=2){
    STEP(pB0,pB1,pA0,pA1,t,(t+3<NT),(t+1<NT),(t+1<NT));       ENDW(t);   RESC(); ROT();
    STEP(pA0,pA1,pB0,pB1,t+1,(t+4<NT),(t+2<NT),(t+2<NT));     ENDW(t+1); RESC(); ROT();
  }
  STEP(pB0,pB1,pA0,pA1,NT-1,false,false,false); RESC();
  { float sacc=pB0[0]+pB0[1]; _Pragma("unroll") for(int r=2;r<16;++r)sacc+=pB0[r]; _Pragma("unroll") for(int r=0;r<16;++r)sacc+=pB1[r]; l_reg+=sacc;
    pw8=(v8i_t){PKW4(pB0,0),PKW4(pB0,4),PKW4(pB0,8),PKW4(pB0,12),PKW4(pB1,0),PKW4(pB1,4),PKW4(pB1,8),PKW4(pB1,12)};
    SBAR(); pv(o,vp0+sl_cur,pw8); }
  #undef PKW4
  #undef PIN
  #undef MX3
  #undef GAPA
  #undef GAPB
  #undef EX
  #undef VRD8
  #undef KRD
  #undef STEP
  #undef ENDW
  {auto rr=__builtin_amdgcn_permlane32_swap(__float_as_uint(l_reg),__float_as_uint(l_reg),false,false);l_reg=__uint_as_float(rr[0])+__uint_as_float(rr[1]);}
  if(hi==0)wsf[32+r32]=l_reg;asm volatile("s_waitcnt lgkmcnt(0)":::"memory");
  float rli[16];
  #pragma unroll
  for(int r=0;r<16;++r)rli[r]=__builtin_amdgcn_rcpf(wsf[32+crow(r,hi)]);
  bf16*Ow=O+(rowbase+q0+wid*QBLK)*OPITCH+h*D;
  { bf16*stg=(bf16*)(shm+LDS_OST)+wid*2048;
    #pragma unroll
    for(int r=0;r<16;++r){const int orow=crow(r,hi);
      #pragma unroll
      for(int d0=0;d0<2;++d0)stg[orow*64+d0*32+r32]=__float2bfloat16(o[d0][r]*rli[r]);}
    asm volatile("s_waitcnt lgkmcnt(0)":::"memory");
    #pragma unroll
    for(int i=0;i<4;++i){const int row=i*8+(lane>>3),ch=lane&7; const u32x4 v=*(const u32x4*)(stg+row*64+ch*8); ATTN_STORE16(Ow+(long)row*OPITCH+ch*8,v);} }
  asm volatile("s_waitcnt lgkmcnt(0)\n\ts_barrier":::"memory");
  #undef LDT
  #undef WRT
  #undef CMASK
  #undef START
  #undef RESC
  #undef ROT
}
__device__ __forceinline__ void attn_unit_fast(int b,int h,int qb,const bf16*Q,const bf16*__restrict__ K,const bf16*__restrict__ V,bf16*O,char*shm){
  const int tid=threadIdx.x,lane=tid&63,r32=lane&31,hi=lane>>5; const int wid=__builtin_amdgcn_readfirstlane(tid>>6);
  const long rowbase=(long)b*SEQ; const int q0=qb*QB;
  const unsigned lds0=(unsigned)(uintptr_t)shm;
  float*wsf=(float*)(shm+LDS_WS)+wid*64;
  const bool kwave=wid<4;
  const unsigned char*sbase=kwave?(const unsigned char*)K+(rowbase*128+(h>>2)*64):(const unsigned char*)V+((size_t)((b*2+(h>>2))*(SEQ/KVBLK))*4096);
  const int svoff=kwave?lane*128+(wid&3)*16:lane*64+(wid&3)*16; const int sstep=kwave?KVBLK*128:4096;
  const __amdgpu_buffer_rsrc_t srs=__builtin_amdgcn_make_buffer_rsrc((void*)sbase,0,0x7fffffff,0x00020000);
  typedef __attribute__((address_space(3))) u32x4* lds_w4p; const lds_w4p sdst=(lds_w4p)((__attribute__((address_space(3))) char*)shm+(kwave?LDS_K:LDS_V)+(wid&3)*1024+lane*16);
  #define LDT(t) __builtin_bit_cast(u32x4,__builtin_amdgcn_raw_buffer_load_b128(srs,svoff,(t)*sstep,0))
  #define WRT(slot,reg) (*(lds_w4p)((__attribute__((address_space(3))) char*)sdst+(slot))=(reg))
  const char*Kbase=shm+LDS_K; v8i_t kf[2];
  const lds_cptr shm3=(lds_cptr)shm; const lds_cptr kp0=shm3+LDS_K+hi*2048+r32*16; const lds_cptr vp0=shm3+LDS_V+hi*2048+r32*16;
  const int NT=SEQ/KVBLK;
  u32x4 st0=LDT(0),st1=LDT(1),st2=LDT(kwave?2:1),st3=LDT(kwave?3:1),stn;
  v8i_t qr;{const unsigned char*q8=(const unsigned char*)Q+((rowbase+q0+wid*QBLK+r32)*512+h*64+hi*32);qr=cat8(*reinterpret_cast<const v4i_t*>(q8),*reinterpret_cast<const v4i_t*>(q8+16));}
  f32x16 o[2];o[0]=f32x16{};o[1]=f32x16{};f32x16 osum=f32x16{};const f32x16 negm=f32x16{};v8i_t ONES8=(v8i_t){0x38383838,0x38383838,0x38383838,0x38383838,0x38383838,0x38383838,0x38383838,0x38383838};asm volatile("":"+v"(ONES8));
  const int qrel=wid*QBLK+r32;
  #define CMASK(P0,P1,t) do{}while(0)
  #define START(P0,P1) do{ _Pragma("unroll") for(int r=0;r<16;++r)P0[r]=__builtin_amdgcn_exp2f(P0[r]); }while(0)
  #define RESC() do{}while(0)
  f32x16 pA0,pA1,pB0,pB1;
  int sl_prev=0,sl_cur=0,sl_next=SLOTB;
  #define ROT() do{sl_prev=sl_cur;sl_cur=sl_next;sl_next=(sl_next==(NSLOT-1)*SLOTB)?0:sl_next+SLOTB;}while(0)
  WRT(0,st0); if(kwave){WRT(SLOTB,st1);WRT(2*SLOTB,st2);}
  WAIT_BARC(3,0);
  qkt(pA0,pA1,Kbase,qr,negm,r32,hi);asm volatile("s_nop 15\n\ts_nop 7":"+v"(pA0),"+v"(pA1));CMASK(pA0,pA1,0);
  START(pA0,pA1);
  _Pragma("unroll") for(int r=0;r<16;++r)pA1[r]=__builtin_amdgcn_exp2f(pA1[r]);
  WAIT_BAR(0);
  if(kwave){WRT(0,st3);stn=LDT(4);}else{WRT(SLOTB,st1);stn=LDT(2);}
  ROT();
  kload8(kf,kp0+sl_cur);
  WAIT_BAR(1);
  v8i_t vf[2]; v8i_t pw8;
  #define PKW4(P,B) pk8(P[B],P[B+1],P[B+2],P[B+3])
  #define PIN(x) asm volatile("":"+v"(x))
  #define MX3(a,b,c) __builtin_fmaxf(__builtin_fmaxf((a),(b)),(c))
  #define GAPA(MF,A0,A1,A2,A3,W0,W1,PW) do{ MF; W0; W1; SBAR(); }while(0)
  #define EX(v) __builtin_amdgcn_exp2f(v)
  #define GAPB(MF,X,B) do{ MF; X[B]=EX(X[B]); X[B+1]=EX(X[B+1]); X[B+2]=EX(X[B+2]); X[B+3]=EX(X[B+3]); SBAR(); }while(0)
  #define VRD8(j) do{ vf[j]=cat8(*(lds_v4p)(vp_+(j)*512),*(lds_v4p)(vp_+(j)*512+1024)); }while(0)
  #define KRD(G,j,SN) do{ if(G){ kload2(kf,kp0+(SN),j); SBAR(); } }while(0)
  #define STEP_(C0,C1,P0,P1,t,GL,SLP,SLN,STG) do{ SBAR(); \
    const lds_cptr vp_=vp0+(SLP); \
    VRD8(0); SBAR(); \
    GAPA(C0=qk8(kf[0],qr,negm), P0[2],P0[3],P0[4],P0[5],     PKASM(pw8[0],P0[0],P0[0+1],P0[0+2],P0[0+3]), (void)0, pw8); \
    VRD8(1); SBAR(); GAPA(C1=qk8(kf[1],qr,negm), P0[6],P0[7],P0[8],P0[9],     PKASM(pw8[1],P0[4],P0[4+1],P0[4+2],P0[4+3]), (void)0, pw8); \
    GAPA((void)0,   P0[10],P0[11],P0[12],P0[13], PKASM(pw8[2],P0[8],P0[8+1],P0[8+2],P0[8+3]), (void)0, pw8); \
    GAPA((void)0,   P0[14],P0[15],P1[0],P1[1],   PKASM(pw8[3],P0[12],P0[12+1],P0[12+2],P0[12+3]), (void)0, pw8); \
    GAPA((void)0,   P1[2],P1[3],P1[4],P1[5],     PKASM(pw8[4],P1[0],P1[0+1],P1[0+2],P1[0+3]), (void)0, pw8); \
    GAPA((void)0,   P1[6],P1[7],P1[8],P1[9],     PKASM(pw8[5],P1[4],P1[4+1],P1[4+2],P1[4+3]), (void)0, pw8); \
    GAPA((void)0,   P1[10],P1[11],P1[12],P1[13], PKASM(pw8[6],P1[8],P1[8+1],P1[8+2],P1[8+3]), (void)0, pw8); \
    GAPA((void)0,   P1[14],P1[15],0.f,0.f,       PKASML(pw8[7],P1[12],P1[12+1],P1[12+2],P1[12+3]), (void)0, pw8); \
    STG; \
    CMASK(C0,C1,t); \
    SBAR(); \
    GAPB(o[0]=pv8(pw8,vf[0],o[0]), C0,0); \
    GAPB(o[1]=pv8(pw8,vf[1],o[1]), C0,4); \
    KRD(GL,0,SLN); GAPB(osum=pv8(pw8,ONES8,osum), C0,8); \
    KRD(GL,1,SLN); GAPB((void)0, C0,12); \
    GAPB((void)0, C1,0); \
    GAPB((void)0, C1,4); \
    GAPB((void)0, C1,8); \
    GAPB((void)0, C1,12); \
    }while(0)
  #define STEP(C0,C1,P0,P1,t,GK,GV,GL) STEP_(C0,C1,P0,P1,t,GL,sl_prev,sl_next, if(kwave){ if(GK){ WRT(sl_cur,stn); if((t)+4<NT) stn=LDT((t)+4); } } else { if(GV){ WRT(sl_next,stn); if((t)+2<NT) stn=LDT((t)+2); } })
  #define STEP6(C0,C1,P0,P1,t,SLP,SLN,WA) STEP_(C0,C1,P0,P1,t,true,SLP,SLN, { *(lds_w4p)(WA)=stn; stn=LDT((t)+kadd); })
  lds_w4p wa0=(lds_w4p)((__attribute__((address_space(3))) char*)sdst+(kwave?1:2)*SLOTB),wa1=(lds_w4p)((__attribute__((address_space(3))) char*)sdst+(kwave?2:0)*SLOTB),wa2=(lds_w4p)((__attribute__((address_space(3))) char*)sdst+(kwave?0:1)*SLOTB);
  asm volatile("":"+v"(wa0),"+v"(wa1),"+v"(wa2));
  const int kadd=kwave?4:2;
  int t=1;
  #undef CMASK
  #define CMASK(P0,P1,t) do{}while(0)
  for(;t+9<NT;t+=6){
    STEP6(pB0,pB1,pA0,pA1,t,  0,2*SLOTB,wa0);       WAIT_BAR(1);
    STEP6(pA0,pA1,pB0,pB1,t+1,SLOTB,0,wa1);         WAIT_BAR(1);
    STEP6(pB0,pB1,pA0,pA1,t+2,2*SLOTB,SLOTB,wa2);   WAIT_BAR(1);
    STEP6(pA0,pA1,pB0,pB1,t+3,0,2*SLOTB,wa0);       WAIT_BAR(1);
    STEP6(pB0,pB1,pA0,pA1,t+4,SLOTB,0,wa1);         WAIT_BAR(1);
    STEP6(pA0,pA1,pB0,pB1,t+5,2*SLOTB,SLOTB,wa2);   WAIT_BAR(1);
  }
  for(;t+5<NT;t+=2){
    STEP(pB0,pB1,pA0,pA1,t,true,true,true);     WAIT_BAR(1); RESC(); ROT();
    STEP(pA0,pA1,pB0,pB1,t+1,true,true,true);   WAIT_BAR(1); RESC(); ROT();
  }
  #undef CMASK
  #define CMASK(P0,P1,t) do{}while(0)
  #define ENDW(tt) do{ if((tt)+3<NT){WAIT_BAR(1);} else if((tt)+2<NT){WAIT_BARC(0,1);} else {WAIT_BAR(0);} }while(0)
  for(;t+1<NT;t+=2){
    STEP(pB0,pB1,pA0,pA1,t,(t+3<NT),(t+1<NT),(t+1<NT));       ENDW(t);   RESC(); ROT();
    STEP(pA0,pA1,pB0,pB1,t+1,(t+4<NT),(t+2<NT),(t+2<NT));     ENDW(t+1); RESC(); ROT();
  }
  STEP(pB0,pB1,pA0,pA1,NT-1,false,false,false); RESC();
  {
    pw8=(v8i_t){PKW4(pB0,0),PKW4(pB0,4),PKW4(pB0,8),PKW4(pB0,12),PKW4(pB1,0),PKW4(pB1,4),PKW4(pB1,8),PKW4(pB1,12)};
    SBAR(); pv(o,vp0+sl_cur,pw8); osum=pv8(pw8,ONES8,osum); }
  #undef PKW4
  #undef PIN
  #undef MX3
  #undef GAPA
  #undef GAPB
  #undef EX
  #undef VRD8
  #undef KRD
  #undef STEP
  #undef STEP_
  #undef STEP6
  #undef ENDW
  float rli[16];
  #pragma unroll
  for(int r=0;r<16;++r)rli[r]=__builtin_amdgcn_rcpf(osum[r]);
  bf16*Ow=O+(rowbase+q0+wid*QBLK)*OPITCH+h*D;
  { bf16*stg=(bf16*)(shm+LDS_OST)+wid*2048;
    #pragma unroll
    for(int r=0;r<16;++r){const int orow=crow(r,hi);
      #pragma unroll
      for(int d0=0;d0<2;++d0)stg[orow*64+d0*32+r32]=__float2bfloat16(o[d0][r]*rli[r]);}
    asm volatile("s_waitcnt lgkmcnt(0)":::"memory");
    #pragma unroll
    for(int i=0;i<4;++i){const int row=i*8+(lane>>3),ch=lane&7; const u32x4 v=*(const u32x4*)(stg+row*64+ch*8); ATTN_STORE16(Ow+(long)row*OPITCH+ch*8,v);} }
  asm volatile("s_waitcnt lgkmcnt(0)\n\ts_barrier":::"memory");
  #undef LDT
  #undef WRT
  #undef CMASK
  #undef START
  #undef RESC
  #undef ROT
}
constexpr int ATTN_LDS_BYTES=LDS_BYTES;
struct AttnTensors { const bf16* Q; const bf16* K; const bf16* V; bf16* O; };
struct AttnUnit { int bh; int qb; };
struct StaticOrder {
  int vcu;
  __device__ __forceinline__ explicit StaticOrder(int grid,int block):vcu((block%8)*(grid/8)+block/8){}
  __device__ __forceinline__ bool next(int i,AttnUnit&u)const{ if(i>=4)return false; const int s=vcu&7; u.bh=vcu>>3; u.qb=(i==0)?s:(i==1)?15-s:(i==2)?16+s:31-s; return true; }
  __device__ __forceinline__ void a_ready(const AttnUnit&)const{}
  __device__ __forceinline__ void done(const AttnUnit&)const{}
};
template<class Sched,int THRL=8> __device__ __forceinline__ void attn_phase(char*lds,const AttnTensors&T,const Sched&S,bool fast){
  AttnUnit u;
  if(fast){ for(int i=0;S.next(i,u);++i){ S.a_ready(u); attn_unit_fast(u.bh/NHEAD,u.bh%NHEAD,u.qb,T.Q,T.K,T.V,T.O,lds); S.done(u); } }
  else { for(int i=0;S.next(i,u);++i){ S.a_ready(u); attn_unit<THRL>(u.bh/NHEAD,u.bh%NHEAD,u.qb,T.Q,T.K,T.V,T.O,lds); S.done(u); } }
}
#undef SBAR
#undef WAIT_BAR
}

constexpr int NWAVES = 8;
#ifndef MK_N_LAUNCHES
#define MK_N_LAUNCHES 1
#endif
constexpr int N_LAUNCHES = MK_N_LAUNCHES;
constexpr int PER_PHASE = 7;

constexpr int BATCH = 4, T = 8192, D = 1024;
constexpr int M = BATCH * T;
constexpr int NIN = 1792;
constexpr int NPQ = 2048;
constexpr int NEXP = 16384;
constexpr float RMS_EPS = 1e-6f;

constexpr size_t MiB = 1u << 20;
constexpr size_t WS_CTL = 0, CTL_ZERO_BYTES = 64 * 1024;
constexpr size_t WS_WIN = 2 * MiB, WS_WOUT = 6 * MiB, WS_WQ = 8 * MiB;
constexpr size_t WS_KEYS = 12 * MiB, WS_SU = 12 * MiB + 512 * 1024, WS_ROPE = 13 * MiB, WS_IG1 = 13 * MiB + 64 * 1024, WS_RSI = 13 * MiB + 128 * 1024, WS_SS = 14 * MiB;
constexpr size_t WS_UT = 16 * MiB, WS_VT = 48 * MiB;
constexpr size_t WS_XN = 80 * MiB;
constexpr size_t WS_XQ = 144 * MiB;
constexpr size_t WS_V8T = 180 * MiB;
constexpr size_t WS_Q = 144 * MiB, WS_K = 176 * MiB, WS_V = 184 * MiB, WS_H = 192 * MiB;
constexpr size_t WS_SUO = 192 * MiB;
constexpr size_t WS_MIX = 224 * MiB;
constexpr size_t WS_QP = 288 * MiB;
constexpr size_t WS_IDX = 416 * MiB, WS_GATE = 424 * MiB, WS_END = 440 * MiB;
constexpr int CW_TMO = 0, CW_CODE = 1;
constexpr int CW_BAR = 4096;
constexpr int RING_OFF = 0, RING_BYTES = 131072;
constexpr int LDSCTL_OFF = RING_BYTES, MISC_OFF = LDSCTL_OFF + 320;
constexpr int LDS_BYTES = 147456;
static_assert(MISC_OFF + 128 <= LDS_BYTES, "LDS map");
#define GAS __attribute__((address_space(1)))
#define LAS __attribute__((address_space(3)))
typedef unsigned short bf16;
typedef unsigned v4u __attribute__((ext_vector_type(4)));
typedef float f32x4 __attribute__((ext_vector_type(4)));
typedef short bf16x8 __attribute__((ext_vector_type(8)));
typedef GAS unsigned gu32;
typedef GAS unsigned long long gu64;
#define RLX_AGENT __ATOMIC_RELAXED, __HIP_MEMORY_SCOPE_AGENT
#define LDS_WAIT() asm volatile("s_waitcnt lgkmcnt(0)" ::: "memory")
#define VM_WAIT() asm volatile("s_waitcnt vmcnt(0)" ::: "memory")
__device__ __forceinline__ unsigned long long rt() { return __builtin_amdgcn_s_memrealtime(); }
__device__ __forceinline__ unsigned f2bf(float f) { unsigned u = __builtin_bit_cast(unsigned, f); return (u + 0x7fffu + ((u >> 16) & 1u)) >> 16; }
__device__ __forceinline__ unsigned pk2(float lo, float hi) { return f2bf(lo) | (f2bf(hi) << 16); }

#define XB_TMO      128
#define XB_XCNT(j)  (256  + 64 * (j))
#define XB_XSUB(j)  (1280 + 64 * (j))
#define XB_XGEN(j)  (2304 + 64 * (j))
#define XB_TOP      3328
#define XB_TOPGEN   3392
#define XCD_BAR_WORDS 3456
#define XB_SPIN_CAP (1u << 18)

__device__ __forceinline__ unsigned xb_ld(unsigned* p)              { return __hip_atomic_load(p, __ATOMIC_RELAXED, __HIP_MEMORY_SCOPE_AGENT); }
__device__ __forceinline__ unsigned xb_add(unsigned* p, unsigned v) { return __hip_atomic_fetch_add(p, v, __ATOMIC_RELAXED, __HIP_MEMORY_SCOPE_AGENT); }
__device__ __forceinline__ unsigned xb_xcc_id() { return (unsigned)__builtin_amdgcn_s_getreg((3 << 11) | 20) & 0xFu; }
#define XB_SPIN(cond, bar) do { unsigned _sp = 0; while (cond) { __builtin_amdgcn_s_sleep(1); \
    if ((++_sp & 255u) == 0u) { if (xb_ld(&(bar)[XB_TMO])) break; if (_sp > XB_SPIN_CAP) { atomicAdd(&(bar)[XB_TMO], 1u); break; } } } } while (0)

#ifndef BAR_EARLY_WB
#define BAR_EARLY_WB 0
#endif
struct XcdBarrier {
    unsigned* bar; unsigned x;
    volatile LAS unsigned* st;
};

__device__ __forceinline__ XcdBarrier xcd_barrier_post(unsigned* bar, volatile LAS unsigned* st) {
    XcdBarrier b; b.bar = bar; b.x = xb_xcc_id(); b.st = st;
    if (threadIdx.x == 0) (void)xb_add(&bar[XB_XCNT(b.x)], 1u);
    return b;
}
__device__ __forceinline__ void xcd_barrier_complete(unsigned* bar, unsigned x, unsigned& nloc, unsigned& nx) {
    const unsigned G = gridDim.x * gridDim.y * gridDim.z;
    unsigned sum, cnt, mine, sp = 0u;
    for (;;) {
        sum = 0u; cnt = 0u; mine = 0u;
#pragma unroll
        for (unsigned j = 0; j < 16; ++j) { const unsigned c = xb_ld(&bar[XB_XCNT(j)]); sum += c; cnt += (c > 0u) ? 1u : 0u; mine = (j == x) ? c : mine; }
        if (sum == G) break;
        __builtin_amdgcn_s_sleep(1);
        if ((++sp & 255u) == 0u) { if (xb_ld(&bar[XB_TMO])) break; if (sp > XB_SPIN_CAP) { atomicAdd(&bar[XB_TMO], 1u); break; } }
    }
    nloc = mine > 0u ? mine : 1u; nx = cnt > 0u ? cnt : 1u;
}

__device__ __forceinline__ void xcd_barrier(const XcdBarrier& b) {
    asm volatile("s_waitcnt vmcnt(0)" ::: "memory");
    __syncthreads();
    if (threadIdx.x == 0) {
        unsigned* bar = b.bar;
        __builtin_amdgcn_s_waitcnt(0);
        unsigned nloc = b.st[0], nx = b.st[1];
        if (nloc == 0u) { xcd_barrier_complete(bar, b.x, nloc, nx); b.st[0] = nloc; b.st[1] = nx; }
#if BAR_EARLY_WB
        __builtin_amdgcn_fence(__ATOMIC_RELEASE, "agent");
        asm volatile("s_waitcnt vmcnt(0)" ::: "memory");
#endif
        const unsigned old = xb_add(&bar[XB_XSUB(b.x)], 1u);
        const unsigned gen = old / nloc;
        if (old + 1u == (gen + 1u) * nloc) {
            __builtin_amdgcn_fence(__ATOMIC_RELEASE, "agent");
            asm volatile("s_waitcnt vmcnt(0)" ::: "memory");
            const unsigned og = xb_add(&bar[XB_TOP], 1u);
            const unsigned tg = og / nx;
            if (og + 1u == (tg + 1u) * nx) xb_add(&bar[XB_TOPGEN], 1u);
            else XB_SPIN(xb_ld(&bar[XB_TOPGEN]) == tg, bar);
            __builtin_amdgcn_fence(__ATOMIC_ACQUIRE, "agent");
            xb_add(&bar[XB_XGEN(b.x)], 1u);
            asm volatile("s_waitcnt vmcnt(0)" ::: "memory");
        } else {
            XB_SPIN(xb_ld(&bar[XB_XGEN(b.x)]) == gen, bar);
            __builtin_amdgcn_fence(__ATOMIC_ACQUIRE, "agent");
            asm volatile("s_waitcnt vmcnt(0)" ::: "memory");
        }
    }
    __syncthreads();
}

struct Frame {
    LAS unsigned char* lds;
    volatile LAS unsigned* MISC;
    gu32* ctl;
    int tid, lane, wave;
    int vcu, G;
    const float* in[16]; float* out; unsigned char* ws;
};

typedef __bf16 bf16x2_dg __attribute__((ext_vector_type(2)));
__device__ __forceinline__ float dot2bf_(unsigned a, unsigned b, float c) { return __builtin_amdgcn_fdot2_f32_bf16(__builtin_bit_cast(bf16x2_dg, a), __builtin_bit_cast(bf16x2_dg, b), c, false); }
__device__ __forceinline__ float wave_sum(float v) {
#pragma unroll
    for (int o = 1; o < 64; o <<= 1) v += __shfl_xor(v, o);
    return v;
}
__device__ __forceinline__ int win_src_col(int rho) {
    const int pn = rho >> 8, bj = (rho >> 7) & 1, wc = (rho >> 5) & 3, fq = (rho >> 3) & 3, n = (rho >> 2) & 1, e = rho & 3;
    if (pn < 2) return 64 * (4 * pn + wc) + 32 * bj + 16 * n + 4 * fq + e;
    if (pn == 2) { if (wc < 2) return 512 + 64 * wc + 32 * bj + 16 * n + 4 * fq + e; return 640 + 64 * (wc - 2) + 32 * bj + 8 * fq + 4 * n + e; }
    const int c = 128 * (pn - 3) + 32 * wc + 8 * fq + 4 * n + e;
    return (bj ? 1280 : 768) + c;
}
template <bool PERMW>
__device__ __forceinline__ void p0_transpose_item(const float* W, int K, int N, const float* ks, bf16* WT, LAS float* scr, int item, int lane) {
    const int nblk = N / 32, kb = item / nblk, nb = item % nblk, k0 = 64 * kb, n0 = 32 * nb;
    const int sc = PERMW ? win_src_col(n0 + (lane & 31)) : (n0 + (lane & 31));
#pragma unroll 8
    for (int i = 0; i < 32; ++i) { const int kk = 2 * i + (lane >> 5); float v = W[(size_t)(k0 + kk) * N + sc]; if (ks) v *= ks[k0 + kk]; scr[kk * 33 + (lane & 31)] = v; }
    LDS_WAIT(); asm volatile("" ::: "memory");
    const int c = lane & 7;
#pragma unroll
    for (int j = 0; j < 4; ++j) { const int n = (lane >> 3) + 8 * j; const LAS float* s = scr + (8 * c) * 33 + n;
        v4u o; o.x = pk2(s[0 * 33], s[1 * 33]); o.y = pk2(s[2 * 33], s[3 * 33]); o.z = pk2(s[4 * 33], s[5 * 33]); o.w = pk2(s[6 * 33], s[7 * 33]);
        *(GAS v4u*)(WT + (size_t)(n0 + n) * K + k0 + 8 * c) = o; }
    LDS_WAIT(); asm volatile("" ::: "memory");
}
template <int NR>
__device__ __forceinline__ void rms_rows_load(f32x4 (&v)[NR][4], int lane, const float* x, int row0, int rstride) {
#pragma unroll
    for (int r = 0; r < NR; ++r) { const GAS f32x4* xr = (const GAS f32x4*)(x + (size_t)(row0 + r * rstride) * D) + lane;
#pragma unroll
        for (int j = 0; j < 4; ++j) v[r][j] = xr[64 * j]; }
}
template <int NR>
__device__ __forceinline__ void rms_rows_finish(const f32x4 (&v)[NR][4], const f32x4 (&gg)[4], int lane, bf16* o, float* rsi, int row0, int rstride) {
#pragma unroll
    for (int r = 0; r < NR; ++r) { float s = 0.f;
#pragma unroll
        for (int j = 0; j < 4; ++j) s += (v[r][j].x * v[r][j].x + v[r][j].y * v[r][j].y) + (v[r][j].z * v[r][j].z + v[r][j].w * v[r][j].w);
        const float rms = sqrtf(wave_sum(s) * (1.f / D) + RMS_EPS), rstd = 1.f / rms;
        if (lane == 0) rsi[row0 + r * rstride] = rms;
        GAS unsigned long long* o8 = (GAS unsigned long long*)(o + (size_t)(row0 + r * rstride) * D) + lane;
#pragma unroll
        for (int j = 0; j < 4; ++j) o8[64 * j] = (unsigned long long)pk2(v[r][j].x * rstd * gg[j].x, v[r][j].y * rstd * gg[j].y) | ((unsigned long long)pk2(v[r][j].z * rstd * gg[j].z, v[r][j].w * rstd * gg[j].w) << 32); }
}
__device__ __forceinline__ unsigned pack_i8x4(const f32x4 v) {
    unsigned w = 0u;
    w = __builtin_amdgcn_cvt_pk_u8_f32(__builtin_rintf(v.x) + 128.0f, 0u, w); w = __builtin_amdgcn_cvt_pk_u8_f32(__builtin_rintf(v.y) + 128.0f, 1u, w);
    w = __builtin_amdgcn_cvt_pk_u8_f32(__builtin_rintf(v.z) + 128.0f, 2u, w); w = __builtin_amdgcn_cvt_pk_u8_f32(__builtin_rintf(v.w) + 128.0f, 3u, w);
    return w ^ 0x80808080u;
}
__device__ __forceinline__ void expert_rows_load(f32x4 (&a)[4][4], const float* pu, const float* pv, int e0, int nw, int lane) {
#pragma unroll
    for (int r = 0; r < 4; ++r) { const int e = e0 + (r >> 1) * nw; const GAS f32x4* src = (const GAS f32x4*)(((r & 1) ? pv : pu) + (size_t)e * D + 16 * lane);
#pragma unroll
        for (int q = 0; q < 4; ++q) a[r][q] = src[q]; }
}
__device__ __forceinline__ void expert_rows_finish(f32x4 (&a)[4][4], const f32x4 (&gq)[4], unsigned char* ut, unsigned char* vt, float* suv, int e0, int nw, int lane) {
#pragma unroll
    for (int r = 0; r < 4; ++r) { const int e = e0 + (r >> 1) * nw; const bool isv = (r & 1) != 0; float amax = 0.f;
#pragma unroll
        for (int q = 0; q < 4; ++q) { if (!isv) a[r][q] = a[r][q] * gq[q];
            amax = fmaxf(amax, fmaxf(fmaxf(fabsf(a[r][q].x), fabsf(a[r][q].y)), fmaxf(fabsf(a[r][q].z), fabsf(a[r][q].w)))); }
#pragma unroll
        for (int o = 1; o < 64; o <<= 1) amax = fmaxf(amax, __shfl_xor(amax, o));
        const float scale = amax > 0.f ? amax * (1.0f / 127.0f) : 1.0f, inv = amax > 0.f ? 127.0f / amax : 0.f;
        v4u o4;
#pragma unroll
        for (int q = 0; q < 4; ++q) o4[q] = pack_i8x4(a[r][q] * inv);
        const int sl = lane >> 3, mm = lane & 7;
        if (!isv) *(GAS v4u*)(ut + ((size_t)sl * NEXP + e) * 128 + (size_t)mm * 16) = o4;
        else {
            typedef unsigned v2u_t __attribute__((ext_vector_type(2)));
            const v2u_t ev = (v2u_t){__builtin_amdgcn_perm(o4[1], o4[0], 0x06040200u), __builtin_amdgcn_perm(o4[3], o4[2], 0x06040200u)}, od = (v2u_t){__builtin_amdgcn_perm(o4[1], o4[0], 0x07050301u), __builtin_amdgcn_perm(o4[3], o4[2], 0x07050301u)};
            unsigned char* row = vt + ((size_t)sl * NEXP + e) * 128 + (size_t)(mm >> 1) * 32 + (size_t)(mm & 1) * 8;
            *(GAS v2u_t*)row = ev; *(GAS v2u_t*)(row + 16) = od; }
        if (lane == 0) suv[2 * e + (isv ? 1 : 0)] = scale; }
}
__device__ __forceinline__ void expert_tables(Frame& F, int e_lo, int e_hi, int wi, int nw) {
    const float* pu = F.in[13]; const float* pv = F.in[14]; const float* norm2_g = F.in[10]; unsigned char* ut = F.ws + WS_UT; unsigned char* vt = F.ws + WS_VT; float* suv = (float*)(F.ws + WS_SU);
    const GAS f32x4* sg = (const GAS f32x4*)(norm2_g + 16 * F.lane); f32x4 gq[4];
#pragma unroll
    for (int q = 0; q < 4; ++q) gq[q] = sg[q];
    f32x4 aA[4][4], aB[4][4]; const int step = 2 * nw;
    int e0 = e_lo + wi;
    if (e0 < e_hi) expert_rows_load(aA, pu, pv, e0, nw, F.lane);
    for (; e0 < e_hi; e0 += 2 * step) {
        const bool n1 = e0 + step < e_hi;
        if (n1) expert_rows_load(aB, pu, pv, e0 + step, nw, F.lane);
        expert_rows_finish(aA, gq, ut, vt, suv, e0, nw, F.lane);
        if (e0 + 2 * step < e_hi) expert_rows_load(aA, pu, pv, e0 + 2 * step, nw, F.lane);
        if (n1) expert_rows_finish(aB, gq, ut, vt, suv, e0 + step, nw, F.lane);
    }
}
__device__ __forceinline__ void p0_prologue(Frame& F) {
    LAS float* scr = (LAS float*)(F.lds + RING_OFF + F.wave * 16384);
    const int gw = F.vcu * NWAVES + F.wave, NGW = F.G * NWAVES;
    const float* w_in = F.in[2]; const float* w_out = F.in[9]; const float* peer_wq = F.in[11]; const float* norm2_g = F.in[10];
    constexpr int I_IN = (D / 64) * (NIN / 32), I_OUT = (D / 64) * (D / 32), I_WQ = (D / 64) * (NPQ / 32);
    constexpr int NITEMS = I_IN + I_OUT + I_WQ;
    for (int it = gw; it < NITEMS; it += NGW) {
        int r = it;
        if (r < I_IN) { p0_transpose_item<true>(w_in, D, NIN, nullptr, (bf16*)(F.ws + WS_WIN), scr, r, F.lane); continue; } r -= I_IN;
        if (r < I_OUT) { p0_transpose_item<false>(w_out, D, D, nullptr, (bf16*)(F.ws + WS_WOUT), scr, r, F.lane); continue; } r -= I_OUT;
        p0_transpose_item<false>(peer_wq, D, NPQ, norm2_g, (bf16*)(F.ws + WS_WQ), scr, r, F.lane);
    }
    const int gt = F.vcu * (NWAVES * 64) + F.tid, NGT = F.G * NWAVES * 64;
    { float* ig = (float*)(F.ws + WS_IG1); for (int i = gt; i < D; i += NGT) ig[i] = 1.0f / F.in[1][i]; }
    { const float* pk = F.in[12]; bf16* kb = (bf16*)(F.ws + WS_KEYS);
      for (int i = gt; i < 2 * 128 * 128 / 2; i += NGT) { const float a = pk[2 * i], b = pk[2 * i + 1]; ((GAS unsigned*)kb)[i] = pk2(a, b); } }
    { float* rt_ = (float*)(F.ws + WS_ROPE);
      for (int i = gt; i < 128 * 16; i += NGT) { const int pos = i >> 4, k = i & 15; const float inv = powf(10000.0f, -(float)k / 16.0f); const float ang = (float)pos * inv; float s, c; sincosf(ang, &s, &c); rt_[2 * i] = c; rt_[2 * i + 1] = s; } }
    expert_tables(F, 0, NEXP, gw, NGW);
    {
        f32x4 gg[4];
#pragma unroll
        for (int j = 0; j < 4; ++j) gg[j] = ((const GAS f32x4*)F.in[1] + F.lane)[64 * j];
        f32x4 vA[4][4], vB[4][4]; const int step = 4 * NGW; bf16* xn = (bf16*)(F.ws + WS_XN); float* rsi = (float*)(F.ws + WS_RSI);
        int m = gw;
        if (m < M) rms_rows_load<4>(vA, F.lane, F.in[0], m, NGW);
        for (; m < M; m += 2 * step) {
            const bool n1 = m + step < M;
            if (n1) rms_rows_load<4>(vB, F.lane, F.in[0], m + step, NGW);
            rms_rows_finish<4>(vA, gg, F.lane, xn, rsi, m, NGW);
            if (m + 2 * step < M) rms_rows_load<4>(vA, F.lane, F.in[0], m + 2 * step, NGW);
            if (n1) rms_rows_finish<4>(vB, gg, F.lane, xn, rsi, m + step, NGW);
        }
    }
}

__device__ __forceinline__ void v8t_phase(Frame& F) {
    const bf16* V = (const bf16*)(F.ws + WS_V); unsigned char* V8T = F.ws + WS_V8T;
    LAS unsigned char* sl = F.lds + RING_OFF + F.wave * 16384;
    const int gw = F.vcu * NWAVES + F.wave, NGW = F.G * NWAVES, lane = F.lane;
    for (int tile = gw; tile < BATCH * 2 * (T / 64); tile += NGW) {
        const int b = tile >> 8, hk = (tile >> 7) & 1, t = tile & 127;
        const GAS v4u* src = (const GAS v4u*)(V + (size_t)(b * T + t * 64 + lane) * 128 + hk * 64);
        v4u x[8];
#pragma unroll
        for (int i = 0; i < 8; ++i) x[i] = src[i];
#pragma unroll
        for (int i = 0; i < 8; ++i) { const unsigned w[4] = {x[i].x, x[i].y, x[i].z, x[i].w}; unsigned o2[2];
#pragma unroll
            for (int e = 0; e < 2; ++e) { int pk = 0;
                pk = __builtin_amdgcn_cvt_pk_fp8_f32(__uint_as_float(w[2 * e] << 16), __uint_as_float(w[2 * e] & 0xffff0000u), pk, false);
                pk = __builtin_amdgcn_cvt_pk_fp8_f32(__uint_as_float(w[2 * e + 1] << 16), __uint_as_float(w[2 * e + 1] & 0xffff0000u), pk, true); o2[e] = (unsigned)pk; }
            *(LAS unsigned*)(sl + lane * 68 + 8 * i) = o2[0]; *(LAS unsigned*)(sl + lane * 68 + 8 * i + 4) = o2[1]; }
        unsigned o[16];
#pragma unroll
        for (int q = 0; q < 16; ++q) { unsigned wv = 0u;
#pragma unroll
            for (int e = 0; e < 4; ++e) { const int sidx = 4 * q + e, hh = sidx >> 5, j = sidx & 31, r = j & 15;
                const int key = ((j < 16) ? 0 : 32) + (r & 3) + 8 * (r >> 2) + 4 * hh;
                wv |= (unsigned)sl[key * 68 + lane] << (8 * e); }
            o[q] = wv; }
        GAS v4u* dst = (GAS v4u*)(V8T + (size_t)tile * 4096 + lane * 64);
#pragma unroll
        for (int q = 0; q < 4; ++q) dst[q] = (v4u){o[4 * q], o[4 * q + 1], o[4 * q + 2], o[4 * q + 3]};
    }
    __syncthreads();
}

__device__ __forceinline__ void conv_phase(Frame& F) {
    const bf16* H = (const bf16*)(F.ws + WS_H); bf16* MIX = (bf16*)(F.ws + WS_MIX);
    const float* cw = F.in[5]; const float* cb = F.in[6]; const float* lg = F.in[7]; const float* lb = F.in[8];
    LAS unsigned short* hs = (LAS unsigned short*)(F.lds + RING_OFF);
    LAS float* co = (LAS float*)(F.lds + RING_OFF + 63488);
    const int c = F.tid;
    float w[31];
#pragma unroll
    for (int j = 0; j < 31; ++j) w[j] = cw[j * 512 + c];
    const float bias = cb[c];
    constexpr int NT_ = M / 32;
    v4u hreg[8];
#define CONV_LOADH(tile_) do { const int t0_ = (tile_) * 32, tb_ = t0_ & ~(T - 1); _Pragma("unroll") for (int q_ = 0; q_ < 8; ++q_) { const int i_ = F.tid + q_ * (NWAVES * 64); const int r_ = i_ >> 6, ch_ = i_ & 63, tk_ = t0_ - 15 + r_; \
        hreg[q_] = (v4u){0u, 0u, 0u, 0u}; if (i_ < 62 * 64 && tk_ >= tb_ && tk_ < tb_ + T) hreg[q_] = *(const GAS v4u*)(H + (size_t)tk_ * 512 + ch_ * 8); } } while (0)
    if (F.vcu < NT_) CONV_LOADH(F.vcu);
    for (int tile = F.vcu; tile < NT_; tile += F.G) {
        const int t0 = tile * 32;
#pragma unroll
        for (int q = 0; q < 8; ++q) { const int i = F.tid + q * (NWAVES * 64); if (i < 62 * 64) *(LAS v4u*)(hs + (i >> 6) * 512 + (i & 63) * 8) = hreg[q]; }
        __syncthreads();
        if (tile + F.G < NT_) CONV_LOADH(tile + F.G);
#pragma unroll 1
        for (int g = 0; g < 4; ++g) {
            float hv[38];
#pragma unroll
            for (int r = 0; r < 38; ++r) hv[r] = __uint_as_float((unsigned)hs[(g * 8 + r) * 512 + c] << 16);
#pragma unroll
            for (int tt = 0; tt < 8; ++tt) { float a = bias;
#pragma unroll
                for (int j = 0; j < 31; ++j) a += w[j] * hv[tt + j];
                co[(g * 8 + tt) * 512 + c] = a; }
        }
        __syncthreads();
#pragma unroll 1
        for (int q = 0; q < 4; ++q) { const int tt = F.wave * 4 + q;
            const f32x4 a = *(const LAS f32x4*)(co + tt * 512 + 8 * F.lane), b = *(const LAS f32x4*)(co + tt * 512 + 8 * F.lane + 4);
            const float mean = wave_sum((a.x + a.y) + (a.z + a.w) + (b.x + b.y) + (b.z + b.w)) * (1.f / 512.f);
            const f32x4 da = a - mean, db = b - mean;
            const float var = wave_sum((da.x * da.x + da.y * da.y) + (da.z * da.z + da.w * da.w) + (db.x * db.x + db.y * db.y) + (db.z * db.z + db.w * db.w)) * (1.f / 512.f);
            const float rstd = 1.f / sqrtf(var + RMS_EPS);
            const f32x4 g0 = *(const GAS f32x4*)(lg + 8 * F.lane), g1 = *(const GAS f32x4*)(lg + 8 * F.lane + 4), b0 = *(const GAS f32x4*)(lb + 8 * F.lane), b1 = *(const GAS f32x4*)(lb + 8 * F.lane + 4);
            f32x4 y0 = da * rstd * g0 + b0, y1 = db * rstd * g1 + b1;
#pragma unroll
            for (int e = 0; e < 4; ++e) { y0[e] = y0[e] * __builtin_amdgcn_rcpf(1.f + __builtin_amdgcn_exp2f(-1.4426950408889634f * y0[e])); y1[e] = y1[e] * __builtin_amdgcn_rcpf(1.f + __builtin_amdgcn_exp2f(-1.4426950408889634f * y1[e])); }
            v4u o; o.x = pk2(y0.x, y0.y); o.y = pk2(y0.z, y0.w); o.z = pk2(y1.x, y1.y); o.w = pk2(y1.z, y1.w);
            *(GAS v4u*)(MIX + (size_t)(t0 + tt) * 1024 + 512 + 8 * F.lane) = o; }
        __syncthreads();
    }
}

__device__ __forceinline__ unsigned f2sort(float x) { const unsigned u = __float_as_uint(x); return (u & 0x80000000u) ? ~u : (u | 0x80000000u); }
__device__ __forceinline__ float sort2f(unsigned s) { const unsigned u = (s & 0x80000000u) ? (s & 0x7fffffffu) : ~s; return __uint_as_float(u); }
template <bool DESC> __device__ __forceinline__ void ce(unsigned& a, unsigned& b) { const unsigned hi = a > b ? a : b, lo = a > b ? b : a; if (DESC) { a = hi; b = lo; } else { a = lo; b = hi; } }
template <int K, int J, bool DESC> __device__ __forceinline__ void bst(unsigned (&a)[16]) {
#pragma unroll
    for (int i = 0; i < 16; ++i) { const int l = i ^ J; if (l > i) { if (((i & K) == 0) == DESC) ce<true>(a[i], a[l]); else ce<false>(a[i], a[l]); } }
}
template <bool DESC> __device__ __forceinline__ void sort16(unsigned (&a)[16]) { ce<DESC>(a[0], a[1]); ce<DESC>(a[2], a[3]); ce<DESC>(a[0], a[2]); ce<DESC>(a[1], a[3]); ce<DESC>(a[1], a[2]); ce<DESC>(a[4], a[5]); ce<DESC>(a[6], a[7]); ce<DESC>(a[4], a[6]); ce<DESC>(a[5], a[7]); ce<DESC>(a[5], a[6]); ce<DESC>(a[0], a[4]); ce<DESC>(a[2], a[6]); ce<DESC>(a[2], a[4]); ce<DESC>(a[1], a[5]); ce<DESC>(a[3], a[7]); ce<DESC>(a[3], a[5]); ce<DESC>(a[1], a[2]); ce<DESC>(a[3], a[4]); ce<DESC>(a[5], a[6]); ce<DESC>(a[8], a[9]); ce<DESC>(a[10], a[11]); ce<DESC>(a[8], a[10]); ce<DESC>(a[9], a[11]); ce<DESC>(a[9], a[10]); ce<DESC>(a[12], a[13]); ce<DESC>(a[14], a[15]); ce<DESC>(a[12], a[14]); ce<DESC>(a[13], a[15]); ce<DESC>(a[13], a[14]); ce<DESC>(a[8], a[12]); ce<DESC>(a[10], a[14]); ce<DESC>(a[10], a[12]); ce<DESC>(a[9], a[13]); ce<DESC>(a[11], a[15]); ce<DESC>(a[11], a[13]); ce<DESC>(a[9], a[10]); ce<DESC>(a[11], a[12]); ce<DESC>(a[13], a[14]); ce<DESC>(a[0], a[8]); ce<DESC>(a[4], a[12]); ce<DESC>(a[4], a[8]); ce<DESC>(a[2], a[10]); ce<DESC>(a[6], a[14]); ce<DESC>(a[6], a[10]); ce<DESC>(a[2], a[4]); ce<DESC>(a[6], a[8]); ce<DESC>(a[10], a[12]); ce<DESC>(a[1], a[9]); ce<DESC>(a[5], a[13]); ce<DESC>(a[5], a[9]); ce<DESC>(a[3], a[11]); ce<DESC>(a[7], a[15]); ce<DESC>(a[7], a[11]); ce<DESC>(a[3], a[5]); ce<DESC>(a[7], a[9]); ce<DESC>(a[11], a[13]); ce<DESC>(a[1], a[2]); ce<DESC>(a[3], a[4]); ce<DESC>(a[5], a[6]); ce<DESC>(a[7], a[8]); ce<DESC>(a[9], a[10]); ce<DESC>(a[11], a[12]); ce<DESC>(a[13], a[14]); }
template <bool DESC> __device__ __forceinline__ void merge16(unsigned (&a)[16]) { bst<16, 8, DESC>(a); bst<16, 4, DESC>(a); bst<16, 2, DESC>(a); bst<16, 1, DESC>(a); }
__device__ __forceinline__ void max16(unsigned (&a)[16], const unsigned (&b)[16]) {
#pragma unroll
    for (int i = 0; i < 16; ++i) a[i] = a[i] > b[i] ? a[i] : b[i];
}
__device__ __forceinline__ void top16_of_128(unsigned (&g)[8][16]) {
    sort16<true>(g[0]); sort16<false>(g[1]); sort16<true>(g[2]); sort16<false>(g[3]); sort16<true>(g[4]); sort16<false>(g[5]); sort16<true>(g[6]); sort16<false>(g[7]);
    max16(g[0], g[1]); merge16<true>(g[0]); max16(g[2], g[3]); merge16<false>(g[2]); max16(g[4], g[5]); merge16<true>(g[4]); max16(g[6], g[7]); merge16<false>(g[6]);
    max16(g[0], g[2]); merge16<true>(g[0]); max16(g[4], g[6]); merge16<false>(g[4]);
    max16(g[0], g[4]); merge16<true>(g[0]);
}
__device__ __forceinline__ void top16_of_64(unsigned (&g)[4][16]) {
    sort16<true>(g[0]); sort16<false>(g[1]); sort16<true>(g[2]); sort16<false>(g[3]);
    max16(g[0], g[1]); merge16<true>(g[0]); max16(g[2], g[3]); merge16<false>(g[2]);
    max16(g[0], g[2]); merge16<true>(g[0]);
}

constexpr int P5_KEYS_BYTES = 65536, P5_SCR_OFF = 65536;
typedef float f32x2p5 __attribute__((ext_vector_type(2)));
__device__ __forceinline__ void topk_phase(Frame& F) {
    typedef float f32x16 __attribute__((ext_vector_type(16)));
    const bf16* QP = (const bf16*)(F.ws + WS_QP); const bf16* KEYS = (const bf16*)(F.ws + WS_KEYS);
    unsigned short* IDX = (unsigned short*)(F.ws + WS_IDX); float* GATE = (float*)(F.ws + WS_GATE); float* SUO = (float*)(F.ws + WS_SUO);
    const GAS f32x2p5* SUVt = (const GAS f32x2p5*)(F.ws + WS_SU);
    for (int i = F.tid; i < 256 * 16; i += NWAVES * 64) { const int row = i >> 4, ch = i & 15;
        const v4u v = *(const GAS v4u*)(KEYS + row * 128 + ch * 8); *(LAS v4u*)(F.lds + RING_OFF + row * 256 + ((ch ^ (row & 15)) << 4)) = v; }
    __syncthreads();
    const int lane = F.lane, r32 = lane & 31, hi = lane >> 5, h = F.wave;
    LAS unsigned char* scr = F.lds + RING_OFF + P5_SCR_OFF + F.wave * 2048 + lane * 32;
    const bool own = (F.G == 256); const int g_lo = own ? 4 * F.vcu : F.vcu, g_hi = own ? 4 * F.vcu + 4 : M / 32, g_st = own ? 1 : F.G;
    bf16x8 qf[2][8];
#define P5_LOADQ(grp_) do { const size_t tk_ = (size_t)((grp_) * 32 + r32); _Pragma("unroll") for (int s = 0; s < 2; ++s) _Pragma("unroll") for (int ks = 0; ks < 8; ++ks) \
        qf[s][ks] = *(const GAS bf16x8*)(QP + tk_ * NPQ + 256 * h + 128 * s + 16 * ks + 8 * hi); } while (0)
    for (int grp = g_lo; grp < g_hi; grp += g_st) {
        const int tok = grp * 32 + r32;
        P5_LOADQ(grp);
        f32x16 sc[2][4];
#pragma unroll
        for (int s = 0; s < 2; ++s)
#pragma unroll
            for (int kb = 0; kb < 4; ++kb) {
                f32x16 a = {};
                const int row = s * 128 + kb * 32 + r32;
#pragma unroll
                for (int ks = 0; ks < 8; ++ks) {
                    const bf16x8 kf = *(const LAS bf16x8*)(F.lds + RING_OFF + row * 256 + (((2 * ks + hi) ^ (row & 15)) << 4));
                    a = __builtin_amdgcn_mfma_f32_32x32x16_bf16(kf, qf[s][ks], a, 0, 0, 0);
                }
                sc[s][kb] = a;
            }
        unsigned g[8][16];
#pragma unroll
        for (int kb = 0; kb < 4; ++kb)
#pragma unroll
            for (int r = 0; r < 16; ++r) {
                auto rr = __builtin_amdgcn_permlane32_swap(__float_as_uint(sc[0][kb][r]), __float_as_uint(sc[1][kb][r]), false, false);
                const int key0 = 32 * kb + (r & 3) + 8 * (r >> 2);
                g[2 * kb][r] = (f2sort(__uint_as_float(rr[0])) & ~127u) | (unsigned)(127 - key0);
                g[2 * kb + 1][r] = (f2sort(__uint_as_float(rr[1])) & ~127u) | (unsigned)(127 - (key0 + 4));
            }
        top16_of_128(g);
        unsigned s1[16], s2[16];
#pragma unroll
        for (int i = 0; i < 16; ++i) { auto rr = __builtin_amdgcn_permlane32_swap(g[0][i], g[0][i], false, false); s1[i] = rr[0]; s2[i] = rr[1]; }
        {
            unsigned w1[4], w2[4];
#pragma unroll
            for (int q = 0; q < 4; ++q) {
                w1[q] = (127u - (s1[4 * q] & 127u)) | ((127u - (s1[4 * q + 1] & 127u)) << 8) | ((127u - (s1[4 * q + 2] & 127u)) << 16) | ((127u - (s1[4 * q + 3] & 127u)) << 24);
                w2[q] = (127u - (s2[4 * q] & 127u)) | ((127u - (s2[4 * q + 1] & 127u)) << 8) | ((127u - (s2[4 * q + 2] & 127u)) << 16) | ((127u - (s2[4 * q + 3] & 127u)) << 24);
            }
            *(LAS v4u*)(scr) = (v4u){w1[0], w1[1], w1[2], w1[3]}; *(LAS v4u*)(scr + 16) = (v4u){w2[0], w2[1], w2[2], w2[3]};
        }
        float v1[16], v2[16];
#pragma unroll
        for (int i = 0; i < 16; ++i) { v1[i] = sort2f(s1[i] & ~127u); v2[i] = sort2f(s2[i] & ~127u); }
        unsigned c[4][16];
        {
            int n = 0;
#pragma unroll
            for (int a = 0; a < 16; ++a)
#pragma unroll
                for (int b = 0; b < 16; ++b)
                    if ((a + 1) * (b + 1) <= 16) { c[n >> 4][n & 15] = (f2sort(v1[a] + v2[b]) & ~255u) | (unsigned)(255 - (16 * a + b)); ++n; }
#pragma unroll
            for (int q = 50; q < 64; ++q) c[q >> 4][q & 15] = 0u;
        }
        top16_of_64(c);
        asm volatile("s_waitcnt lgkmcnt(0)" ::: "memory");
        float ts[16]; unsigned ex[16];
#pragma unroll
        for (int k = 0; k < 16; ++k) {
            const unsigned ab = 255u - (c[0][k] & 255u); const unsigned a = ab >> 4, b = ab & 15u;
            const unsigned i1 = *(const LAS unsigned char*)(scr + a), i2 = *(const LAS unsigned char*)(scr + 16 + b);
            ex[k] = i1 * 128u + i2; ts[k] = sort2f(c[0][k] & ~255u);
        }
        float den = 0.f; const float tmax = ts[0];
#pragma unroll
        for (int k = 0; k < 16; ++k) { ts[k] = __builtin_amdgcn_exp2f((ts[k] - tmax) * 1.4426950408889634f); den += ts[k]; }
        const float rden = __builtin_amdgcn_rcpf(den);
        unsigned eo[8]; float go[8];
#pragma unroll
        for (int k = 0; k < 8; ++k) { eo[k] = hi ? ex[k + 8] : ex[k]; go[k] = (hi ? ts[k + 8] : ts[k]) * rden; }
        float so[8];
#pragma unroll
        for (int k = 0; k < 8; ++k) { const f32x2p5 sv2 = SUVt[eo[k]]; so[k] = sv2.x; go[k] *= sv2.y; }
        const size_t ob = (size_t)tok * 128 + h * 16 + hi * 8;
        *(GAS v4u*)(IDX + ob) = (v4u){eo[0] | (eo[1] << 16), eo[2] | (eo[3] << 16), eo[4] | (eo[5] << 16), eo[6] | (eo[7] << 16)};
        *(GAS f32x4*)(GATE + ob) = (f32x4){go[0], go[1], go[2], go[3]}; *(GAS f32x4*)(GATE + ob + 4) = (f32x4){go[4], go[5], go[6], go[7]};
        *(GAS f32x4*)(SUO + ob) = (f32x4){so[0], so[1], so[2], so[3]}; *(GAS f32x4*)(SUO + ob + 4) = (f32x4){so[4], so[5], so[6], so[7]};
    }
#undef P5_LOADQ
    __syncthreads();
}

typedef float f32x2 __attribute__((ext_vector_type(2)));
__device__ __forceinline__ v4u bufload16(__amdgpu_buffer_rsrc_t rsrc, unsigned voff, unsigned soff) { return __builtin_bit_cast(v4u, __builtin_amdgcn_raw_buffer_load_b128(rsrc, (int)voff, (int)soff, 0)); }
__device__ __forceinline__ int dot4(unsigned a, unsigned b, int c) { return __builtin_amdgcn_sdot4((int)a, (int)b, c, false); }
template <int CTRL> __device__ __forceinline__ int dpp_mov(int v) { return __builtin_amdgcn_update_dpp(0, v, CTRL, 0xf, 0xf, false); }
#ifndef P6_PREFETCH
#define P6_PREFETCH 0
#endif
template <bool VPASS>
__device__ __forceinline__ void p6_load(v4u (&u)[16], v4u& xq, unsigned& x1w, const __amdgpu_buffer_rsrc_t rt, const unsigned char* XQ, const bf16* X1B, LAS unsigned* ids, int tok0, int it, int g, int m,
                                        const __amdgpu_buffer_rsrc_t rpf_u, const __amdgpu_buffer_rsrc_t rpf_v, unsigned pfbase, int lane, unsigned& pv) {
    const int s = it >> 4, t = it & 15; const unsigned soff = (unsigned)s << 21;
    pv = 0u;
#if P6_PREFETCH
    if (lane < 4) {
        const bool last = (s == 7);
        if (!(VPASS && last)) {
            const unsigned nso = last ? 0u : (unsigned)(s + 1) << 21;
            pv = (unsigned)__builtin_amdgcn_raw_buffer_load_b32((!VPASS && !last) ? rpf_u : rpf_v, (int)(pfbase + 512u * (unsigned)t + 128u * (unsigned)lane), (int)nso, 0);
        }
    }
#endif
    if (VPASS) x1w = __builtin_nontemporal_load((const GAS unsigned*)(X1B + (size_t)(tok0 + t) * D + 128 * s + 2 * lane));
    else xq = __builtin_nontemporal_load((const GAS v4u*)(XQ + (size_t)(tok0 + t) * D + 128 * s + 16 * m));
    const v4u ia = *(const LAS v4u*)(ids + t * 64 + 8 * g), ib = *(const LAS v4u*)(ids + t * 64 + 8 * g + 4);
    const unsigned idw[8] = {ia.x, ia.y, ia.z, ia.w, ib.x, ib.y, ib.z, ib.w};
#pragma unroll
    for (int k = 0; k < 16; ++k) { const unsigned id = (k & 1) ? (idw[k >> 1] >> 16) : (idw[k >> 1] & 0xffffu); u[k] = bufload16(rt, (id << 7) | ((unsigned)m << 4), soff); }
}
__device__ __forceinline__ void p6_comp_u(const v4u (&u)[16], const v4u xq, LAS int* da, int it, int lane) {
    const int t = it & 15;
    int p[16];
#pragma unroll
    for (int k = 0; k < 16; ++k) { int q0; asm("v_dot4_i32_i8 %0, %1, %2, 0" : "=v"(q0) : "v"(u[k].x), "v"(xq.x));
        p[k] = dot4(u[k].w, xq.w, dot4(u[k].z, xq.z, dot4(u[k].y, xq.y, q0))); }
    asm volatile("s_nop 1\n\t"
        "v_add_u32_dpp %0, %0, %0 row_half_mirror row_mask:0xf bank_mask:0x5\n\tv_add_u32_dpp %1, %1, %1 row_half_mirror row_mask:0xf bank_mask:0x5\n\t"
        "v_add_u32_dpp %2, %2, %2 row_half_mirror row_mask:0xf bank_mask:0x5\n\tv_add_u32_dpp %3, %3, %3 row_half_mirror row_mask:0xf bank_mask:0x5\n\t"
        "v_add_u32_dpp %4, %4, %4 row_half_mirror row_mask:0xf bank_mask:0x5\n\tv_add_u32_dpp %5, %5, %5 row_half_mirror row_mask:0xf bank_mask:0x5\n\t"
        "v_add_u32_dpp %6, %6, %6 row_half_mirror row_mask:0xf bank_mask:0x5\n\tv_add_u32_dpp %7, %7, %7 row_half_mirror row_mask:0xf bank_mask:0x5\n\t"
        "v_add_u32_dpp %0, %8, %8 row_half_mirror row_mask:0xf bank_mask:0xa\n\tv_add_u32_dpp %1, %9, %9 row_half_mirror row_mask:0xf bank_mask:0xa\n\t"
        "v_add_u32_dpp %2, %10, %10 row_half_mirror row_mask:0xf bank_mask:0xa\n\tv_add_u32_dpp %3, %11, %11 row_half_mirror row_mask:0xf bank_mask:0xa\n\t"
        "v_add_u32_dpp %4, %12, %12 row_half_mirror row_mask:0xf bank_mask:0xa\n\tv_add_u32_dpp %5, %13, %13 row_half_mirror row_mask:0xf bank_mask:0xa\n\t"
        "v_add_u32_dpp %6, %14, %14 row_half_mirror row_mask:0xf bank_mask:0xa\n\tv_add_u32_dpp %7, %15, %15 row_half_mirror row_mask:0xf bank_mask:0xa\n\ts_nop 1"
        : "+v"(p[0]), "+v"(p[1]), "+v"(p[2]), "+v"(p[3]), "+v"(p[4]), "+v"(p[5]), "+v"(p[6]), "+v"(p[7])
        : "v"(p[8]), "v"(p[9]), "v"(p[10]), "v"(p[11]), "v"(p[12]), "v"(p[13]), "v"(p[14]), "v"(p[15]));
    { const bool up = (lane & 2) != 0;
#pragma unroll
      for (int k = 0; k < 4; ++k) { const int keep = up ? p[k + 4] : p[k], send = up ? p[k] : p[k + 4]; p[k] = keep + dpp_mov<0x4E>(send); } }
    { const bool up = (lane & 1) != 0;
#pragma unroll
      for (int k = 0; k < 2; ++k) { const int keep = up ? p[k + 2] : p[k], send = up ? p[k] : p[k + 2]; p[k] = keep + dpp_mov<0xB1>(send); } }
    typedef int i32x2 __attribute__((ext_vector_type(2)));
    LAS i32x2* dp = (LAS i32x2*)(da + t * 128 + 2 * lane); i32x2 dv = *dp; dv.x += p[0]; dv.y += p[1]; *dp = dv;
}
typedef int v2i32_t __attribute__((ext_vector_type(2)));
constexpr int P6_PLANE = 1040;
__device__ __forceinline__ void p6_comp_v(const v4u (&u)[16], const unsigned x1w, LAS unsigned char* img, const LAS unsigned char* wq, const LAS float* sc, bf16* XF, int tok0, int it, int lane, int g, int m) {
    const int s = it >> 4, t = it & 15;
    const int h = lane >> 5, pp = (lane >> 4) & 1, i16 = lane & 15;
    LAS unsigned char* wa = img + m * P6_PLANE + (8 * g) * 16;
    const LAS unsigned char* ra = img + (4 * h) * P6_PLANE + (8 * pp + (i16 >> 1)) * 16 + 8 * (i16 & 1);
    v4u W4[4];
#pragma unroll
    for (int n = 0; n < 4; ++n) W4[n] = *(const LAS v4u*)(wq + t * 128 + (2 * n + pp) * 16);
    int a[4] = {0, 0, 0, 0};
#pragma unroll
    for (int hf = 0; hf < 2; ++hf) {
#pragma unroll
        for (int k = 0; k < 8; ++k) *(LAS v4u*)(wa + 16 * k) = u[8 * hf + k];
#pragma unroll
        for (int n = 0; n < 4; ++n)
#pragma unroll
            for (int dbi = 0; dbi < 4; ++dbi) {
                const v2i32_t v = __builtin_amdgcn_ds_read_tr8_b64_v2i32((LAS v2i32_t*)(ra + dbi * P6_PLANE + 256 * n));
                a[dbi] = dot4((unsigned)v.y, W4[n][2 * hf + 1], dot4((unsigned)v.x, W4[n][2 * hf], a[dbi]));
            }
    }
    int tot[2];
#pragma unroll
    for (int d = 0; d < 2; ++d) { auto rr = __builtin_amdgcn_permlane16_swap((unsigned)a[d], (unsigned)a[d + 2], false, false); tot[d] = (int)rr[0] + (int)rr[1]; }
    const float sw = sc[16 + t];
    const float xf0 = __uint_as_float(x1w << 16) + (float)tot[0] * sw, xf1 = __uint_as_float(x1w & 0xffff0000u) + (float)tot[1] * sw;
    __builtin_nontemporal_store(pk2(xf0, xf1), (GAS unsigned*)(XF + (size_t)(tok0 + t) * D + 128 * s + 2 * lane));
}
__device__ __forceinline__ void peer_phase(Frame& F) {
    const bf16* X1B = (const bf16*)(F.ws + WS_XN); bf16* XF = (bf16*)(F.ws + WS_MIX);
    unsigned char* XQ = F.ws + WS_XQ;
    const unsigned short* IDX = (const unsigned short*)(F.ws + WS_IDX); const float* GATE = (const float*)(F.ws + WS_GATE); const float* SS = (const float*)(F.ws + WS_SS);
    const float* SUO = (const float*)(F.ws + WS_SUO);
    const float* fg = F.in[15]; float* OUT = F.out;
    const int lane = F.lane, g = lane >> 3, m = lane & 7;
    const __amdgpu_buffer_rsrc_t ru = __builtin_amdgcn_make_buffer_rsrc((void*)(F.ws + WS_UT), 0, 16 << 20, 0x00020000);
    const __amdgpu_buffer_rsrc_t rv = __builtin_amdgcn_make_buffer_rsrc((void*)(F.ws + WS_VT), 0, 16 << 20, 0x00020000);
    LAS unsigned char* wl = F.lds + RING_OFF + F.wave * 16384;
    LAS unsigned* ids = (LAS unsigned*)wl;
    LAS int* da = (LAS int*)(wl + 4096);
    LAS unsigned char* img = wl + 4096;
    LAS unsigned char* wq = wl + 12416;
    LAS float* sc = (LAS float*)(wl + 14464);
    const int gw = F.vcu * NWAVES + F.wave, NGW = F.G * NWAVES;
    const unsigned pfbase = (unsigned)(((F.vcu & 31) * NWAVES + F.wave) * 8192);
    for (int tg = gw; tg < M / 16; tg += NGW) {
        const int tok0 = tg * 16;
#pragma unroll 1
        for (int tb = 0; tb < 16; tb += 4) {
            v4u xa[4], xb[4]; unsigned idv[4];
#pragma unroll
            for (int j = 0; j < 4; ++j) { const int t = tb + j;
                idv[j] = *(const GAS unsigned*)(IDX + (size_t)(tok0 + t) * 128 + 2 * lane);
                const GAS v4u* xp = (const GAS v4u*)(X1B + (size_t)(tok0 + t) * D + 16 * lane); xa[j] = xp[0]; xb[j] = xp[1]; }
#pragma unroll
            for (int j = 0; j < 4; ++j) { const int t = tb + j;
                ids[t * 64 + lane] = idv[j];
                typedef int i32x2 __attribute__((ext_vector_type(2)));
                *(LAS i32x2*)(da + t * 128 + 2 * lane) = (i32x2){0, 0};
                const unsigned xw[8] = {xa[j].x, xa[j].y, xa[j].z, xa[j].w, xb[j].x, xb[j].y, xb[j].z, xb[j].w};
                float xv[16]; float amax = 0.f;
#pragma unroll
                for (int q = 0; q < 8; ++q) { xv[2 * q] = __uint_as_float(xw[q] << 16); xv[2 * q + 1] = __uint_as_float(xw[q] & 0xffff0000u); amax = fmaxf(amax, fmaxf(fabsf(xv[2 * q]), fabsf(xv[2 * q + 1]))); }
#pragma unroll
                for (int o = 1; o < 64; o <<= 1) amax = fmaxf(amax, __shfl_xor(amax, o));
                const float inv = amax > 0.f ? 127.0f / amax : 0.f;
                v4u o4;
#pragma unroll
                for (int q = 0; q < 4; ++q) o4[q] = pack_i8x4((f32x4){xv[4 * q], xv[4 * q + 1], xv[4 * q + 2], xv[4 * q + 3]} * inv);
                *(GAS v4u*)(XQ + (size_t)(tok0 + t) * D + 16 * lane) = o4;
                if (lane == 0) sc[t] = amax > 0.f ? amax * (1.0f / 127.0f) : 1.0f; }
        }
        asm volatile("s_waitcnt vmcnt(0)" ::: "memory");
        {
            v4u uA[16], uB[16]; v4u xA, xB; unsigned dummy; unsigned pvA, pvB, pfacc = 0u;
            p6_load<false>(uA, xA, dummy, ru, XQ, X1B, ids, tok0, 0, g, m, ru, rv, pfbase, lane, pvA);
#pragma unroll 1
            for (int it = 0; it < 128; it += 2) {
                p6_load<false>(uB, xB, dummy, ru, XQ, X1B, ids, tok0, it + 1, g, m, ru, rv, pfbase, lane, pvB);
                p6_comp_u(uA, xA, da, it, lane);
                pfacc ^= pvA; p6_load<false>(uA, xA, dummy, ru, XQ, X1B, ids, tok0, (it + 2 < 128) ? it + 2 : 127, g, m, ru, rv, pfbase, lane, pvA);
                p6_comp_u(uB, xB, da, it + 1, lane); pfacc ^= pvB;
            }
            asm volatile("" :: "v"(pfacc ^ pvA));
        }
#pragma unroll 1
        for (int tb = 0; tb < 16; tb += 4) {
            float ssv[4]; f32x2 gt2[4]; f32x2 su2[4];
#pragma unroll
            for (int j = 0; j < 4; ++j) { const int t = tb + j, tok = tok0 + t;
                ssv[j] = (lane < 16) ? SS[(size_t)tok * 16 + lane] : 0.f;
                gt2[j] = *(const GAS f32x2*)(GATE + (size_t)tok * 128 + 2 * lane);
                su2[j] = *(const GAS f32x2*)(SUO + (size_t)tok * 128 + 2 * lane); }
#pragma unroll
            for (int j = 0; j < 4; ++j) { const int t = tb + j;
                const float rstd2 = 1.f / sqrtf(wave_sum(ssv[j]) * (1.f / D) + RMS_EPS);
                typedef int i32x2 __attribute__((ext_vector_type(2)));
                const i32x2 dv = *(const LAS i32x2*)(da + t * 128 + 2 * lane);
                const float zs = sc[t] * rstd2;
                const float z0 = (float)dv.x * su2[j].x * zs, z1 = (float)dv.y * su2[j].y * zs;
                const float h0 = z0 * __builtin_amdgcn_rcpf(1.f + __builtin_amdgcn_exp2f(-1.4426950408889634f * 1.5957691216057308f * (z0 + 0.044715f * z0 * z0 * z0)));
                const float h1 = z1 * __builtin_amdgcn_rcpf(1.f + __builtin_amdgcn_exp2f(-1.4426950408889634f * 1.5957691216057308f * (z1 + 0.044715f * z1 * z1 * z1)));
                const float w0 = gt2[j].x * h0, w1 = gt2[j].y * h1;
                float wmax = fmaxf(fabsf(w0), fabsf(w1));
#pragma unroll
                for (int o = 1; o < 64; o <<= 1) wmax = fmaxf(wmax, __shfl_xor(wmax, o));
                const float winv = wmax > 0.f ? 127.0f / wmax : 0.f;
                const int q0 = (int)__builtin_rintf(w0 * winv), q1 = (int)__builtin_rintf(w1 * winv);
                *(LAS unsigned short*)(wq + t * 128 + 2 * lane) = (unsigned short)((q0 & 0xff) | ((q1 & 0xff) << 8));
                if (lane == 0) sc[16 + t] = wmax * (1.0f / 127.0f); }
        }
        {
            v4u uA[16], uB[16]; unsigned xA, xB; v4u dummy; unsigned pvA, pvB, pfacc = 0u;
            p6_load<true>(uA, dummy, xA, rv, XQ, X1B, ids, tok0, 0, g, m, ru, rv, pfbase, lane, pvA);
#pragma unroll 1
            for (int it = 0; it < 128; it += 2) {
                p6_load<true>(uB, dummy, xB, rv, XQ, X1B, ids, tok0, it + 1, g, m, ru, rv, pfbase, lane, pvB);
                p6_comp_v(uA, xA, img, wq, sc, XF, tok0, it, lane, g, m);
                pfacc ^= pvA; p6_load<true>(uA, dummy, xA, rv, XQ, X1B, ids, tok0, (it + 2 < 128) ? it + 2 : 127, g, m, ru, rv, pfbase, lane, pvA);
                p6_comp_v(uB, xB, img, wq, sc, XF, tok0, it + 1, lane, g, m); pfacc ^= pvB;
            }
            asm volatile("" :: "v"(pfacc ^ pvA));
        }
#pragma unroll 1
        for (int tb = 0; tb < 16; tb += 4) {
            unsigned xw[4][8];
#pragma unroll
            for (int j = 0; j < 4; ++j)
#pragma unroll
                for (int s = 0; s < 8; ++s) xw[j][s] = *(const GAS unsigned*)(XF + (size_t)(tok0 + tb + j) * D + 128 * s + 2 * lane);
            f32x2 gg[8];
#pragma unroll
            for (int s = 0; s < 8; ++s) gg[s] = *(const GAS f32x2*)(fg + 128 * s + 2 * lane);
#pragma unroll
            for (int j = 0; j < 4; ++j) {
                float ss = 0.f;
#pragma unroll
                for (int s = 0; s < 8; ++s) { const float a0 = __uint_as_float(xw[j][s] << 16), a1 = __uint_as_float(xw[j][s] & 0xffff0000u); ss += a0 * a0 + a1 * a1; }
                const float rstd = 1.f / sqrtf(wave_sum(ss) * (1.f / D) + RMS_EPS);
#pragma unroll
                for (int s = 0; s < 8; ++s) { const size_t off = (size_t)(tok0 + tb + j) * D + 128 * s + 2 * lane;
                    f32x2 ov = (f32x2){__uint_as_float(xw[j][s] << 16) * rstd * gg[s].x, __uint_as_float(xw[j][s] & 0xffff0000u) * rstd * gg[s].y};
                    __builtin_nontemporal_store(ov, (GAS f32x2*)(OUT + off)); }
            }
        }
    }
}

struct Args { const float* in[16]; float* out; unsigned char* ws; int ph_lo, ph_hi, li, pad; };
__global__ void __launch_bounds__(NWAVES * 64, 2) mk_fwd(Args args) {
    extern __shared__ __attribute__((aligned(16))) unsigned char lds[];
    Frame F;
    F.lds = (LAS unsigned char*)lds;
    F.MISC = (volatile LAS unsigned*)(F.lds + MISC_OFF);
    F.tid = threadIdx.x; F.lane = F.tid & 63; F.wave = __builtin_amdgcn_readfirstlane(F.tid >> 6);
    F.G = gridDim.x; { const int bx = blockIdx.x; F.vcu = (F.G % 8 == 0) ? (bx % 8) * (F.G / 8) + bx / 8 : bx; }
#define GRID_BAR(seam) do { if (N_LAUNCHES == PER_PHASE) { if (F.tid == 0) __hip_atomic_store(F.ctl + CW_TMO, 0xBADBA0u | (unsigned)(seam), RLX_AGENT); } \
    else { xcd_barrier(bar); } } while (0)
    unsigned char* ws = args.ws;
    F.ctl = (gu32*)(ws + WS_CTL); F.ws = ws; F.out = args.out;
#pragma unroll
    for (int i = 0; i < 16; ++i) F.in[i] = args.in[i];
    for (int u = F.tid; u < (LDS_BYTES - LDSCTL_OFF) / 4; u += NWAVES * 64) ((LAS unsigned*)(F.lds + LDSCTL_OFF))[u] = 0u;
    __syncthreads();
    XcdBarrier bar; bar.bar = (unsigned*)(F.ctl + CW_BAR); bar.x = 0; bar.st = nullptr;
    if (N_LAUNCHES != PER_PHASE) bar = xcd_barrier_post((unsigned*)(F.ctl + CW_BAR), F.MISC + 8);

    const pg8::WsSt WST{__builtin_amdgcn_make_buffer_rsrc((void*)ws, 0, (int)WS_END, 0x00020000), ws};
    const int lo = args.ph_lo, hi = args.ph_hi;
#define IN(k) (lo <= (k) && (k) < hi)
#define BOTH(k) (IN(k) && IN((k) + 1))

    if (IN(0)) { p0_prologue(F); if (BOTH(0)) GRID_BAR(0); }

    if (IN(1)) {
        pg8::Gemm g{(const pg8::bf16_t*)(ws + WS_XN), (const pg8::bf16_t*)(ws + WS_WIN), M, NIN, D}; pg8::StaticOrder S; S.init(M, NIN, F.G, (int)blockIdx.x);
        pg8::EpiP1 E{WST, WS_Q, WS_K, WS_V, WS_H, F.in[3], F.in[4], (const float*)(ws + WS_ROPE), attn_body::C2};
        pg8::gemm_phase<pg8::EpiP1, pg8::StaticOrder, PG8_ALIGN, PG8_SP2>(F.lds + RING_OFF, g, S, E);
        if (BOTH(1)) GRID_BAR(1);
    }

    if (IN(2)) {
        v8t_phase(F);
        if (N_LAUNCHES != PER_PHASE) { xcd_barrier(bar); }
        const attn_body::AttnTensors AT{(const attn_body::bf16*)(ws + WS_Q), (const attn_body::bf16*)(ws + WS_K), (const attn_body::bf16*)(ws + WS_V8T), (attn_body::bf16*)(ws + WS_MIX)};
        const attn_body::StaticOrder S((int)F.G, (int)blockIdx.x);
        bool attn_fast;
        { const float gq = fabsf(F.in[3][F.lane]), gk = fabsf(F.in[4][F.lane]); float mq = gq, mk = gk;
#pragma unroll
          for (int o = 1; o < 64; o <<= 1) { mq = fmaxf(mq, __shfl_xor(mq, o)); mk = fmaxf(mk, __shfl_xor(mk, o)); }
          attn_fast = (64.0f * attn_body::C2 * mq * mk <= 14.0f); }
#if defined(FORCE_ATTN_SLOW)
        attn_fast = false;
#endif
        attn_body::attn_phase<attn_body::StaticOrder>((char*)lds + RING_OFF, AT, S, attn_fast);
        __syncthreads();
        conv_phase(F);
        if (BOTH(2)) GRID_BAR(2);
    }

    if (IN(3)) {
        pg8::Gemm g{(const pg8::bf16_t*)(ws + WS_MIX), (const pg8::bf16_t*)(ws + WS_WOUT), M, D, D}; pg8::StaticOrder S; S.init(M, D, F.G, (int)blockIdx.x);
        pg8::EpiP3 E{WST, WS_XN, (pg8::bf16_t*)(ws + WS_XN), (const float*)(ws + WS_RSI), (const float*)(ws + WS_IG1), (float*)(ws + WS_SS)};
        pg8::gemm_phase<pg8::EpiP3, pg8::StaticOrder, PG8_ALIGN, PG8_SP2>(F.lds + RING_OFF, g, S, E);
        if (BOTH(3)) GRID_BAR(3);
    }

    if (IN(4)) {
        pg8::Gemm g{(const pg8::bf16_t*)(ws + WS_XN), (const pg8::bf16_t*)(ws + WS_WQ), M, NPQ, D}; pg8::StaticOrder S; S.init(M, NPQ, F.G, (int)blockIdx.x);
        pg8::EpiP4 E{WST, WS_QP, (const float*)(ws + WS_SS)};
        pg8::gemm_phase<pg8::EpiP4, pg8::StaticOrder, PG8_ALIGN, PG8_SP2>(F.lds + RING_OFF, g, S, E);
        if (BOTH(4)) GRID_BAR(4);
    }

    if (IN(5)) { topk_phase(F); if (BOTH(5)) { if (F.G == 256) { asm volatile("s_waitcnt vmcnt(0)" ::: "memory"); __syncthreads(); } else GRID_BAR(5); } }

    if (IN(6)) { peer_phase(F); }
#undef IN
#undef BOTH
}

extern "C" void kernel_launch(void* const* d_in, const int* in_sizes, int n_in, void* d_out, int out_size, void* d_ws, size_t ws_size, hipStream_t stream) {
    static int grid = 0;
    if (grid == 0) {
        if (n_in != 16 || in_sizes[0] != M * D || out_size != M * D || ws_size < WS_END) { fprintf(stderr, "kernel_launch: built for 16 inputs, x and out of %d floats, >= %zu bytes of workspace; got n_in %d, in0 %d, out %d, ws %zu; nothing launched\n", M * D, (size_t)WS_END, n_in, n_in > 0 ? in_sizes[0] : -1, out_size, ws_size); grid = -1; return; }
        int dev = 0, cus = 0, per_cu = 0;
        if (hipGetDevice(&dev) != hipSuccess || hipDeviceGetAttribute(&cus, hipDeviceAttributeMultiprocessorCount, dev) != hipSuccess) { fprintf(stderr, "kernel_launch: hipGetDevice / hipDeviceGetAttribute failed; nothing launched\n"); grid = -1; return; }
        if (hipFuncSetAttribute((const void*)mk_fwd, hipFuncAttributeMaxDynamicSharedMemorySize, LDS_BYTES) != hipSuccess) { fprintf(stderr, "kernel_launch: hipFuncSetAttribute failed\n"); grid = -1; return; }
        if (hipOccupancyMaxActiveBlocksPerMultiprocessor(&per_cu, (const void*)mk_fwd, NWAVES * 64, LDS_BYTES) != hipSuccess || per_cu < 1)
            fprintf(stderr, "kernel_launch: note: the occupancy query reports %d workgroups per CU\n", per_cu);
        (void)hipGetLastError();
        grid = cus;
        if (grid != 256) { fprintf(stderr, "kernel_launch: this kernel's static work deals are built for the 256 CUs of an MI355X; found %d; nothing launched\n", grid); grid = -1; return; }
    }
    if (grid < 0) return;
    if (hipMemsetAsync((char*)d_ws + WS_CTL, 0, CTL_ZERO_BYTES, stream) != hipSuccess) { fprintf(stderr, "kernel_launch: hipMemsetAsync of the control words failed; nothing launched\n"); return; }
    Args a{};
    for (int i = 0; i < 16; ++i) a.in[i] = (const float*)d_in[i];
    a.out = (float*)d_out; a.ws = (unsigned char*)d_ws;
    for (int li = 0; li < N_LAUNCHES; ++li) {
        a.ph_lo = (N_LAUNCHES == PER_PHASE) ? li : 0; a.ph_hi = (N_LAUNCHES == PER_PHASE) ? li + 1 : PER_PHASE; a.li = li;
        hipLaunchKernelGGL(mk_fwd, dim3(grid), dim3(NWAVES * 64), LDS_BYTES, stream, a);
        const hipError_t le = hipPeekAtLastError();
        if (le != hipSuccess) { fprintf(stderr, "kernel_launch: launch %d failed: %s\n", li, hipGetErrorName(le)); break; }
    }
}
```

```cpp
#include <hip/hip_runtime.h>
#include <cstdio>
#include <cstdint>
namespace pg8 {
#define PG8_LAS __attribute__((address_space(3)))
typedef unsigned short bf16_t;
typedef short bf16x8 __attribute__((ext_vector_type(8)));
typedef float f32x4 __attribute__((ext_vector_type(4)));
typedef unsigned u32x4 __attribute__((ext_vector_type(4)));
constexpr int BM = 256, BK = 64, HALF = 128, HTB = HALF * BK * 2  , STAGE_BYTES = 8 * HTB, NXCD = 8, WGM = 8;

__host__ __device__ __forceinline__ int lds_byte(int r, int c) { const int st = (r >> 4) * 2 + (c >> 5), rr = r & 15, cc = c & 31, ob = rr * 64 + cc * 2; return st * 1024 + (ob ^ (((ob >> 9) & 1) << 5)); }
__host__ __device__ __forceinline__ void stage_rc(int b, int& R, int& C) { const int st = b / 1024, sb = b % 1024, swz = sb ^ (((sb >> 9) & 1) << 5); R = (st >> 1) * 16 + swz / 64; C = (st & 1) * 32 + (swz % 64) / 2; }
__host__ __device__ __forceinline__ int perm32(int rho) { const int n = rho >> 4, i = rho & 15; return 8 * (i >> 2) + 4 * n + (i & 3); }

struct Unit { int pm, pn; };
struct Gemm { const bf16_t* A; const bf16_t* Bt; int M, N, K; };

struct StaticOrder {
    int nM, nN, nwg, G, c;
    __host__ __device__ void init(int M, int N, int G_, int c_) { nM = M / BM; nN = N / BM; nwg = nM * nN; G = G_; c = c_; }
    __host__ __device__ bool next(int i, Unit& u) const {
        const long L = (long)i * G + c; if (L >= nwg) return false;
        int wgid = (int)L; { const int q = nwg / NXCD, r = nwg % NXCD, xcd = wgid % NXCD, off = wgid / NXCD; wgid = (xcd < r ? xcd * (q + 1) : r * (q + 1) + (xcd - r) * q) + off; }
        const int nig = WGM * nN, gid = wgid / nig, fm = gid * WGM, gsz = (nM - fm) < WGM ? (nM - fm) : WGM;
        u.pm = fm + ((wgid % nig) % gsz); u.pn = (wgid % nig) / gsz; return true;
    }
    __device__ __forceinline__ void a_ready(const Unit&) const {}
    __device__ __forceinline__ void done(const Unit&) const {}
};


__device__ __forceinline__ unsigned cvt_pk_bf16(float lo, float hi) { unsigned r; asm volatile("v_cvt_pk_bf16_f32 %0, %1, %2" : "=v"(r) : "v"(lo), "v"(hi)); return r; }
typedef unsigned u32x2 __attribute__((ext_vector_type(2)));
__device__ __forceinline__ u32x4 pack8(const f32x4 a, const f32x4 b) { u32x4 w; w.x = cvt_pk_bf16(a[0], a[1]); w.y = cvt_pk_bf16(a[2], a[3]); w.z = cvt_pk_bf16(b[0], b[1]); w.w = cvt_pk_bf16(b[2], b[3]); return w; }

#ifndef WT_STORES
#define WT_STORES 0
#endif
struct WsSt { __amdgpu_buffer_rsrc_t rs; unsigned char* base;
    __device__ __forceinline__ void st16(size_t off, const u32x4 v) const {
#if WT_STORES
        __builtin_amdgcn_raw_buffer_store_b128(v, rs, (int)(unsigned)off, 0, 16);
#else
        *(u32x4*)(base + off) = v;
#endif
    } };
struct EpiP1 {
    static constexpr bool PERM = true, AFTER_DRAIN = false;
    WsSt W; size_t oQ, oK, oV, oH; const float *qg, *kg; const float* rope; float qscale;
    __device__ __forceinline__ void operator()(const f32x4 (&acc)[2][2][4][2], const Unit& u, int wr, int wc, int fr, int fq) const {
        const int row0 = u.pm * BM + wr * 64 + fr;
        if (u.pn < 2 || (u.pn == 2 && wc < 2)) {
            const bool isq = u.pn < 2;
            const float* g = isq ? qg : kg;
            f32x4 gv[2][2];
#pragma unroll
            for (int bj = 0; bj < 2; ++bj)
#pragma unroll
                for (int n = 0; n < 2; ++n) gv[bj][n] = *(const f32x4*)(g + 32 * bj + 16 * n + 4 * fq);
            const float sc = isq ? qscale : 1.f;
            const size_t base = isq ? (oQ + (size_t)(4 * u.pn + wc) * 64) : (oK + (size_t)wc * 64);
            const int pitch = isq ? 512 : 128;
            f32x4 rA[2][2], rB[4][2];
#pragma unroll
            for (int ai = 0; ai < 2; ++ai) { const int pos = ((row0 + ai * HALF) & 8191) >> 6; const f32x4* rp = (const f32x4*)(rope + (pos * 16 + 4 * fq) * 2); rA[ai][0] = rp[0]; rA[ai][1] = rp[1]; }
#pragma unroll
            for (int m = 0; m < 4; ++m) { const int pos = (row0 + m * 16) & 63; const f32x4* rp = (const f32x4*)(rope + (pos * 16 + 4 * fq) * 2); rB[m][0] = rp[0]; rB[m][1] = rp[1]; }
#pragma unroll
            for (int ai = 0; ai < 2; ++ai)
#pragma unroll
                for (int m = 0; m < 4; ++m) {
                    const int row = row0 + ai * HALF + m * 16;
                    float ss = 0.f;
#pragma unroll
                    for (int bj = 0; bj < 2; ++bj)
#pragma unroll
                        for (int n = 0; n < 2; ++n) { const f32x4 v = acc[ai][bj][m][n]; ss += (v[0] * v[0] + v[1] * v[1]) + (v[2] * v[2] + v[3] * v[3]); }
                    ss += __shfl_xor(ss, 16); ss += __shfl_xor(ss, 32);
                    const float rstd = __builtin_amdgcn_rsqf(ss * (1.0f / 64.0f) + 1e-6f) * sc;
#pragma unroll
                    for (int bj = 0; bj < 2; ++bj) {
                        const f32x4 r01 = bj ? rB[m][0] : rA[ai][0], r23 = bj ? rB[m][1] : rA[ai][1];
                        const f32x4 x1 = acc[ai][bj][m][0] * gv[bj][0] * rstd, x2 = acc[ai][bj][m][1] * gv[bj][1] * rstd;
                        const f32x4 cs = (f32x4){r01[0], r01[2], r23[0], r23[2]}, sn = (f32x4){r01[1], r01[3], r23[1], r23[3]};
                        const f32x4 o1 = x1 * cs - x2 * sn, o2 = x2 * cs + x1 * sn;
                        u32x2 w8; { int lo = 0, hi_ = 0;
                            lo = __builtin_amdgcn_cvt_pk_fp8_f32(o1[0], o1[1], lo, false); lo = __builtin_amdgcn_cvt_pk_fp8_f32(o1[2], o1[3], lo, true);
                            hi_ = __builtin_amdgcn_cvt_pk_fp8_f32(o2[0], o2[1], hi_, false); hi_ = __builtin_amdgcn_cvt_pk_fp8_f32(o2[2], o2[3], hi_, true); w8.x = (unsigned)lo; w8.y = (unsigned)hi_; }
                        *(u32x2*)(W.base + base + (size_t)row * pitch + 32 * bj + 8 * fq) = w8;
                    }
                }
        } else if (u.pn == 2) {
            const int hk = wc - 2, s0 = 32 * ((fr >> 2) & 1) + 4 * (fr >> 3) + (fr & 3);
#pragma unroll
            for (int ai = 0; ai < 2; ++ai) {
                const int rowa = row0 + ai * HALF;
                unsigned char* tb = W.base + oV + (size_t)((rowa >> 13) * 256 + hk * 128 + ((rowa & 8191) >> 6)) * 4096 + s0;
#pragma unroll
                for (int bj = 0; bj < 2; ++bj)
#pragma unroll
                    for (int n = 0; n < 2; ++n)
#pragma unroll
                        for (int e = 0; e < 4; ++e) {
                            int pk = 0;
                            pk = __builtin_amdgcn_cvt_pk_fp8_f32(acc[ai][bj][0][n][e], acc[ai][bj][1][n][e], pk, false); pk = __builtin_amdgcn_cvt_pk_fp8_f32(acc[ai][bj][2][n][e], acc[ai][bj][3][n][e], pk, true);
                            unsigned char* pd = tb + (32 * bj + 8 * fq + 4 * n + e) * 64;
                            pd[0] = (unsigned char)(pk & 0xff); pd[8] = (unsigned char)((pk >> 8) & 0xff); pd[16] = (unsigned char)((pk >> 16) & 0xff); pd[24] = (unsigned char)((unsigned)pk >> 24);
                        }
            }
        } else {
            const size_t base = oH + (size_t)((u.pn - 3) * 128 + wc * 32 + 8 * fq) * 2;
#pragma unroll
            for (int ai = 0; ai < 2; ++ai)
#pragma unroll
                for (int m = 0; m < 4; ++m) {
                    const int row = row0 + ai * HALF + m * 16;
                    f32x4 o[2];
#pragma unroll
                    for (int n = 0; n < 2; ++n) { const f32x4 a = acc[ai][0][m][n], b = acc[ai][1][m][n];
#pragma unroll
                        for (int e = 0; e < 4; ++e) o[n][e] = a[e] * __builtin_amdgcn_rcpf(1.0f + __builtin_amdgcn_exp2f(-1.4426950408889634f * b[e])); }
                    W.st16(base + (size_t)row * 1024, pack8(o[0], o[1]));
                }
        }
    }
};

struct EpiP3 {
    static constexpr bool PERM = true, AFTER_DRAIN = false;
    WsSt W; size_t oX; bf16_t* X1B; const float* rsi; const float* ig1; float* SS;
    __device__ __forceinline__ void operator()(const f32x4 (&acc)[2][2][4][2], const Unit& u, int wr, int wc, int fr, int fq) const {
        const int row0 = u.pm * BM + wr * 64 + fr, col0 = u.pn * BM + wc * 32 + 8 * fq;
        f32x4 ig[2][2];
#pragma unroll
        for (int bj = 0; bj < 2; ++bj)
#pragma unroll
            for (int n = 0; n < 2; ++n) ig[bj][n] = *(const f32x4*)(ig1 + col0 + bj * HALF + 4 * n);
#pragma unroll
        for (int ai = 0; ai < 2; ++ai) {
        u32x4 xw[2][4][2]; float ri[2][4];
#pragma unroll
            for (int m = 0; m < 4; ++m) { const int row = row0 + ai * HALF + m * 16; const size_t off = (size_t)row * 1024 + col0;
                ri[ai][m] = rsi[row];
#pragma unroll
                for (int bj = 0; bj < 2; ++bj) xw[ai][m][bj] = *(const u32x4*)(X1B + off + bj * HALF); }
            asm volatile("" ::: "memory");
#pragma unroll
            for (int m = 0; m < 4; ++m) {
                const int row = row0 + ai * HALF + m * 16; const size_t off = (size_t)row * 1024 + col0;
                float ss = 0.f;
#pragma unroll
                for (int bj = 0; bj < 2; ++bj) {
                    const u32x4 w_ = xw[ai][m][bj];
                    const f32x4 xa = (f32x4){__uint_as_float(w_.x << 16), __uint_as_float(w_.x & 0xffff0000u), __uint_as_float(w_.y << 16), __uint_as_float(w_.y & 0xffff0000u)};
                    const f32x4 xb = (f32x4){__uint_as_float(w_.z << 16), __uint_as_float(w_.z & 0xffff0000u), __uint_as_float(w_.w << 16), __uint_as_float(w_.w & 0xffff0000u)};
                    const f32x4 v0 = acc[ai][bj][m][0] + xa * ig[bj][0] * ri[ai][m], v1 = acc[ai][bj][m][1] + xb * ig[bj][1] * ri[ai][m];
                    W.st16(oX + (off + bj * HALF) * 2, pack8(v0, v1));
                    ss += (v0[0] * v0[0] + v0[1] * v0[1]) + (v0[2] * v0[2] + v0[3] * v0[3]) + (v1[0] * v1[0] + v1[1] * v1[1]) + (v1[2] * v1[2] + v1[3] * v1[3]);
                }
                ss += __shfl_xor(ss, 16); ss += __shfl_xor(ss, 32);
                if (fq == 0) SS[(size_t)row * 16 + u.pn * 4 + wc] = ss;
            }
        }
    }
};

struct EpiP4 {
    static constexpr bool PERM = true, AFTER_DRAIN = false;
    WsSt W; size_t oQP; const float* SS;
    __device__ __forceinline__ void operator()(const f32x4 (&acc)[2][2][4][2], const Unit& u, int wr, int wc, int fr, int fq) const {
        const int row0 = u.pm * BM + wr * 64 + fr, col0 = u.pn * BM + wc * 32 + 8 * fq;
        f32x4 sv[2][4];
#pragma unroll
        for (int ai = 0; ai < 2; ++ai)
#pragma unroll
            for (int m = 0; m < 4; ++m) sv[ai][m] = *(const f32x4*)(SS + (size_t)(row0 + ai * HALF + m * 16) * 16 + 4 * fq);
#pragma unroll
        for (int ai = 0; ai < 2; ++ai)
#pragma unroll
            for (int m = 0; m < 4; ++m) {
                const int row = row0 + ai * HALF + m * 16;
                float s = (sv[ai][m][0] + sv[ai][m][1]) + (sv[ai][m][2] + sv[ai][m][3]);
                s += __shfl_xor(s, 16); s += __shfl_xor(s, 32);
                const float rstd = __builtin_amdgcn_rsqf(s * (1.0f / 1024.0f) + 1e-6f);
#pragma unroll
                for (int bj = 0; bj < 2; ++bj)
                    W.st16(oQP + ((size_t)row * 2048 + col0 + bj * HALF) * 2, pack8(acc[ai][bj][m][0] * rstd, acc[ai][bj][m][1] * rstd));
            }
    }
};
template <class Epi, class Sched, bool ALIGN_EPI = false, bool SP2 = false>
__device__ __forceinline__ void gemm_phase(PG8_LAS unsigned char* lds, const Gemm g, const Sched& S, const Epi& E) {
    const int tid = threadIdx.x, wid = __builtin_amdgcn_readfirstlane(tid >> 6), lane = tid & 63, wr = wid >> 2, wc = wid & 3, fr = lane & 15, fq = lane >> 4;
    const int K = g.K, nt = K / BK;
    unsigned voffA[2], voffB[2];
#pragma unroll
    for (int i = 0; i < 2; ++i) { int R, C; stage_rc(tid * 16 + i * 8192, R, C); const int Rb = Epi::PERM ? ((R & ~31) + perm32(R & 31)) : R;
        voffA[i] = (unsigned)(R * K + C) * 2u; voffB[i] = (unsigned)(Rb * K + C) * 2u; }
    const size_t kstep = (size_t)(BK * 2);
    const size_t hstep = (size_t)HALF * K * 2;
    const size_t tstep = 2 * hstep;
    const unsigned ldsw = (unsigned)wid * 1024u;
    const int aoff = lds_byte(wr * 64 + fr, fq * 8), boff = lds_byte(wc * 32 + fr, fq * 8);
#define PG8_SA(b, h) (((b) * 2 + (h)) * HTB)
#define PG8_SB(b, h) ((4 + (b) * 2 + (h)) * HTB)
#define PG8_STAGE(bufoff, gbase, voff) do { _Pragma("unroll") for (int _i = 0; _i < 2; ++_i) \
        __builtin_amdgcn_global_load_lds((const unsigned*)((const char*)(gbase) + (voff)[_i]), (PG8_LAS unsigned*)(lds + (bufoff) + ldsw + _i * 8192), 16, 0, 0); } while (0)
#define PG8_LDA(dst, b, h) do { _Pragma("unroll") for (int m = 0; m < 4; ++m) _Pragma("unroll") for (int k = 0; k < 2; ++k) dst[m][k] = *(const PG8_LAS bf16x8*)(lds + PG8_SA(b, h) + aoff + m * 2048 + k * 1024); } while (0)
#define PG8_LDB(dst, b, h) do { _Pragma("unroll") for (int n = 0; n < 2; ++n) _Pragma("unroll") for (int k = 0; k < 2; ++k) dst[n][k] = *(const PG8_LAS bf16x8*)(lds + PG8_SB(b, h) + boff + n * 2048 + k * 1024); } while (0)
#define PG8_MMA(ai, bj, At, Bt) do { __builtin_amdgcn_s_setprio(1); _Pragma("unroll") for (int m = 0; m < 4; ++m) _Pragma("unroll") for (int n = 0; n < 2; ++n) _Pragma("unroll") for (int k = 0; k < 2; ++k) \
        acc[ai][bj][m][n] = __builtin_amdgcn_mfma_f32_16x16x32_bf16(Bt[n][k], At[m][k], acc[ai][bj][m][n], 0, 0, 0); __builtin_amdgcn_s_setprio(0); } while (0)
#define PG8_WAIT_V(n) asm volatile("s_waitcnt vmcnt(" #n ")" ::: "memory")
#define PG8_WAIT_L(n) asm volatile("s_waitcnt lgkmcnt(" #n ")" ::: "memory")
#define PG8_BAR __builtin_amdgcn_s_barrier()
#define PG8_SCHED __builtin_amdgcn_sched_barrier(0)
    Unit cur, nxt; int ui = 0;
    if (!S.next(0, cur)) return;
    f32x4 acc[2][2][4][2];
#pragma unroll
    for (int a = 0; a < 2; ++a)
#pragma unroll
        for (int b = 0; b < 2; ++b)
#pragma unroll
            for (int m = 0; m < 4; ++m)
#pragma unroll
                for (int n = 0; n < 2; ++n) acc[a][b][m][n] = (f32x4){0.f, 0.f, 0.f, 0.f};
    bf16x8 At[4][2], B0[2][2], B1[2][2];
    const char* cA = (const char*)g.A + (size_t)cur.pm * tstep; const char* cB = (const char*)g.Bt + (size_t)cur.pn * tstep;
    S.a_ready(cur);
    if constexpr (SP2) {
        PG8_STAGE(PG8_SB(0, 0), cB, voffB); PG8_STAGE(PG8_SB(0, 1), cB + hstep, voffB); PG8_STAGE(PG8_SA(0, 0), cA, voffA); PG8_STAGE(PG8_SA(0, 1), cA + hstep, voffA);
        if (wr == 1) PG8_BAR;
        PG8_WAIT_V(2); PG8_BAR;
        PG8_STAGE(PG8_SB(1, 0), cB + kstep, voffB); PG8_STAGE(PG8_SA(1, 0), cA + kstep, voffA); PG8_STAGE(PG8_SB(1, 1), cB + hstep + kstep, voffB);
        PG8_WAIT_V(6); PG8_BAR;
    } else {
        PG8_STAGE(PG8_SB(0, 0), cB, voffB); PG8_STAGE(PG8_SA(0, 0), cA, voffA); PG8_STAGE(PG8_SB(0, 1), cB + hstep, voffB); PG8_STAGE(PG8_SA(0, 1), cA + hstep, voffA);
        if (wr == 1) PG8_BAR;
        PG8_WAIT_V(4); PG8_BAR;
        PG8_STAGE(PG8_SB(1, 0), cB + kstep, voffB); PG8_STAGE(PG8_SA(1, 0), cA + kstep, voffA); PG8_STAGE(PG8_SB(1, 1), cB + hstep + kstep, voffB);
        PG8_WAIT_V(6); PG8_BAR;
    }
    for (;;) {
        const bool has_next = S.next(ui + 1, nxt);
        const char* nA = has_next ? (const char*)g.A + (size_t)nxt.pm * tstep : cA; const char* nB = has_next ? (const char*)g.Bt + (size_t)nxt.pn * tstep : cB;
        for (int t = 0; t < nt; t += 2) {
            const bool last = (t == nt - 2);
            const char* a1 = cA + (size_t)(t + 1) * kstep;
            const char* a2 = last ? nA : cA + (size_t)(t + 2) * kstep; const char* b2 = last ? nB : cB + (size_t)(t + 2) * kstep;
            const char* a3 = a2 + kstep; const char* b3 = b2 + kstep;
            if (last && has_next) S.a_ready(nxt);
            if constexpr (SP2) {
            PG8_LDB(B0, 0, 0); PG8_LDB(B1, 0, 1); PG8_SCHED; PG8_LDA(At, 0, 0); PG8_STAGE(PG8_SA(1, 1), a1 + hstep, voffA);
            PG8_WAIT_V(8); PG8_WAIT_L(0); PG8_BAR; PG8_MMA(0, 0, At, B0); PG8_MMA(0, 1, At, B1); PG8_BAR; PG8_SCHED;
            PG8_LDA(At, 0, 1); PG8_STAGE(PG8_SB(0, 0), b2, voffB); PG8_STAGE(PG8_SB(0, 1), b2 + hstep, voffB); PG8_STAGE(PG8_SA(0, 0), a2, voffA);
            PG8_WAIT_V(8); PG8_WAIT_L(0); PG8_BAR; PG8_MMA(1, 0, At, B0); PG8_MMA(1, 1, At, B1); PG8_BAR; PG8_SCHED;
            PG8_LDB(B0, 1, 0); PG8_LDB(B1, 1, 1); PG8_SCHED; PG8_LDA(At, 1, 0); PG8_STAGE(PG8_SA(0, 1), a2 + hstep, voffA);
            PG8_WAIT_V(8); PG8_WAIT_L(0); PG8_BAR; PG8_MMA(0, 0, At, B0); PG8_MMA(0, 1, At, B1); PG8_BAR; PG8_SCHED;
            PG8_LDA(At, 1, 1); PG8_STAGE(PG8_SB(1, 0), b3, voffB); PG8_STAGE(PG8_SB(1, 1), b3 + hstep, voffB); PG8_STAGE(PG8_SA(1, 0), a3, voffA);
            PG8_WAIT_V(8); PG8_WAIT_L(0); PG8_BAR; PG8_MMA(1, 0, At, B0); PG8_MMA(1, 1, At, B1); PG8_BAR; PG8_SCHED;
            } else {
            PG8_LDB(B0, 0, 0); PG8_SCHED; PG8_LDA(At, 0, 0); PG8_STAGE(PG8_SA(1, 1), a1 + hstep, voffA);
            PG8_WAIT_L(8); PG8_BAR; PG8_WAIT_L(0); PG8_MMA(0, 0, At, B0); PG8_BAR; PG8_SCHED;
            PG8_LDB(B1, 0, 1); PG8_STAGE(PG8_SB(0, 0), b2, voffB);
            PG8_BAR; PG8_WAIT_L(0); PG8_MMA(0, 1, At, B1); PG8_BAR;
            PG8_LDA(At, 0, 1); PG8_STAGE(PG8_SA(0, 0), a2, voffA);
            PG8_BAR; PG8_WAIT_L(0); PG8_MMA(1, 0, At, B0); PG8_BAR; PG8_SCHED;
            PG8_STAGE(PG8_SB(0, 1), b2 + hstep, voffB);
            PG8_WAIT_V(6); PG8_BAR; PG8_MMA(1, 1, At, B1); PG8_BAR;
            PG8_LDB(B0, 1, 0); PG8_SCHED; PG8_LDA(At, 1, 0); PG8_STAGE(PG8_SA(0, 1), a2 + hstep, voffA);
            PG8_WAIT_L(8); PG8_BAR; PG8_WAIT_L(0); PG8_MMA(0, 0, At, B0); PG8_BAR; PG8_SCHED;
            PG8_LDB(B1, 1, 1); PG8_STAGE(PG8_SB(1, 0), b3, voffB);
            PG8_BAR; PG8_WAIT_L(0); PG8_MMA(0, 1, At, B1); PG8_BAR;
            PG8_LDA(At, 1, 1); PG8_STAGE(PG8_SA(1, 0), a3, voffA);
            PG8_BAR; PG8_WAIT_L(0); PG8_MMA(1, 0, At, B0); PG8_BAR; PG8_SCHED;
            PG8_STAGE(PG8_SB(1, 1), b3 + hstep, voffB);
            PG8_WAIT_V(6); PG8_BAR; PG8_MMA(1, 1, At, B1); PG8_BAR;
            }
        }
        if constexpr (ALIGN_EPI) { if (wr == 0) PG8_BAR; }
        if constexpr (!Epi::AFTER_DRAIN) { E(acc, cur, wr, wc, fr, fq); S.done(cur); }
        if (!has_next) break;
#pragma unroll
        for (int a = 0; a < 2; ++a)
#pragma unroll
            for (int b = 0; b < 2; ++b)
#pragma unroll
                for (int m = 0; m < 4; ++m)
#pragma unroll
                    for (int n = 0; n < 2; ++n) acc[a][b][m][n] = (f32x4){0.f, 0.f, 0.f, 0.f};
        cur = nxt; cA = nA; cB = nB; ++ui;
        if constexpr (ALIGN_EPI) { if (wr == 1) PG8_BAR; }
    }
    PG8_WAIT_V(0);
    if constexpr (!ALIGN_EPI) { if (wr == 0) PG8_BAR; }
    PG8_BAR;
    if constexpr (Epi::AFTER_DRAIN) { E.fused(acc, cur, wr, wc, fr, fq, lds, wid, lane); S.done(cur); }
#undef PG8_SA
#undef PG8_SB
#undef PG8_STAGE
#undef PG8_LDA
#undef PG8_LDB
#undef PG8_MMA
#undef PG8_WAIT_V
#undef PG8_WAIT_L
#undef PG8_BAR
#undef PG8_SCHED
}
}
#ifndef PG8_SP2
#define PG8_SP2 true
#endif
#ifndef PG8_ALIGN
#define PG8_ALIGN true
#endif
#include <hip/hip_bf16.h>
#include <cmath>
namespace attn_body {
using bf16=__hip_bfloat16;
using bf16x8=__attribute__((ext_vector_type(8)))short;
using s16x4=__attribute__((ext_vector_type(4)))short;
using f32x16=__attribute__((ext_vector_type(16)))float;
using u32x4=__attribute__((ext_vector_type(4)))unsigned;
constexpr int BATCH=4,NHEAD=8,SEQ=8192,D=64,QPITCH=512,KVPITCH=128,OPITCH=1024;
constexpr int NW=8,QBLK=32,QB=QBLK*NW,KVBLK=64,NQB=SEQ/QB;
constexpr int ATTN_UNIT_ROWS=QB;
__device__ __forceinline__ int crow(int r,int hi){return (r&3)+8*(r>>2)+4*hi;}
#define SBAR() __builtin_amdgcn_sched_barrier(0)
__device__ __forceinline__ void cmask(f32x16&p0,f32x16&p1,int jb,int qrel,int hi){
  const float NEG=-INFINITY; int kb=64*jb+4*hi;
  #pragma unroll
  for(int r=0;r<16;++r){int kv=kb+(r&3)+8*(r>>2); if(kv>qrel)p0[r]=NEG; if(kv+32>qrel)p1[r]=NEG;}
}

constexpr int NSLOT=3, SLOTB=8192;
constexpr int LDS_K=0, LDS_V=NSLOT*SLOTB, LDS_WS=2*NSLOT*SLOTB, LDS_OST=LDS_WS+NW*64*4, LDS_BYTES=LDS_OST+NW*4096;
constexpr float C2=0.125f*1.4426950408889634f;
__device__ __forceinline__ void glds16(const void*gsrc,unsigned lds_dst){unsigned keep;
  asm volatile("s_mov_b32 %0, m0\n\ts_mov_b32 m0, %2\n\ts_nop 0\n\tglobal_load_lds_dwordx4 %1, off\n\ts_mov_b32 m0, %0":"=&s"(keep):"v"(gsrc),"s"(lds_dst):"memory");}
__device__ __forceinline__ float max3f(float a,float b,float c){float r;asm("v_max3_f32 %0, %1, %2, %3":"=v"(r):"v"(a),"v"(b),"v"(c));return r;}
__device__ __forceinline__ float max2f(float a,float b){float r;asm("v_max_f32_e32 %0, %1, %2":"=v"(r):"v"(a),"v"(b));return r;}
__device__ __forceinline__ float fadd_s(float a,float b){float r;asm("v_add_f32_e32 %0, %1, %2":"=v"(r):"v"(a),"v"(b));return r;}
__device__ __forceinline__ float fsub_s(float a,float b){float r;asm("v_sub_f32_e32 %0, %1, %2":"=v"(r):"v"(a),"v"(b));return r;}
typedef float f32x2_t __attribute__((ext_vector_type(2))); typedef __bf16 bf16x2_t __attribute__((ext_vector_type(2)));
__device__ __forceinline__ unsigned cvtpk_s(float lo,float hi){f32x2_t v={lo,hi};bf16x2_t b=__builtin_convertvector(v,bf16x2_t);return __builtin_bit_cast(unsigned,b);}
#define WAIT_BAR(N) asm volatile("s_waitcnt lgkmcnt(0)\n\ts_barrier":::"memory")
#define WAIT_BARC(N,NV) do{ if(kwave){WAIT_BAR(N);}else{WAIT_BAR(NV);} }while(0)

typedef int v8i_t __attribute__((ext_vector_type(8))); typedef int v4i_t __attribute__((ext_vector_type(4)));
__device__ __forceinline__ v8i_t cat8(const v4i_t a,const v4i_t b){return (v8i_t){a.x,a.y,a.z,a.w,b.x,b.y,b.z,b.w};}
__device__ __forceinline__ f32x16 qk8(const v8i_t kf,const v8i_t qf,const f32x16 c){return __builtin_amdgcn_mfma_scale_f32_32x32x64_f8f6f4(kf,qf,c,0,0,0,0,0,0);}
__device__ __forceinline__ void qkt(f32x16&p0,f32x16&p1,const char*Kslot,const v8i_t qr,const f32x16&negm,int r32,int hi){
  const char*kb=Kslot+hi*2048+r32*16;
  const v4i_t a0=*reinterpret_cast<const v4i_t*>(kb),a1=*reinterpret_cast<const v4i_t*>(kb+1024),b0=*reinterpret_cast<const v4i_t*>(kb+512),b1=*reinterpret_cast<const v4i_t*>(kb+1536);
  p0=qk8(cat8(a0,a1),qr,negm);p1=qk8(cat8(b0,b1),qr,negm);
}
typedef __attribute__((address_space(3))) const char* lds_cptr;
typedef short v4i16_t __attribute__((ext_vector_type(4)));
typedef __attribute__((address_space(3))) const v4i_t* lds_v4p;
__device__ __forceinline__ void kload2(v8i_t*kf,lds_cptr kp,int j){ kf[j]=cat8(*(lds_v4p)(kp+j*512),*(lds_v4p)(kp+j*512+1024)); }
__device__ __forceinline__ void kload8(v8i_t*kf,lds_cptr kp){ kload2(kf,kp,0); kload2(kf,kp,1); }
__device__ __forceinline__ s16x4 vtr(lds_cptr p){ return __builtin_bit_cast(s16x4,__builtin_amdgcn_ds_read_tr16_b64_v4i16((__attribute__((address_space(3))) v4i16_t*)p)); }
__device__ __forceinline__ float rowmax(const f32x16&p0,const f32x16&p1){
  float a=max3f(p0[0],p0[1],p1[0]),b=max3f(p0[2],p0[3],p1[1]);a=max3f(a,p1[2],p1[3]);
  #pragma unroll
  for(int r=4;r<16;r+=4){a=max3f(a,p0[r],p0[r+1]);b=max3f(b,p0[r+2],p0[r+3]);a=max3f(a,p1[r],p1[r+1]);b=max3f(b,p1[r+2],p1[r+3]);}
  const float m=max2f(a,b);
  auto rr=__builtin_amdgcn_permlane32_swap(__float_as_uint(m),__float_as_uint(m),false,false);
  return max2f(__uint_as_float(rr[0]),__uint_as_float(rr[1]));
}
__device__ __forceinline__ f32x16 pv8(const v8i_t pa,const v8i_t vb,const f32x16 c){return __builtin_amdgcn_mfma_scale_f32_32x32x64_f8f6f4(pa,vb,c,1,0,0,0,0,0);}
#define PKASM(w,a,b,c,d) do{ int t_; asm volatile("v_cvt_pkrtz_f16_f32 %0, %2, %3\n\tv_cvt_pkrtz_f16_f32 %1, %4, %5\n\tv_perm_b32 %0, %1, %0, %6":"=&v"(w),"=&v"(t_):"v"(a),"v"(b),"v"(c),"v"(d),"s"(0x07050301)); }while(0)
#define PKASML(w,a,b,c,d) do{ int t_; asm volatile("v_cvt_pkrtz_f16_f32 %0, %2, %3\n\tv_cvt_pkrtz_f16_f32 %1, %4, %5\n\tv_perm_b32 %0, %1, %0, %6\n\ts_nop 1":"=&v"(w),"=&v"(t_):"v"(a),"v"(b),"v"(c),"v"(d),"s"(0x07050301)); }while(0)
__device__ __forceinline__ int pk8(float a,float b,float c,float d){int w=0;w=__builtin_amdgcn_cvt_pk_bf8_f32(a,b,w,false);w=__builtin_amdgcn_cvt_pk_bf8_f32(c,d,w,true);return w;}
__device__ __forceinline__ void pv(f32x16*o,lds_cptr vp,const v8i_t pw){
  const v8i_t v0=cat8(*(lds_v4p)(vp),*(lds_v4p)(vp+1024)),v1=cat8(*(lds_v4p)(vp+512),*(lds_v4p)(vp+1536));
  o[0]=pv8(pw,v0,o[0]);o[1]=pv8(pw,v1,o[1]);
}
#ifndef ATTN_STORE16
#define ATTN_STORE16(p,v) (*(u32x4*)(p)=(v))
#endif
template<int THRL> __device__ __forceinline__ void attn_unit(int b,int h,int qb,const bf16*Q,const bf16*__restrict__ K,const bf16*__restrict__ V,bf16*O,char*shm){
  const int tid=threadIdx.x,lane=tid&63,r32=lane&31,hi=lane>>5; const int wid=__builtin_amdgcn_readfirstlane(tid>>6);
  const long rowbase=(long)b*SEQ; const int q0=qb*QB;
  const unsigned lds0=(unsigned)(uintptr_t)shm;
  float*wsf=(float*)(shm+LDS_WS)+wid*64;
  const bool kwave=wid<4;
  const unsigned char*ksrc=(const unsigned char*)K+(rowbase*128+(h>>2)*64)+(long)lane*128+(wid&3)*16;
  const unsigned char*vsrc=(const unsigned char*)V+((size_t)((b*2+(h>>2))*(SEQ/KVBLK))*4096)+(long)lane*64+(wid&3)*16;
  const unsigned char*ssrc=kwave?ksrc:vsrc; const long sstep=kwave?(long)KVBLK*128:4096L;
  typedef __attribute__((address_space(3))) u32x4* lds_w4p; const lds_w4p sdst=(lds_w4p)((__attribute__((address_space(3))) char*)shm+(kwave?LDS_K:LDS_V)+(wid&3)*1024+lane*16);
  #define LDT(t) (*reinterpret_cast<const u32x4*>(ssrc+(long)(t)*sstep))
  #define WRT(slot,reg) (*(lds_w4p)((__attribute__((address_space(3))) char*)sdst+(slot))=(reg))
  const char*Kbase=shm+LDS_K; v8i_t kf[2];
  const lds_cptr shm3=(lds_cptr)shm; const lds_cptr kp0=shm3+LDS_K+hi*2048+r32*16; const lds_cptr vp0=shm3+LDS_V+hi*2048+r32*16;
  const int NT=SEQ/KVBLK;
  u32x4 st0=LDT(0),st1=LDT(1),st2=LDT(kwave?2:1),st3=LDT(kwave?3:1),stn;
  v8i_t qr;{const unsigned char*q8=(const unsigned char*)Q+((rowbase+q0+wid*QBLK+r32)*512+h*64+hi*32);qr=cat8(*reinterpret_cast<const v4i_t*>(q8),*reinterpret_cast<const v4i_t*>(q8+16));}
  float mhat=0.f,l_reg=0.f;f32x16 o[2];o[0]=f32x16{};o[1]=f32x16{};f32x16 negm=f32x16{};asm volatile("":"+v"(negm));
  const int qrel=wid*QBLK+r32;
  #define CMASK(P0,P1,t) do{}while(0)
  bool resc=false;
  #define START(P0,P1) do{ const float rm=rowmax(P0,P1); resc=false; \
    { const float dl=rm; mhat=fadd_s(mhat,dl); \
      _Pragma("unroll") for(int r=0;r<16;++r){P0[r]=fsub_s(P0[r],dl);P1[r]=fsub_s(P1[r],dl);} \
      _Pragma("unroll") for(int r=0;r<16;++r)negm[r]=-mhat; asm volatile("":"+v"(negm)); } \
    _Pragma("unroll") for(int r=0;r<16;++r)P0[r]=__builtin_amdgcn_exp2f(P0[r]); }while(0)
  #define RESC() do{ if(resc){ asm volatile("s_waitcnt lgkmcnt(0)":::"memory"); \
      _Pragma("unroll") for(int d_=0;d_<2;++d_) _Pragma("unroll") for(int r=0;r<16;++r)o[d_][r]*=wsf[crow(r,hi)]; } }while(0)
  f32x16 pA0,pA1,pB0,pB1;
  int sl_prev=0,sl_cur=0,sl_next=SLOTB;
  #define ROT() do{sl_prev=sl_cur;sl_cur=sl_next;sl_next=(sl_next==(NSLOT-1)*SLOTB)?0:sl_next+SLOTB;}while(0)
  WRT(0,st0); if(kwave){WRT(SLOTB,st1);WRT(2*SLOTB,st2);}
  WAIT_BARC(3,0);
  qkt(pA0,pA1,Kbase,qr,negm,r32,hi);asm volatile("s_nop 15\n\ts_nop 7":"+v"(pA0),"+v"(pA1));CMASK(pA0,pA1,0);
  START(pA0,pA1);
  _Pragma("unroll") for(int r=0;r<16;++r)pA1[r]=__builtin_amdgcn_exp2f(pA1[r]);
  WAIT_BAR(0);
  if(kwave){WRT(0,st3);stn=LDT(4);}else{WRT(SLOTB,st1);stn=LDT(2);}
  ROT();
  kload8(kf,kp0+sl_cur);
  WAIT_BAR(1);
  v8i_t vf[2]; v8i_t pw8;
  #define PKW4(P,B) pk8(P[B],P[B+1],P[B+2],P[B+3])
  #define PIN(x) asm volatile("":"+v"(x))
  #define MX3(a,b,c) __builtin_fmaxf(__builtin_fmaxf((a),(b)),(c))
  #define GAPA(MF,A0,A1,A2,A3,W0,W1,PW) do{ MF; sacc+=A0; sacc+=A1; sacc+=A2; sacc+=A3; PIN(sacc); W0; W1; PIN(PW); SBAR(); }while(0)
  #define EX(v) __builtin_amdgcn_exp2f(v)
  #define GAPB(MF,X,B) do{ MF; X[B]=EX(X[B]); X[B+1]=EX(X[B+1]); X[B+2]=EX(X[B+2]); X[B+3]=EX(X[B+3]); PIN(X); SBAR(); }while(0)
  #define VRD8(j) do{ vf[j]=cat8(*(lds_v4p)(vp_+(j)*512),*(lds_v4p)(vp_+(j)*512+1024)); }while(0)
  #define KRD(G,j) do{ if(G){ kload2(kf,kp0+sl_next,j); SBAR(); } }while(0)
  #define STEP(C0,C1,P0,P1,t,GK,GV,GL) do{ SBAR(); \
    const lds_cptr vp_=vp0+sl_prev; \
    VRD8(0); SBAR(); float sacc=(P0[0]+P0[1]); \
    GAPA(C0=qk8(kf[0],qr,negm), P0[2],P0[3],P0[4],P0[5],     pw8[0]=PKW4(P0,0), (void)0, pw8); \
    VRD8(1); SBAR(); GAPA(C1=qk8(kf[1],qr,negm), P0[6],P0[7],P0[8],P0[9],     pw8[1]=PKW4(P0,4), (void)0, pw8); \
    GAPA((void)0,   P0[10],P0[11],P0[12],P0[13], pw8[2]=PKW4(P0,8), (void)0, pw8); \
    GAPA((void)0,   P0[14],P0[15],P1[0],P1[1],   pw8[3]=PKW4(P0,12), (void)0, pw8); \
    GAPA((void)0,   P1[2],P1[3],P1[4],P1[5],     pw8[4]=PKW4(P1,0), (void)0, pw8); \
    GAPA((void)0,   P1[6],P1[7],P1[8],P1[9],     pw8[5]=PKW4(P1,4), (void)0, pw8); \
    GAPA((void)0,   P1[10],P1[11],P1[12],P1[13], pw8[6]=PKW4(P1,8), (void)0, pw8); \
    GAPA((void)0,   P1[14],P1[15],0.f,0.f,       pw8[7]=PKW4(P1,12), (void)0, pw8); \
    l_reg+=sacc; \
    if(kwave){ if(GK){ WRT(sl_cur,stn); if((t)+4<NT) stn=LDT((t)+4); } } else { if(GV){ WRT(sl_next,stn); if((t)+2<NT) stn=LDT((t)+2); } } \
    CMASK(C0,C1,t); \
    { float a=MX3(C0[0],C0[1],C1[0]),b=MX3(C0[2],C0[3],C1[1]); a=MX3(a,C1[2],C1[3]); \
      _Pragma("unroll") for(int r=4;r<16;r+=4){a=MX3(a,C0[r],C0[r+1]);b=MX3(b,C0[r+2],C0[r+3]);a=MX3(a,C1[r],C1[r+1]);b=MX3(b,C1[r+2],C1[r+3]);} \
      float rm=__builtin_fmaxf(a,b); { auto rr=__builtin_amdgcn_permlane32_swap(__float_as_uint(rm),__float_as_uint(rm),false,false); rm=__builtin_fmaxf(__uint_as_float(rr[0]),__uint_as_float(rr[1])); } \
      resc=false; \
      if(__builtin_expect(__any(rm>(float)THRL),0)){ const float dl=__builtin_fmaxf(rm,0.f); mhat+=dl; \
        _Pragma("unroll") for(int r=0;r<16;++r){C0[r]-=dl;C1[r]-=dl;} \
        _Pragma("unroll") for(int r=0;r<16;++r)negm[r]=-mhat; asm volatile("":"+v"(negm)); \
        const float f=__builtin_amdgcn_exp2f(-dl); l_reg*=f; if(hi==0)wsf[r32]=f; resc=true; } } \
    SBAR(); \
    GAPB(o[0]=pv8(pw8,vf[0],o[0]), C0,0); \
    GAPB(o[1]=pv8(pw8,vf[1],o[1]), C0,4); \
    KRD(GL,0); GAPB((void)0, C0,8); \
    KRD(GL,1); GAPB((void)0, C0,12); \
    GAPB((void)0, C1,0); \
    GAPB((void)0, C1,4); \
    GAPB((void)0, C1,8); \
    GAPB((void)0, C1,12); \
    }while(0)
  int t=1;
  #undef CMASK
  #define CMASK(P0,P1,t) do{}while(0)
  for(;t+5<NT;t+=2){
    STEP(pB0,pB1,pA0,pA1,t,true,true,true);     WAIT_BAR(1); RESC(); ROT();
    STEP(pA0,pA1,pB0,pB1,t+1,true,true,true);   WAIT_BAR(1); RESC(); ROT();
  }
  #undef CMASK
  #define CMASK(P0,P1,t) do{}while(0)
  #define ENDW(tt) do{ if((tt)+3<NT){WAIT_BAR(1);} else if((tt)+2<NT){WAIT_BARC(0,1);} else {WAIT_BAR(0);} }while(0)
  for(;t+1<NT;t+=2){
    STEP(pB0,pB1,pA0,pA1,t,(t+3<NT),(t+1<NT),(t+1<NT));       ENDW(t);   RESC(); ROT();
    STEP(pA0,pA1,pB0,pB1,t+1,(t+4<NT),(t+2<NT),(t+2<NT));     ENDW(t+1); RESC(); ROT();
  }
  STEP(pB0,pB1,pA0,pA1,NT-1,false,false,false); RESC();
  { float sacc=pB0[0]+pB0[1]; _Pragma("unroll") for(int r=2;r<16;++r)sacc+=pB0[r]; _Pragma("unroll") for(int r=0;r<16;++r)sacc+=pB1[r]; l_reg+=sacc;
    pw8=(v8i_t){PKW4(pB0,0),PKW4(pB0,4),PKW4(pB0,8),PKW4(pB0,12),PKW4(pB1,0),PKW4(pB1,4),PKW4(pB1,8),PKW4(pB1,12)};
    SBAR(); pv(o,vp0+sl_cur,pw8); }
  #undef PKW4
  #undef PIN
  #undef MX3
  #undef GAPA
  #undef GAPB
  #undef EX
  #undef VRD8
  #undef KRD
  #undef STEP
  #undef ENDW
  {auto rr=__builtin_amdgcn_permlane32_swap(__float_as_uint(l_reg),__float_as_uint(l_reg),false,false);l_reg=__uint_as_float(rr[0])+__uint_as_float(rr[1]);}
  if(hi==0)wsf[32+r32]=l_reg;asm volatile("s_waitcnt lgkmcnt(0)":::"memory");
  float rli[16];
  #pragma unroll
  for(int r=0;r<16;++r)rli[r]=__builtin_amdgcn_rcpf(wsf[32+crow(r,hi)]);
  bf16*Ow=O+(rowbase+q0+wid*QBLK)*OPITCH+h*D;
  { bf16*stg=(bf16*)(shm+LDS_OST)+wid*2048;
    #pragma unroll
    for(int r=0;r<16;++r){const int orow=crow(r,hi);
      #pragma unroll
      for(int d0=0;d0<2;++d0)stg[orow*64+d0*32+r32]=__float2bfloat16(o[d0][r]*rli[r]);}
    asm volatile("s_waitcnt lgkmcnt(0)":::"memory");
    #pragma unroll
    for(int i=0;i<4;++i){const int row=i*8+(lane>>3),ch=lane&7; const u32x4 v=*(const u32x4*)(stg+row*64+ch*8); ATTN_STORE16(Ow+(long)row*OPITCH+ch*8,v);} }
  asm volatile("s_waitcnt lgkmcnt(0)\n\ts_barrier":::"memory");
  #undef LDT
  #undef WRT
  #undef CMASK
  #undef START
  #undef RESC
  #undef ROT
}
__device__ __forceinline__ void attn_unit_fast(int b,int h,int qb,const bf16*Q,const bf16*__restrict__ K,const bf16*__restrict__ V,bf16*O,char*shm){
  const int tid=threadIdx.x,lane=tid&63,r32=lane&31,hi=lane>>5; const int wid=__builtin_amdgcn_readfirstlane(tid>>6);
  const long rowbase=(long)b*SEQ; const int q0=qb*QB;
  const unsigned lds0=(unsigned)(uintptr_t)shm;
  float*wsf=(float*)(shm+LDS_WS)+wid*64;
  const bool kwave=wid<4;
  const unsigned char*sbase=kwave?(const unsigned char*)K+(rowbase*128+(h>>2)*64):(const unsigned char*)V+((size_t)((b*2+(h>>2))*(SEQ/KVBLK))*4096);
  const int svoff=kwave?lane*128+(wid&3)*16:lane*64+(wid&3)*16; const int sstep=kwave?KVBLK*128:4096;
  const __amdgpu_buffer_rsrc_t srs=__builtin_amdgcn_make_buffer_rsrc((void*)sbase,0,0x7fffffff,0x00020000);
  typedef __attribute__((address_space(3))) u32x4* lds_w4p; const lds_w4p sdst=(lds_w4p)((__attribute__((address_space(3))) char*)shm+(kwave?LDS_K:LDS_V)+(wid&3)*1024+lane*16);
  #define LDT(t) __builtin_bit_cast(u32x4,__builtin_amdgcn_raw_buffer_load_b128(srs,svoff,(t)*sstep,0))
  #define WRT(slot,reg) (*(lds_w4p)((__attribute__((address_space(3))) char*)sdst+(slot))=(reg))
  const char*Kbase=shm+LDS_K; v8i_t kf[2];
  const lds_cptr shm3=(lds_cptr)shm; const lds_cptr kp0=shm3+LDS_K+hi*2048+r32*16; const lds_cptr vp0=shm3+LDS_V+hi*2048+r32*16;
  const int NT=SEQ/KVBLK;
  u32x4 st0=LDT(0),st1=LDT(1),st2=LDT(kwave?2:1),st3=LDT(kwave?3:1),stn;
  v8i_t qr;{const unsigned char*q8=(const unsigned char*)Q+((rowbase+q0+wid*QBLK+r32)*512+h*64+hi*32);qr=cat8(*reinterpret_cast<const v4i_t*>(q8),*reinterpret_cast<const v4i_t*>(q8+16));}
  f32x16 o[2];o[0]=f32x16{};o[1]=f32x16{};f32x16 osum=f32x16{};const f32x16 negm=f32x16{};v8i_t ONES8=(v8i_t){0x38383838,0x38383838,0x38383838,0x38383838,0x38383838,0x38383838,0x38383838,0x38383838};asm volatile("":"+v"(ONES8));
  const int qrel=wid*QBLK+r32;
  #define CMASK(P0,P1,t) do{}while(0)
  #define START(P0,P1) do{ _Pragma("unroll") for(int r=0;r<16;++r)P0[r]=__builtin_amdgcn_exp2f(P0[r]); }while(0)
  #define RESC() do{}while(0)
  f32x16 pA0,pA1,pB0,pB1;
  int sl_prev=0,sl_cur=0,sl_next=SLOTB;
  #define ROT() do{sl_prev=sl_cur;sl_cur=sl_next;sl_next=(sl_next==(NSLOT-1)*SLOTB)?0:sl_next+SLOTB;}while(0)
  WRT(0,st0); if(kwave){WRT(SLOTB,st1);WRT(2*SLOTB,st2);}
  WAIT_BARC(3,0);
  qkt(pA0,pA1,Kbase,qr,negm,r32,hi);asm volatile("s_nop 15\n\ts_nop 7":"+v"(pA0),"+v"(pA1));CMASK(pA0,pA1,0);
  START(pA0,pA1);
  _Pragma("unroll") for(int r=0;r<16;++r)pA1[r]=__builtin_amdgcn_exp2f(pA1[r]);
  WAIT_BAR(0);
  if(kwave){WRT(0,st3);stn=LDT(4);}else{WRT(SLOTB,st1);stn=LDT(2);}
  ROT();
  kload8(kf,kp0+sl_cur);
  WAIT_BAR(1);
  v8i_t vf[2]; v8i_t pw8;
  #define PKW4(P,B) pk8(P[B],P[B+1],P[B+2],P[B+3])
  #define PIN(x) asm volatile("":"+v"(x))
  #define MX3(a,b,c) __builtin_fmaxf(__builtin_fmaxf((a),(b)),(c))
  #define GAPA(MF,A0,A1,A2,A3,W0,W1,PW) do{ MF; W0; W1; SBAR(); }while(0)
  #define EX(v) __builtin_amdgcn_exp2f(v)
  #define GAPB(MF,X,B) do{ MF; X[B]=EX(X[B]); X[B+1]=EX(X[B+1]); X[B+2]=EX(X[B+2]); X[B+3]=EX(X[B+3]); SBAR(); }while(0)
  #define VRD8(j) do{ vf[j]=cat8(*(lds_v4p)(vp_+(j)*512),*(lds_v4p)(vp_+(j)*512+1024)); }while(0)
  #define KRD(G,j,SN) do{ if(G){ kload2(kf,kp0+(SN),j); SBAR(); } }while(0)
  #define STEP_(C0,C1,P0,P1,t,GL,SLP,SLN,STG) do{ SBAR(); \
    const lds_cptr vp_=vp0+(SLP); \
    VRD8(0); SBAR(); \
    GAPA(C0=qk8(kf[0],qr,negm), P0[2],P0[3],P0[4],P0[5],     PKASM(pw8[0],P0[0],P0[0+1],P0[0+2],P0[0+3]), (void)0, pw8); \
    VRD8(1); SBAR(); GAPA(C1=qk8(kf[1],qr,negm), P0[6],P0[7],P0[8],P0[9],     PKASM(pw8[1],P0[4],P0[4+1],P0[4+2],P0[4+3]), (void)0, pw8); \
    GAPA((void)0,   P0[10],P0[11],P0[12],P0[13], PKASM(pw8[2],P0[8],P0[8+1],P0[8+2],P0[8+3]), (void)0, pw8); \
    GAPA((void)0,   P0[14],P0[15],P1[0],P1[1],   PKASM(pw8[3],P0[12],P0[12+1],P0[12+2],P0[12+3]), (void)0, pw8); \
    GAPA((void)0,   P1[2],P1[3],P1[4],P1[5],     PKASM(pw8[4],P1[0],P1[0+1],P1[0+2],P1[0+3]), (void)0, pw8); \
    GAPA((void)0,   P1[6],P1[7],P1[8],P1[9],     PKASM(pw8[5],P1[4],P1[4+1],P1[4+2],P1[4+3]), (void)0, pw8); \
    GAPA((void)0,   P1[10],P1[11],P1[12],P1[13], PKASM(pw8[6],P1[8],P1[8+1],P1[8+2],P1[8+3]), (void)0, pw8); \
    GAPA((void)0,   P1[14],P1[15],0.f,0.f,       PKASML(pw8[7],P1[12],P1[12+1],P1[12+2],P1[12+3]), (void)0, pw8); \
    STG; \
    CMASK(C0,C1,t); \
    SBAR(); \
    GAPB(o[0]=pv8(pw8,vf[0],o[0]), C0,0); \
    GAPB(o[1]=pv8(pw8,vf[1],o[1]), C0,4); \
    KRD(GL,0,SLN); GAPB(osum=pv8(pw8,ONES8,osum), C0,8); \
    KRD(GL,1,SLN); GAPB((void)0, C0,12); \
    GAPB((void)0, C1,0); \
    GAPB((void)0, C1,4); \
    GAPB((void)0, C1,8); \
    GAPB((void)0, C1,12); \
    }while(0)
  #define STEP(C0,C1,P0,P1,t,GK,GV,GL) STEP_(C0,C1,P0,P1,t,GL,sl_prev,sl_next, if(kwave){ if(GK){ WRT(sl_cur,stn); if((t)+4<NT) stn=LDT((t)+4); } } else { if(GV){ WRT(sl_next,stn); if((t)+2<NT) stn=LDT((t)+2); } })
  #define STEP6(C0,C1,P0,P1,t,SLP,SLN,WA) STEP_(C0,C1,P0,P1,t,true,SLP,SLN, { *(lds_w4p)(WA)=stn; stn=LDT((t)+kadd); })
  lds_w4p wa0=(lds_w4p)((__attribute__((address_space(3))) char*)sdst+(kwave?1:2)*SLOTB),wa1=(lds_w4p)((__attribute__((address_space(3))) char*)sdst+(kwave?2:0)*SLOTB),wa2=(lds_w4p)((__attribute__((address_space(3))) char*)sdst+(kwave?0:1)*SLOTB);
  asm volatile("":"+v"(wa0),"+v"(wa1),"+v"(wa2));
  const int kadd=kwave?4:2;
  int t=1;
  #undef CMASK
  #define CMASK(P0,P1,t) do{}while(0)
  for(;t+9<NT;t+=6){
    STEP6(pB0,pB1,pA0,pA1,t,  0,2*SLOTB,wa0);       WAIT_BAR(1);
    STEP6(pA0,pA1,pB0,pB1,t+1,SLOTB,0,wa1);         WAIT_BAR(1);
    STEP6(pB0,pB1,pA0,pA1,t+2,2*SLOTB,SLOTB,wa2);   WAIT_BAR(1);
    STEP6(pA0,pA1,pB0,pB1,t+3,0,2*SLOTB,wa0);       WAIT_BAR(1);
    STEP6(pB0,pB1,pA0,pA1,t+4,SLOTB,0,wa1);         WAIT_BAR(1);
    STEP6(pA0,pA1,pB0,pB1,t+5,2*SLOTB,SLOTB,wa2);   WAIT_BAR(1);
  }
  for(;t+5<NT;t+=2){
    STEP(pB0,pB1,pA0,pA1,t,true,true,true);     WAIT_BAR(1); RESC(); ROT();
    STEP(pA0,pA1,pB0,pB1,t+1,true,true,true);   WAIT_BAR(1); RESC(); ROT();
  }
  #undef CMASK
  #define CMASK(P0,P1,t) do{}while(0)
  #define ENDW(tt) do{ if((tt)+3<NT){WAIT_BAR(1);} else if((tt)+2<NT){WAIT_BARC(0,1);} else {WAIT_BAR(0);} }while(0)
  for(;t+1<NT;t+=2){
    STEP(pB0,pB1,pA0,pA1,t,(t+3<NT),(t+1<NT),(t+1<NT));       ENDW(t);   RESC(); ROT();
    STEP(pA0,pA1,pB0,pB1,t+1,(t+4<NT),(t+2<NT),(t+2<NT));     ENDW(t+1); RESC(); ROT();
  }
  STEP(pB0,pB1,pA0,pA1,NT-1,false,false,false); RESC();
  {
    pw8=(v8i_t){PKW4(pB0,0),PKW4(pB0,4),PKW4(pB0,8),PKW4(pB0,12),PKW4(pB1,0),PKW4(pB1,4),PKW4(pB1,8),PKW4(pB1,12)};
    SBAR(); pv(o,vp0+sl_cur,pw8); osum=pv8(pw8,ONES8,osum); }
  #undef PKW4
  #undef PIN
  #undef MX3
  #undef GAPA
  #undef GAPB
  #undef EX
  #undef VRD8
  #undef KRD
  #undef STEP
  #undef STEP_
  #undef STEP6
  #undef ENDW
  float rli[16];
  #pragma unroll
  for(int r=0;r<16;++r)rli[r]=__builtin_amdgcn_rcpf(osum[r]);
  bf16*Ow=O+(rowbase+q0+wid*QBLK)*OPITCH+h*D;
  { bf16*stg=(bf16*)(shm+LDS_OST)+wid*2048;
    #pragma unroll
    for(int r=0;r<16;++r){const int orow=crow(r,hi);
      #pragma unroll
      for(int d0=0;d0<2;++d0)stg[orow*64+d0*32+r32]=__float2bfloat16(o[d0][r]*rli[r]);}
    asm volatile("s_waitcnt lgkmcnt(0)":::"memory");
    #pragma unroll
    for(int i=0;i<4;++i){const int row=i*8+(lane>>3),ch=lane&7; const u32x4 v=*(const u32x4*)(stg+row*64+ch*8); ATTN_STORE16(Ow+(long)row*OPITCH+ch*8,v);} }
  asm volatile("s_waitcnt lgkmcnt(0)\n\ts_barrier":::"memory");
  #undef LDT
  #undef WRT
  #undef CMASK
  #undef START
  #undef RESC
  #undef ROT
}
constexpr int ATTN_LDS_BYTES=LDS_BYTES;
struct AttnTensors { const bf16* Q; const bf16* K; const bf16* V; bf16* O; };
struct AttnUnit { int bh; int qb; };
struct StaticOrder {
  int vcu;
  __device__ __forceinline__ explicit StaticOrder(int grid,int block):vcu((block%8)*(grid/8)+block/8){}
  __device__ __forceinline__ bool next(int i,AttnUnit&u)const{ if(i>=4)return false; const int s=vcu&7; u.bh=vcu>>3; u.qb=(i==0)?s:(i==1)?15-s:(i==2)?16+s:31-s; return true; }
  __device__ __forceinline__ void a_ready(const AttnUnit&)const{}
  __device__ __forceinline__ void done(const AttnUnit&)const{}
};
template<class Sched,int THRL=8> __device__ __forceinline__ void attn_phase(char*lds,const AttnTensors&T,const Sched&S,bool fast){
  AttnUnit u;
  if(fast){ for(int i=0;S.next(i,u);++i){ S.a_ready(u); attn_unit_fast(u.bh/NHEAD,u.bh%NHEAD,u.qb,T.Q,T.K,T.V,T.O,lds); S.done(u); } }
  else { for(int i=0;S.next(i,u);++i){ S.a_ready(u); attn_unit<THRL>(u.bh/NHEAD,u.bh%NHEAD,u.qb,T.Q,T.K,T.V,T.O,lds); S.done(u); } }
}
#undef SBAR
#undef WAIT_BAR
}

constexpr int NWAVES = 8;
#ifndef MK_N_LAUNCHES
#define MK_N_LAUNCHES 1
#endif
constexpr int N_LAUNCHES = MK_N_LAUNCHES;
constexpr int PER_PHASE = 7;

constexpr int BATCH = 4, T = 8192, D = 1024;
constexpr int M = BATCH * T;
constexpr int NIN = 1792;
constexpr int NPQ = 2048;
constexpr int NEXP = 16384;
constexpr float RMS_EPS = 1e-6f;

constexpr size_t MiB = 1u << 20;
constexpr size_t WS_CTL = 0, CTL_ZERO_BYTES = 64 * 1024;
constexpr size_t WS_WIN = 2 * MiB, WS_WOUT = 6 * MiB, WS_WQ = 8 * MiB;
constexpr size_t WS_KEYS = 12 * MiB, WS_SU = 12 * MiB + 512 * 1024, WS_ROPE = 13 * MiB, WS_IG1 = 13 * MiB + 64 * 1024, WS_RSI = 13 * MiB + 128 * 1024, WS_SS = 14 * MiB;
constexpr size_t WS_UT = 16 * MiB, WS_VT = 48 * MiB;
constexpr size_t WS_XN = 80 * MiB;
constexpr size_t WS_XQ = 144 * MiB;
constexpr size_t WS_V8T = 180 * MiB;
constexpr size_t WS_Q = 144 * MiB, WS_K = 176 * MiB, WS_H = 192 * MiB;
constexpr size_t WS_SUO = 192 * MiB;
constexpr size_t WS_MIX = 224 * MiB;
constexpr size_t WS_QP = 288 * MiB;
constexpr size_t WS_IDX = 416 * MiB, WS_GATE = 424 * MiB, WS_END = 440 * MiB;
constexpr int CW_TMO = 0, CW_CODE = 1;
constexpr int CW_BAR = 4096;
constexpr int RING_OFF = 0, RING_BYTES = 131072;
constexpr int LDSCTL_OFF = RING_BYTES, MISC_OFF = LDSCTL_OFF + 320;
constexpr int LDS_BYTES = 147456;
static_assert(MISC_OFF + 128 <= LDS_BYTES, "LDS map");
#define GAS __attribute__((address_space(1)))
#define LAS __attribute__((address_space(3)))
typedef unsigned short bf16;
typedef unsigned v4u __attribute__((ext_vector_type(4)));
typedef float f32x4 __attribute__((ext_vector_type(4)));
typedef short bf16x8 __attribute__((ext_vector_type(8)));
typedef GAS unsigned gu32;
typedef GAS unsigned long long gu64;
#define RLX_AGENT __ATOMIC_RELAXED, __HIP_MEMORY_SCOPE_AGENT
#define LDS_WAIT() asm volatile("s_waitcnt lgkmcnt(0)" ::: "memory")
#define VM_WAIT() asm volatile("s_waitcnt vmcnt(0)" ::: "memory")
__device__ __forceinline__ unsigned long long rt() { return __builtin_amdgcn_s_memrealtime(); }
__device__ __forceinline__ unsigned f2bf(float f) { unsigned u = __builtin_bit_cast(unsigned, f); return (u + 0x7fffu + ((u >> 16) & 1u)) >> 16; }
__device__ __forceinline__ unsigned pk2(float lo, float hi) { return f2bf(lo) | (f2bf(hi) << 16); }

#define XB_TMO      128
#define XB_XCNT(j)  (256  + 64 * (j))
#define XB_XSUB(j)  (1280 + 64 * (j))
#define XB_XGEN(j)  (2304 + 64 * (j))
#define XB_TOP      3328
#define XB_TOPGEN   3392
#define XCD_BAR_WORDS 3456
#define XB_SPIN_CAP (1u << 18)

__device__ __forceinline__ unsigned xb_ld(unsigned* p)              { return __hip_atomic_load(p, __ATOMIC_RELAXED, __HIP_MEMORY_SCOPE_AGENT); }
__device__ __forceinline__ unsigned xb_add(unsigned* p, unsigned v) { return __hip_atomic_fetch_add(p, v, __ATOMIC_RELAXED, __HIP_MEMORY_SCOPE_AGENT); }
__device__ __forceinline__ unsigned xb_xcc_id() { return (unsigned)__builtin_amdgcn_s_getreg((3 << 11) | 20) & 0xFu; }
#define XB_SPIN(cond, bar) do { unsigned _sp = 0; while (cond) { __builtin_amdgcn_s_sleep(1); \
    if ((++_sp & 255u) == 0u) { if (xb_ld(&(bar)[XB_TMO])) break; if (_sp > XB_SPIN_CAP) { atomicAdd(&(bar)[XB_TMO], 1u); break; } } } } while (0)

#ifndef BAR_EARLY_WB
#define BAR_EARLY_WB 0
#endif
struct XcdBarrier {
    unsigned* bar; unsigned x;
    volatile LAS unsigned* st;
};

__device__ __forceinline__ XcdBarrier xcd_barrier_post(unsigned* bar, volatile LAS unsigned* st) {
    XcdBarrier b; b.bar = bar; b.x = xb_xcc_id(); b.st = st;
    if (threadIdx.x == 0) (void)xb_add(&bar[XB_XCNT(b.x)], 1u);
    return b;
}
__device__ __forceinline__ void xcd_barrier_complete(unsigned* bar, unsigned x, unsigned& nloc, unsigned& nx) {
    const unsigned G = gridDim.x * gridDim.y * gridDim.z;
    unsigned sum, cnt, mine, sp = 0u;
    for (;;) {
        sum = 0u; cnt = 0u; mine = 0u;
#pragma unroll
        for (unsigned j = 0; j < 16; ++j) { const unsigned c = xb_ld(&bar[XB_XCNT(j)]); sum += c; cnt += (c > 0u) ? 1u : 0u; mine = (j == x) ? c : mine; }
        if (sum == G) break;
        __builtin_amdgcn_s_sleep(1);
        if ((++sp & 255u) == 0u) { if (xb_ld(&bar[XB_TMO])) break; if (sp > XB_SPIN_CAP) { atomicAdd(&bar[XB_TMO], 1u); break; } }
    }
    nloc = mine > 0u ? mine : 1u; nx = cnt > 0u ? cnt : 1u;
}

__device__ __forceinline__ void xcd_barrier(const XcdBarrier& b) {
    asm volatile("s_waitcnt vmcnt(0)" ::: "memory");
    __syncthreads();
    if (threadIdx.x == 0) {
        unsigned* bar = b.bar;
        __builtin_amdgcn_s_waitcnt(0);
        unsigned nloc = b.st[0], nx = b.st[1];
        if (nloc == 0u) { xcd_barrier_complete(bar, b.x, nloc, nx); b.st[0] = nloc; b.st[1] = nx; }
#if BAR_EARLY_WB
        __builtin_amdgcn_fence(__ATOMIC_RELEASE, "agent");
        asm volatile("s_waitcnt vmcnt(0)" ::: "memory");
#endif
        const unsigned old = xb_add(&bar[XB_XSUB(b.x)], 1u);
        const unsigned gen = old / nloc;
        if (old + 1u == (gen + 1u) * nloc) {
            __builtin_amdgcn_fence(__ATOMIC_RELEASE, "agent");
            asm volatile("s_waitcnt vmcnt(0)" ::: "memory");
            const unsigned og = xb_add(&bar[XB_TOP], 1u);
            const unsigned tg = og / nx;
            if (og + 1u == (tg + 1u) * nx) xb_add(&bar[XB_TOPGEN], 1u);
            else XB_SPIN(xb_ld(&bar[XB_TOPGEN]) == tg, bar);
            __builtin_amdgcn_fence(__ATOMIC_ACQUIRE, "agent");
            xb_add(&bar[XB_XGEN(b.x)], 1u);
            asm volatile("s_waitcnt vmcnt(0)" ::: "memory");
        } else {
            XB_SPIN(xb_ld(&bar[XB_XGEN(b.x)]) == gen, bar);
            __builtin_amdgcn_fence(__ATOMIC_ACQUIRE, "agent");
            asm volatile("s_waitcnt vmcnt(0)" ::: "memory");
        }
    }
    __syncthreads();
}

struct Frame {
    LAS unsigned char* lds;
    volatile LAS unsigned* MISC;
    gu32* ctl;
    int tid, lane, wave;
    int vcu, G;
    const float* in[16]; float* out; unsigned char* ws;
};

typedef __bf16 bf16x2_dg __attribute__((ext_vector_type(2)));
__device__ __forceinline__ float dot2bf_(unsigned a, unsigned b, float c) { return __builtin_amdgcn_fdot2_f32_bf16(__builtin_bit_cast(bf16x2_dg, a), __builtin_bit_cast(bf16x2_dg, b), c, false); }
__device__ __forceinline__ float wave_sum(float v) {
#pragma unroll
    for (int o = 1; o < 64; o <<= 1) v += __shfl_xor(v, o);
    return v;
}
__device__ __forceinline__ int win_src_col(int rho) {
    const int pn = rho >> 8, bj = (rho >> 7) & 1, wc = (rho >> 5) & 3, fq = (rho >> 3) & 3, n = (rho >> 2) & 1, e = rho & 3;
    if (pn < 2) return 64 * (4 * pn + wc) + 32 * bj + 16 * n + 4 * fq + e;
    if (pn == 2) { if (wc < 2) return 512 + 64 * wc + 32 * bj + 16 * n + 4 * fq + e; return 640 + 64 * (wc - 2) + 32 * bj + 8 * fq + 4 * n + e; }
    const int c = 128 * (pn - 3) + 32 * wc + 8 * fq + 4 * n + e;
    return (bj ? 1280 : 768) + c;
}
template <bool PERMW>
__device__ __forceinline__ void p0_transpose_item(const float* W, int K, int N, const float* ks, bf16* WT, LAS float* scr, int item, int lane) {
    const int nblk = N / 32, kb = item / nblk, nb = item % nblk, k0 = 64 * kb, n0 = 32 * nb;
    const int sc = PERMW ? win_src_col(n0 + (lane & 31)) : (n0 + (lane & 31));
#pragma unroll 8
    for (int i = 0; i < 32; ++i) { const int kk = 2 * i + (lane >> 5); float v = W[(size_t)(k0 + kk) * N + sc]; if (ks) v *= ks[k0 + kk]; scr[kk * 33 + (lane & 31)] = v; }
    LDS_WAIT(); asm volatile("" ::: "memory");
    const int c = lane & 7;
#pragma unroll
    for (int j = 0; j < 4; ++j) { const int n = (lane >> 3) + 8 * j; const LAS float* s = scr + (8 * c) * 33 + n;
        v4u o; o.x = pk2(s[0 * 33], s[1 * 33]); o.y = pk2(s[2 * 33], s[3 * 33]); o.z = pk2(s[4 * 33], s[5 * 33]); o.w = pk2(s[6 * 33], s[7 * 33]);
        *(GAS v4u*)(WT + (size_t)(n0 + n) * K + k0 + 8 * c) = o; }
    LDS_WAIT(); asm volatile("" ::: "memory");
}
template <int NR>
__device__ __forceinline__ void rms_rows_to_bf16(int lane, const float* x, const float* g, bf16* o, float* rsi, int row0, int rstride) {
    f32x4 v[NR][4];
#pragma unroll
    for (int r = 0; r < NR; ++r) { const GAS f32x4* xr = (const GAS f32x4*)(x + (size_t)(row0 + r * rstride) * D) + lane;
#pragma unroll
        for (int j = 0; j < 4; ++j) v[r][j] = xr[64 * j]; }
    f32x4 gg[4];
#pragma unroll
    for (int j = 0; j < 4; ++j) gg[j] = ((const GAS f32x4*)g + lane)[64 * j];
#pragma unroll
    for (int r = 0; r < NR; ++r) { float s = 0.f;
#pragma unroll
        for (int j = 0; j < 4; ++j) s += (v[r][j].x * v[r][j].x + v[r][j].y * v[r][j].y) + (v[r][j].z * v[r][j].z + v[r][j].w * v[r][j].w);
        const float rms = sqrtf(wave_sum(s) * (1.f / D) + RMS_EPS), rstd = 1.f / rms;
        if (lane == 0) rsi[row0 + r * rstride] = rms;
        GAS unsigned long long* o8 = (GAS unsigned long long*)(o + (size_t)(row0 + r * rstride) * D) + lane;
#pragma unroll
        for (int j = 0; j < 4; ++j) o8[64 * j] = (unsigned long long)pk2(v[r][j].x * rstd * gg[j].x, v[r][j].y * rstd * gg[j].y) | ((unsigned long long)pk2(v[r][j].z * rstd * gg[j].z, v[r][j].w * rstd * gg[j].w) << 32); }
}
__device__ __forceinline__ unsigned pack_i8x4(const f32x4 v) {
    unsigned w = 0u;
    w = __builtin_amdgcn_cvt_pk_u8_f32(__builtin_rintf(v.x) + 128.0f, 0u, w); w = __builtin_amdgcn_cvt_pk_u8_f32(__builtin_rintf(v.y) + 128.0f, 1u, w);
    w = __builtin_amdgcn_cvt_pk_u8_f32(__builtin_rintf(v.z) + 128.0f, 2u, w); w = __builtin_amdgcn_cvt_pk_u8_f32(__builtin_rintf(v.w) + 128.0f, 3u, w);
    return w ^ 0x80808080u;
}
__device__ __forceinline__ void expert_tables(Frame& F, int e_lo, int e_hi, int wi, int nw) {
    const float* pu = F.in[13]; const float* pv = F.in[14]; const float* norm2_g = F.in[10]; unsigned char* ut = F.ws + WS_UT; unsigned char* vt = F.ws + WS_VT; float* suv = (float*)(F.ws + WS_SU);
      for (int e0 = e_lo + wi; e0 < e_hi; e0 += 2 * nw) {
          f32x4 a[4][4];
#pragma unroll
          for (int r = 0; r < 4; ++r) { const int e = e0 + (r >> 1) * nw; const GAS f32x4* src = (const GAS f32x4*)(((r & 1) ? pv : pu) + (size_t)e * D + 16 * F.lane);
#pragma unroll
              for (int q = 0; q < 4; ++q) a[r][q] = src[q]; }
          const GAS f32x4* sg = (const GAS f32x4*)(norm2_g + 16 * F.lane); f32x4 gq[4];
#pragma unroll
          for (int q = 0; q < 4; ++q) gq[q] = sg[q];
#pragma unroll
          for (int r = 0; r < 4; ++r) { const int e = e0 + (r >> 1) * nw; const bool isv = (r & 1) != 0; float amax = 0.f;
#pragma unroll
              for (int q = 0; q < 4; ++q) { if (!isv) a[r][q] = a[r][q] * gq[q];
                  amax = fmaxf(amax, fmaxf(fmaxf(fabsf(a[r][q].x), fabsf(a[r][q].y)), fmaxf(fabsf(a[r][q].z), fabsf(a[r][q].w)))); }
#pragma unroll
              for (int o = 1; o < 64; o <<= 1) amax = fmaxf(amax, __shfl_xor(amax, o));
              const float scale = amax > 0.f ? amax * (1.0f / 127.0f) : 1.0f, inv = amax > 0.f ? 127.0f / amax : 0.f;
              v4u o4;
#pragma unroll
              for (int q = 0; q < 4; ++q) o4[q] = pack_i8x4(a[r][q] * inv);
              const int sl = F.lane >> 3, mm = F.lane & 7;
              if (!isv) *(GAS v4u*)(ut + ((size_t)sl * NEXP + e) * 128 + (size_t)mm * 16) = o4;
              else {
                  typedef unsigned v2u_t __attribute__((ext_vector_type(2)));
                  const v2u_t ev = (v2u_t){__builtin_amdgcn_perm(o4[1], o4[0], 0x06040200u), __builtin_amdgcn_perm(o4[3], o4[2], 0x06040200u)}, od = (v2u_t){__builtin_amdgcn_perm(o4[1], o4[0], 0x07050301u), __builtin_amdgcn_perm(o4[3], o4[2], 0x07050301u)};
                  unsigned char* row = vt + ((size_t)sl * NEXP + e) * 128 + (size_t)(mm >> 1) * 32 + (size_t)(mm & 1) * 8;
                  *(GAS v2u_t*)row = ev; *(GAS v2u_t*)(row + 16) = od; }
              if (F.lane == 0) suv[2 * e + (isv ? 1 : 0)] = scale; } }
}
__device__ __forceinline__ void p0_prologue(Frame& F) {
    LAS float* scr = (LAS float*)(F.lds + RING_OFF + F.wave * 16384);
    const int gw = F.vcu * NWAVES + F.wave, NGW = F.G * NWAVES;
    const float* w_in = F.in[2]; const float* w_out = F.in[9]; const float* peer_wq = F.in[11]; const float* norm2_g = F.in[10];
    constexpr int I_IN = (D / 64) * (NIN / 32), I_OUT = (D / 64) * (D / 32), I_WQ = (D / 64) * (NPQ / 32);
    constexpr int NITEMS = I_IN + I_OUT + I_WQ;
    for (int it = gw; it < NITEMS; it += NGW) {
        int r = it;
        if (r < I_IN) { p0_transpose_item<true>(w_in, D, NIN, nullptr, (bf16*)(F.ws + WS_WIN), scr, r, F.lane); continue; } r -= I_IN;
        if (r < I_OUT) { p0_transpose_item<false>(w_out, D, D, nullptr, (bf16*)(F.ws + WS_WOUT), scr, r, F.lane); continue; } r -= I_OUT;
        p0_transpose_item<false>(peer_wq, D, NPQ, norm2_g, (bf16*)(F.ws + WS_WQ), scr, r, F.lane);
    }
    const int gt = F.vcu * (NWAVES * 64) + F.tid, NGT = F.G * NWAVES * 64;
    { float* ig = (float*)(F.ws + WS_IG1); for (int i = gt; i < D; i += NGT) ig[i] = 1.0f / F.in[1][i]; }
    { const float* pk = F.in[12]; bf16* kb = (bf16*)(F.ws + WS_KEYS);
      for (int i = gt; i < 2 * 128 * 128 / 2; i += NGT) { const float a = pk[2 * i], b = pk[2 * i + 1]; ((GAS unsigned*)kb)[i] = pk2(a, b); } }
    { float* rt_ = (float*)(F.ws + WS_ROPE);
      for (int i = gt; i < 128 * 16; i += NGT) { const int pos = i >> 4, k = i & 15; const float inv = powf(10000.0f, -(float)k / 16.0f); const float ang = (float)pos * inv; float s, c; sincosf(ang, &s, &c); rt_[2 * i] = c; rt_[2 * i + 1] = s; } }
    expert_tables(F, 0, NEXP, gw, NGW);
    for (int m = gw; m < M; m += 4 * NGW) rms_rows_to_bf16<4>(F.lane, F.in[0], F.in[1], (bf16*)(F.ws + WS_XN), (float*)(F.ws + WS_RSI), m, NGW);
}

__device__ __forceinline__ void conv_phase(Frame& F) {
    const bf16* H = (const bf16*)(F.ws + WS_H); bf16* MIX = (bf16*)(F.ws + WS_MIX);
    const float* cw = F.in[5]; const float* cb = F.in[6]; const float* lg = F.in[7]; const float* lb = F.in[8];
    LAS unsigned short* hs = (LAS unsigned short*)(F.lds + RING_OFF);
    LAS float* co = (LAS float*)(F.lds + RING_OFF + 63488);
    const int c = F.tid;
    float w[31];
#pragma unroll
    for (int j = 0; j < 31; ++j) w[j] = cw[j * 512 + c];
    const float bias = cb[c];
    constexpr int NT_ = M / 32;
    v4u hreg[8];
#define CONV_LOADH(tile_) do { const int t0_ = (tile_) * 32, tb_ = t0_ & ~(T - 1); _Pragma("unroll") for (int q_ = 0; q_ < 8; ++q_) { const int i_ = F.tid + q_ * (NWAVES * 64); const int r_ = i_ >> 6, ch_ = i_ & 63, tk_ = t0_ - 15 + r_; \
        hreg[q_] = (v4u){0u, 0u, 0u, 0u}; if (i_ < 62 * 64 && tk_ >= tb_ && tk_ < tb_ + T) hreg[q_] = *(const GAS v4u*)(H + (size_t)tk_ * 512 + ch_ * 8); } } while (0)
    if (F.vcu < NT_) CONV_LOADH(F.vcu);
    for (int tile = F.vcu; tile < NT_; tile += F.G) {
        const int t0 = tile * 32;
#pragma unroll
        for (int q = 0; q < 8; ++q) { const int i = F.tid + q * (NWAVES * 64); if (i < 62 * 64) *(LAS v4u*)(hs + (i >> 6) * 512 + (i & 63) * 8) = hreg[q]; }
        __syncthreads();
        if (tile + F.G < NT_) CONV_LOADH(tile + F.G);
#pragma unroll 1
        for (int g = 0; g < 4; ++g) {
            float hv[38];
#pragma unroll
            for (int r = 0; r < 38; ++r) hv[r] = __uint_as_float((unsigned)hs[(g * 8 + r) * 512 + c] << 16);
#pragma unroll
            for (int tt = 0; tt < 8; ++tt) { float a = bias;
#pragma unroll
                for (int j = 0; j < 31; ++j) a += w[j] * hv[tt + j];
                co[(g * 8 + tt) * 512 + c] = a; }
        }
        __syncthreads();
#pragma unroll 1
        for (int q = 0; q < 4; ++q) { const int tt = F.wave * 4 + q;
            const f32x4 a = *(const LAS f32x4*)(co + tt * 512 + 8 * F.lane), b = *(const LAS f32x4*)(co + tt * 512 + 8 * F.lane + 4);
            const float mean = wave_sum((a.x + a.y) + (a.z + a.w) + (b.x + b.y) + (b.z + b.w)) * (1.f / 512.f);
            const f32x4 da = a - mean, db = b - mean;
            const float var = wave_sum((da.x * da.x + da.y * da.y) + (da.z * da.z + da.w * da.w) + (db.x * db.x + db.y * db.y) + (db.z * db.z + db.w * db.w)) * (1.f / 512.f);
            const float rstd = 1.f / sqrtf(var + RMS_EPS);
            const f32x4 g0 = *(const GAS f32x4*)(lg + 8 * F.lane), g1 = *(const GAS f32x4*)(lg + 8 * F.lane + 4), b0 = *(const GAS f32x4*)(lb + 8 * F.lane), b1 = *(const GAS f32x4*)(lb + 8 * F.lane + 4);
            f32x4 y0 = da * rstd * g0 + b0, y1 = db * rstd * g1 + b1;
#pragma unroll
            for (int e = 0; e < 4; ++e) { y0[e] = y0[e] * __builtin_amdgcn_rcpf(1.f + __builtin_amdgcn_exp2f(-1.4426950408889634f * y0[e])); y1[e] = y1[e] * __builtin_amdgcn_rcpf(1.f + __builtin_amdgcn_exp2f(-1.4426950408889634f * y1[e])); }
            v4u o; o.x = pk2(y0.x, y0.y); o.y = pk2(y0.z, y0.w); o.z = pk2(y1.x, y1.y); o.w = pk2(y1.z, y1.w);
            *(GAS v4u*)(MIX + (size_t)(t0 + tt) * 1024 + 512 + 8 * F.lane) = o; }
        __syncthreads();
    }
}

__device__ __forceinline__ unsigned f2sort(float x) { const unsigned u = __float_as_uint(x); return (u & 0x80000000u) ? ~u : (u | 0x80000000u); }
__device__ __forceinline__ float sort2f(unsigned s) { const unsigned u = (s & 0x80000000u) ? (s & 0x7fffffffu) : ~s; return __uint_as_float(u); }
template <bool DESC> __device__ __forceinline__ void ce(unsigned& a, unsigned& b) { const unsigned hi = a > b ? a : b, lo = a > b ? b : a; if (DESC) { a = hi; b = lo; } else { a = lo; b = hi; } }
template <int K, int J, bool DESC> __device__ __forceinline__ void bst(unsigned (&a)[16]) {
#pragma unroll
    for (int i = 0; i < 16; ++i) { const int l = i ^ J; if (l > i) { if (((i & K) == 0) == DESC) ce<true>(a[i], a[l]); else ce<false>(a[i], a[l]); } }
}
template <bool DESC> __device__ __forceinline__ void sort16(unsigned (&a)[16]) { ce<DESC>(a[0], a[1]); ce<DESC>(a[2], a[3]); ce<DESC>(a[0], a[2]); ce<DESC>(a[1], a[3]); ce<DESC>(a[1], a[2]); ce<DESC>(a[4], a[5]); ce<DESC>(a[6], a[7]); ce<DESC>(a[4], a[6]); ce<DESC>(a[5], a[7]); ce<DESC>(a[5], a[6]); ce<DESC>(a[0], a[4]); ce<DESC>(a[2], a[6]); ce<DESC>(a[2], a[4]); ce<DESC>(a[1], a[5]); ce<DESC>(a[3], a[7]); ce<DESC>(a[3], a[5]); ce<DESC>(a[1], a[2]); ce<DESC>(a[3], a[4]); ce<DESC>(a[5], a[6]); ce<DESC>(a[8], a[9]); ce<DESC>(a[10], a[11]); ce<DESC>(a[8], a[10]); ce<DESC>(a[9], a[11]); ce<DESC>(a[9], a[10]); ce<DESC>(a[12], a[13]); ce<DESC>(a[14], a[15]); ce<DESC>(a[12], a[14]); ce<DESC>(a[13], a[15]); ce<DESC>(a[13], a[14]); ce<DESC>(a[8], a[12]); ce<DESC>(a[10], a[14]); ce<DESC>(a[10], a[12]); ce<DESC>(a[9], a[13]); ce<DESC>(a[11], a[15]); ce<DESC>(a[11], a[13]); ce<DESC>(a[9], a[10]); ce<DESC>(a[11], a[12]); ce<DESC>(a[13], a[14]); ce<DESC>(a[0], a[8]); ce<DESC>(a[4], a[12]); ce<DESC>(a[4], a[8]); ce<DESC>(a[2], a[10]); ce<DESC>(a[6], a[14]); ce<DESC>(a[6], a[10]); ce<DESC>(a[2], a[4]); ce<DESC>(a[6], a[8]); ce<DESC>(a[10], a[12]); ce<DESC>(a[1], a[9]); ce<DESC>(a[5], a[13]); ce<DESC>(a[5], a[9]); ce<DESC>(a[3], a[11]); ce<DESC>(a[7], a[15]); ce<DESC>(a[7], a[11]); ce<DESC>(a[3], a[5]); ce<DESC>(a[7], a[9]); ce<DESC>(a[11], a[13]); ce<DESC>(a[1], a[2]); ce<DESC>(a[3], a[4]); ce<DESC>(a[5], a[6]); ce<DESC>(a[7], a[8]); ce<DESC>(a[9], a[10]); ce<DESC>(a[11], a[12]); ce<DESC>(a[13], a[14]); }
template <bool DESC> __device__ __forceinline__ void merge16(unsigned (&a)[16]) { bst<16, 8, DESC>(a); bst<16, 4, DESC>(a); bst<16, 2, DESC>(a); bst<16, 1, DESC>(a); }
__device__ __forceinline__ void max16(unsigned (&a)[16], const unsigned (&b)[16]) {
#pragma unroll
    for (int i = 0; i < 16; ++i) a[i] = a[i] > b[i] ? a[i] : b[i];
}
__device__ __forceinline__ void top16_of_128(unsigned (&g)[8][16]) {
    sort16<true>(g[0]); sort16<false>(g[1]); sort16<true>(g[2]); sort16<false>(g[3]); sort16<true>(g[4]); sort16<false>(g[5]); sort16<true>(g[6]); sort16<false>(g[7]);
    max16(g[0], g[1]); merge16<true>(g[0]); max16(g[2], g[3]); merge16<false>(g[2]); max16(g[4], g[5]); merge16<true>(g[4]); max16(g[6], g[7]); merge16<false>(g[6]);
    max16(g[0], g[2]); merge16<true>(g[0]); max16(g[4], g[6]); merge16<false>(g[4]);
    max16(g[0], g[4]); merge16<true>(g[0]);
}
__device__ __forceinline__ void top16_of_64(unsigned (&g)[4][16]) {
    sort16<true>(g[0]); sort16<false>(g[1]); sort16<true>(g[2]); sort16<false>(g[3]);
    max16(g[0], g[1]); merge16<true>(g[0]); max16(g[2], g[3]); merge16<false>(g[2]);
    max16(g[0], g[2]); merge16<true>(g[0]);
}

constexpr int P5_KEYS_BYTES = 65536, P5_SCR_OFF = 65536;
typedef float f32x2p5 __attribute__((ext_vector_type(2)));
__device__ __forceinline__ void topk_phase(Frame& F) {
    typedef float f32x16 __attribute__((ext_vector_type(16)));
    const bf16* QP = (const bf16*)(F.ws + WS_QP); const bf16* KEYS = (const bf16*)(F.ws + WS_KEYS);
    unsigned short* IDX = (unsigned short*)(F.ws + WS_IDX); float* GATE = (float*)(F.ws + WS_GATE); float* SUO = (float*)(F.ws + WS_SUO);
    const GAS f32x2p5* SUVt = (const GAS f32x2p5*)(F.ws + WS_SU);
    for (int i = F.tid; i < 256 * 16; i += NWAVES * 64) { const int row = i >> 4, ch = i & 15;
        const v4u v = *(const GAS v4u*)(KEYS + row * 128 + ch * 8); *(LAS v4u*)(F.lds + RING_OFF + row * 256 + ((ch ^ (row & 15)) << 4)) = v; }
    __syncthreads();
    const int lane = F.lane, r32 = lane & 31, hi = lane >> 5, h = F.wave;
    LAS unsigned char* scr = F.lds + RING_OFF + P5_SCR_OFF + F.wave * 2048 + lane * 32;
    const bool own = (F.G == 256); const int g_lo = own ? 4 * F.vcu : F.vcu, g_hi = own ? 4 * F.vcu + 4 : M / 32, g_st = own ? 1 : F.G;
    bf16x8 qf[2][8];
#define P5_LOADQ(grp_) do { const size_t tk_ = (size_t)((grp_) * 32 + r32); _Pragma("unroll") for (int s = 0; s < 2; ++s) _Pragma("unroll") for (int ks = 0; ks < 8; ++ks) \
        qf[s][ks] = *(const GAS bf16x8*)(QP + tk_ * NPQ + 256 * h + 128 * s + 16 * ks + 8 * hi); } while (0)
    for (int grp = g_lo; grp < g_hi; grp += g_st) {
        const int tok = grp * 32 + r32;
        P5_LOADQ(grp);
        f32x16 sc[2][4];
#pragma unroll
        for (int s = 0; s < 2; ++s)
#pragma unroll
            for (int kb = 0; kb < 4; ++kb) {
                f32x16 a = {};
                const int row = s * 128 + kb * 32 + r32;
#pragma unroll
                for (int ks = 0; ks < 8; ++ks) {
                    const bf16x8 kf = *(const LAS bf16x8*)(F.lds + RING_OFF + row * 256 + (((2 * ks + hi) ^ (row & 15)) << 4));
                    a = __builtin_amdgcn_mfma_f32_32x32x16_bf16(kf, qf[s][ks], a, 0, 0, 0);
                }
                sc[s][kb] = a;
            }
        unsigned g[8][16];
#pragma unroll
        for (int kb = 0; kb < 4; ++kb)
#pragma unroll
            for (int r = 0; r < 16; ++r) {
                auto rr = __builtin_amdgcn_permlane32_swap(__float_as_uint(sc[0][kb][r]), __float_as_uint(sc[1][kb][r]), false, false);
                const int key0 = 32 * kb + (r & 3) + 8 * (r >> 2);
                g[2 * kb][r] = (f2sort(__uint_as_float(rr[0])) & ~127u) | (unsigned)(127 - key0);
                g[2 * kb + 1][r] = (f2sort(__uint_as_float(rr[1])) & ~127u) | (unsigned)(127 - (key0 + 4));
            }
        top16_of_128(g);
        unsigned s1[16], s2[16];
#pragma unroll
        for (int i = 0; i < 16; ++i) { auto rr = __builtin_amdgcn_permlane32_swap(g[0][i], g[0][i], false, false); s1[i] = rr[0]; s2[i] = rr[1]; }
        {
            unsigned w1[4], w2[4];
#pragma unroll
            for (int q = 0; q < 4; ++q) {
                w1[q] = (127u - (s1[4 * q] & 127u)) | ((127u - (s1[4 * q + 1] & 127u)) << 8) | ((127u - (s1[4 * q + 2] & 127u)) << 16) | ((127u - (s1[4 * q + 3] & 127u)) << 24);
                w2[q] = (127u - (s2[4 * q] & 127u)) | ((127u - (s2[4 * q + 1] & 127u)) << 8) | ((127u - (s2[4 * q + 2] & 127u)) << 16) | ((127u - (s2[4 * q + 3] & 127u)) << 24);
            }
            *(LAS v4u*)(scr) = (v4u){w1[0], w1[1], w1[2], w1[3]}; *(LAS v4u*)(scr + 16) = (v4u){w2[0], w2[1], w2[2], w2[3]};
        }
        float v1[16], v2[16];
#pragma unroll
        for (int i = 0; i < 16; ++i) { v1[i] = sort2f(s1[i] & ~127u); v2[i] = sort2f(s2[i] & ~127u); }
        unsigned c[4][16];
        {
            int n = 0;
#pragma unroll
            for (int a = 0; a < 16; ++a)
#pragma unroll
                for (int b = 0; b < 16; ++b)
                    if ((a + 1) * (b + 1) <= 16) { c[n >> 4][n & 15] = (f2sort(v1[a] + v2[b]) & ~255u) | (unsigned)(255 - (16 * a + b)); ++n; }
#pragma unroll
            for (int q = 50; q < 64; ++q) c[q >> 4][q & 15] = 0u;
        }
        top16_of_64(c);
        asm volatile("s_waitcnt lgkmcnt(0)" ::: "memory");
        float ts[16]; unsigned ex[16];
#pragma unroll
        for (int k = 0; k < 16; ++k) {
            const unsigned ab = 255u - (c[0][k] & 255u); const unsigned a = ab >> 4, b = ab & 15u;
            const unsigned i1 = *(const LAS unsigned char*)(scr + a), i2 = *(const LAS unsigned char*)(scr + 16 + b);
            ex[k] = i1 * 128u + i2; ts[k] = sort2f(c[0][k] & ~255u);
        }
        float den = 0.f; const float tmax = ts[0];
#pragma unroll
        for (int k = 0; k < 16; ++k) { ts[k] = __builtin_amdgcn_exp2f((ts[k] - tmax) * 1.4426950408889634f); den += ts[k]; }
        const float rden = __builtin_amdgcn_rcpf(den);
        unsigned eo[8]; float go[8];
#pragma unroll
        for (int k = 0; k < 8; ++k) { eo[k] = hi ? ex[k + 8] : ex[k]; go[k] = (hi ? ts[k + 8] : ts[k]) * rden; }
        float so[8];
#pragma unroll
        for (int k = 0; k < 8; ++k) { const f32x2p5 sv2 = SUVt[eo[k]]; so[k] = sv2.x; go[k] *= sv2.y; }
        const size_t ob = (size_t)tok * 128 + h * 16 + hi * 8;
        *(GAS v4u*)(IDX + ob) = (v4u){eo[0] | (eo[1] << 16), eo[2] | (eo[3] << 16), eo[4] | (eo[5] << 16), eo[6] | (eo[7] << 16)};
        *(GAS f32x4*)(GATE + ob) = (f32x4){go[0], go[1], go[2], go[3]}; *(GAS f32x4*)(GATE + ob + 4) = (f32x4){go[4], go[5], go[6], go[7]};
        *(GAS f32x4*)(SUO + ob) = (f32x4){so[0], so[1], so[2], so[3]}; *(GAS f32x4*)(SUO + ob + 4) = (f32x4){so[4], so[5], so[6], so[7]};
    }
#undef P5_LOADQ
    __syncthreads();
}

typedef float f32x2 __attribute__((ext_vector_type(2)));
__device__ __forceinline__ v4u bufload16(__amdgpu_buffer_rsrc_t rsrc, unsigned voff, unsigned soff) { return __builtin_bit_cast(v4u, __builtin_amdgcn_raw_buffer_load_b128(rsrc, (int)voff, (int)soff, 0)); }
__device__ __forceinline__ int dot4(unsigned a, unsigned b, int c) { return __builtin_amdgcn_sdot4((int)a, (int)b, c, false); }
template <int CTRL> __device__ __forceinline__ int dpp_mov(int v) { return __builtin_amdgcn_update_dpp(0, v, CTRL, 0xf, 0xf, false); }
#ifndef P6_PREFETCH
#define P6_PREFETCH 0
#endif
template <bool VPASS>
__device__ __forceinline__ void p6_load(v4u (&u)[16], v4u& xq, unsigned& x1w, const __amdgpu_buffer_rsrc_t rt, const unsigned char* XQ, const bf16* X1B, LAS unsigned* ids, int tok0, int it, int g, int m,
                                        const __amdgpu_buffer_rsrc_t rpf_u, const __amdgpu_buffer_rsrc_t rpf_v, unsigned pfbase, int lane, unsigned& pv) {
    const int s = it >> 4, t = it & 15; const unsigned soff = (unsigned)s << 21;
    pv = 0u;
#if P6_PREFETCH
    if (lane < 4) {
        const bool last = (s == 7);
        if (!(VPASS && last)) {
            const unsigned nso = last ? 0u : (unsigned)(s + 1) << 21;
            pv = (unsigned)__builtin_amdgcn_raw_buffer_load_b32((!VPASS && !last) ? rpf_u : rpf_v, (int)(pfbase + 512u * (unsigned)t + 128u * (unsigned)lane), (int)nso, 0);
        }
    }
#endif
    if (VPASS) x1w = __builtin_nontemporal_load((const GAS unsigned*)(X1B + (size_t)(tok0 + t) * D + 128 * s + 2 * lane));
    else xq = __builtin_nontemporal_load((const GAS v4u*)(XQ + (size_t)(tok0 + t) * D + 128 * s + 16 * m));
    const v4u ia = *(const LAS v4u*)(ids + t * 64 + 8 * g), ib = *(const LAS v4u*)(ids + t * 64 + 8 * g + 4);
    const unsigned idw[8] = {ia.x, ia.y, ia.z, ia.w, ib.x, ib.y, ib.z, ib.w};
#pragma unroll
    for (int k = 0; k < 16; ++k) { const unsigned id = (k & 1) ? (idw[k >> 1] >> 16) : (idw[k >> 1] & 0xffffu); u[k] = bufload16(rt, (id << 7) | ((unsigned)m << 4), soff); }
}
__device__ __forceinline__ void p6_comp_u(const v4u (&u)[16], const v4u xq, LAS int* da, int it, int lane) {
    const int t = it & 15;
    int p[16];
#pragma unroll
    for (int k = 0; k < 16; ++k) { int q0; asm("v_dot4_i32_i8 %0, %1, %2, 0" : "=v"(q0) : "v"(u[k].x), "v"(xq.x));
        p[k] = dot4(u[k].w, xq.w, dot4(u[k].z, xq.z, dot4(u[k].y, xq.y, q0))); }
    asm volatile("s_nop 1\n\t"
        "v_add_u32_dpp %0, %0, %0 row_half_mirror row_mask:0xf bank_mask:0x5\n\tv_add_u32_dpp %1, %1, %1 row_half_mirror row_mask:0xf bank_mask:0x5\n\t"
        "v_add_u32_dpp %2, %2, %2 row_half_mirror row_mask:0xf bank_mask:0x5\n\tv_add_u32_dpp %3, %3, %3 row_half_mirror row_mask:0xf bank_mask:0x5\n\t"
        "v_add_u32_dpp %4, %4, %4 row_half_mirror row_mask:0xf bank_mask:0x5\n\tv_add_u32_dpp %5, %5, %5 row_half_mirror row_mask:0xf bank_mask:0x5\n\t"
        "v_add_u32_dpp %6, %6, %6 row_half_mirror row_mask:0xf bank_mask:0x5\n\tv_add_u32_dpp %7, %7, %7 row_half_mirror row_mask:0xf bank_mask:0x5\n\t"
        "v_add_u32_dpp %0, %8, %8 row_half_mirror row_mask:0xf bank_mask:0xa\n\tv_add_u32_dpp %1, %9, %9 row_half_mirror row_mask:0xf bank_mask:0xa\n\t"
        "v_add_u32_dpp %2, %10, %10 row_half_mirror row_mask:0xf bank_mask:0xa\n\tv_add_u32_dpp %3, %11, %11 row_half_mirror row_mask:0xf bank_mask:0xa\n\t"
        "v_add_u32_dpp %4, %12, %12 row_half_mirror row_mask:0xf bank_mask:0xa\n\tv_add_u32_dpp %5, %13, %13 row_half_mirror row_mask:0xf bank_mask:0xa\n\t"
        "v_add_u32_dpp %6, %14, %14 row_half_mirror row_mask:0xf bank_mask:0xa\n\tv_add_u32_dpp %7, %15, %15 row_half_mirror row_mask:0xf bank_mask:0xa\n\ts_nop 1"
        : "+v"(p[0]), "+v"(p[1]), "+v"(p[2]), "+v"(p[3]), "+v"(p[4]), "+v"(p[5]), "+v"(p[6]), "+v"(p[7])
        : "v"(p[8]), "v"(p[9]), "v"(p[10]), "v"(p[11]), "v"(p[12]), "v"(p[13]), "v"(p[14]), "v"(p[15]));
    { const bool up = (lane & 2) != 0;
#pragma unroll
      for (int k = 0; k < 4; ++k) { const int keep = up ? p[k + 4] : p[k], send = up ? p[k] : p[k + 4]; p[k] = keep + dpp_mov<0x4E>(send); } }
    { const bool up = (lane & 1) != 0;
#pragma unroll
      for (int k = 0; k < 2; ++k) { const int keep = up ? p[k + 2] : p[k], send = up ? p[k] : p[k + 2]; p[k] = keep + dpp_mov<0xB1>(send); } }
    typedef int i32x2 __attribute__((ext_vector_type(2)));
    LAS i32x2* dp = (LAS i32x2*)(da + t * 128 + 2 * lane); i32x2 dv = *dp; dv.x += p[0]; dv.y += p[1]; *dp = dv;
}
typedef int v2i32_t __attribute__((ext_vector_type(2)));
constexpr int P6_PLANE = 1040;
__device__ __forceinline__ void p6_comp_v(const v4u (&u)[16], const unsigned x1w, LAS unsigned char* img, const LAS unsigned char* wq, const LAS float* sc, bf16* XF, int tok0, int it, int lane, int g, int m) {
    const int s = it >> 4, t = it & 15;
    const int h = lane >> 5, pp = (lane >> 4) & 1, i16 = lane & 15;
    LAS unsigned char* wa = img + m * P6_PLANE + (8 * g) * 16;
    const LAS unsigned char* ra = img + (4 * h) * P6_PLANE + (8 * pp + (i16 >> 1)) * 16 + 8 * (i16 & 1);
    v4u W4[4];
#pragma unroll
    for (int n = 0; n < 4; ++n) W4[n] = *(const LAS v4u*)(wq + t * 128 + (2 * n + pp) * 16);
    int a[4] = {0, 0, 0, 0};
#pragma unroll
    for (int hf = 0; hf < 2; ++hf) {
#pragma unroll
        for (int k = 0; k < 8; ++k) *(LAS v4u*)(wa + 16 * k) = u[8 * hf + k];
#pragma unroll
        for (int n = 0; n < 4; ++n)
#pragma unroll
            for (int dbi = 0; dbi < 4; ++dbi) {
                const v2i32_t v = __builtin_amdgcn_ds_read_tr8_b64_v2i32((LAS v2i32_t*)(ra + dbi * P6_PLANE + 256 * n));
                a[dbi] = dot4((unsigned)v.y, W4[n][2 * hf + 1], dot4((unsigned)v.x, W4[n][2 * hf], a[dbi]));
            }
    }
    int tot[2];
#pragma unroll
    for (int d = 0; d < 2; ++d) { auto rr = __builtin_amdgcn_permlane16_swap((unsigned)a[d], (unsigned)a[d + 2], false, false); tot[d] = (int)rr[0] + (int)rr[1]; }
    const float sw = sc[16 + t];
    const float xf0 = __uint_as_float(x1w << 16) + (float)tot[0] * sw, xf1 = __uint_as_float(x1w & 0xffff0000u) + (float)tot[1] * sw;
    __builtin_nontemporal_store(pk2(xf0, xf1), (GAS unsigned*)(XF + (size_t)(tok0 + t) * D + 128 * s + 2 * lane));
}
__device__ __forceinline__ void peer_phase(Frame& F) {
    const bf16* X1B = (const bf16*)(F.ws + WS_XN); bf16* XF = (bf16*)(F.ws + WS_MIX);
    unsigned char* XQ = F.ws + WS_XQ;
    const unsigned short* IDX = (const unsigned short*)(F.ws + WS_IDX); const float* GATE = (const float*)(F.ws + WS_GATE); const float* SS = (const float*)(F.ws + WS_SS);
    const float* SUO = (const float*)(F.ws + WS_SUO);
    const float* fg = F.in[15]; float* OUT = F.out;
    const int lane = F.lane, g = lane >> 3, m = lane & 7;
    const __amdgpu_buffer_rsrc_t ru = __builtin_amdgcn_make_buffer_rsrc((void*)(F.ws + WS_UT), 0, 16 << 20, 0x00020000);
    const __amdgpu_buffer_rsrc_t rv = __builtin_amdgcn_make_buffer_rsrc((void*)(F.ws + WS_VT), 0, 16 << 20, 0x00020000);
    LAS unsigned char* wl = F.lds + RING_OFF + F.wave * 16384;
    LAS unsigned* ids = (LAS unsigned*)wl;
    LAS int* da = (LAS int*)(wl + 4096);
    LAS unsigned char* img = wl + 4096;
    LAS unsigned char* wq = wl + 12416;
    LAS float* sc = (LAS float*)(wl + 14464);
    const int gw = F.vcu * NWAVES + F.wave, NGW = F.G * NWAVES;
    const unsigned pfbase = (unsigned)(((F.vcu & 31) * NWAVES + F.wave) * 8192);
    for (int tg = gw; tg < M / 16; tg += NGW) {
        const int tok0 = tg * 16;
#pragma unroll 1
        for (int tb = 0; tb < 16; tb += 4) {
            v4u xa[4], xb[4]; unsigned idv[4];
#pragma unroll
            for (int j = 0; j < 4; ++j) { const int t = tb + j;
                idv[j] = *(const GAS unsigned*)(IDX + (size_t)(tok0 + t) * 128 + 2 * lane);
                const GAS v4u* xp = (const GAS v4u*)(X1B + (size_t)(tok0 + t) * D + 16 * lane); xa[j] = xp[0]; xb[j] = xp[1]; }
#pragma unroll
            for (int j = 0; j < 4; ++j) { const int t = tb + j;
                ids[t * 64 + lane] = idv[j];
                typedef int i32x2 __attribute__((ext_vector_type(2)));
                *(LAS i32x2*)(da + t * 128 + 2 * lane) = (i32x2){0, 0};
                const unsigned xw[8] = {xa[j].x, xa[j].y, xa[j].z, xa[j].w, xb[j].x, xb[j].y, xb[j].z, xb[j].w};
                float xv[16]; float amax = 0.f;
#pragma unroll
                for (int q = 0; q < 8; ++q) { xv[2 * q] = __uint_as_float(xw[q] << 16); xv[2 * q + 1] = __uint_as_float(xw[q] & 0xffff0000u); amax = fmaxf(amax, fmaxf(fabsf(xv[2 * q]), fabsf(xv[2 * q + 1]))); }
#pragma unroll
                for (int o = 1; o < 64; o <<= 1) amax = fmaxf(amax, __shfl_xor(amax, o));
                const float inv = amax > 0.f ? 127.0f / amax : 0.f;
                v4u o4;
#pragma unroll
                for (int q = 0; q < 4; ++q) o4[q] = pack_i8x4((f32x4){xv[4 * q], xv[4 * q + 1], xv[4 * q + 2], xv[4 * q + 3]} * inv);
                *(GAS v4u*)(XQ + (size_t)(tok0 + t) * D + 16 * lane) = o4;
                if (lane == 0) sc[t] = amax > 0.f ? amax * (1.0f / 127.0f) : 1.0f; }
        }
        asm volatile("s_waitcnt vmcnt(0)" ::: "memory");
        {
            v4u uA[16], uB[16]; v4u xA, xB; unsigned dummy; unsigned pvA, pvB, pfacc = 0u;
            p6_load<false>(uA, xA, dummy, ru, XQ, X1B, ids, tok0, 0, g, m, ru, rv, pfbase, lane, pvA);
#pragma unroll 1
            for (int it = 0; it < 128; it += 2) {
                p6_load<false>(uB, xB, dummy, ru, XQ, X1B, ids, tok0, it + 1, g, m, ru, rv, pfbase, lane, pvB);
                p6_comp_u(uA, xA, da, it, lane);
                pfacc ^= pvA; p6_load<false>(uA, xA, dummy, ru, XQ, X1B, ids, tok0, (it + 2 < 128) ? it + 2 : 127, g, m, ru, rv, pfbase, lane, pvA);
                p6_comp_u(uB, xB, da, it + 1, lane); pfacc ^= pvB;
            }
            asm volatile("" :: "v"(pfacc ^ pvA));
        }
#pragma unroll 1
        for (int tb = 0; tb < 16; tb += 4) {
            float ssv[4]; f32x2 gt2[4]; f32x2 su2[4];
#pragma unroll
            for (int j = 0; j < 4; ++j) { const int t = tb + j, tok = tok0 + t;
                ssv[j] = (lane < 16) ? SS[(size_t)tok * 16 + lane] : 0.f;
                gt2[j] = *(const GAS f32x2*)(GATE + (size_t)tok * 128 + 2 * lane);
                su2[j] = *(const GAS f32x2*)(SUO + (size_t)tok * 128 + 2 * lane); }
#pragma unroll
            for (int j = 0; j < 4; ++j) { const int t = tb + j;
                const float rstd2 = 1.f / sqrtf(wave_sum(ssv[j]) * (1.f / D) + RMS_EPS);
                typedef int i32x2 __attribute__((ext_vector_type(2)));
                const i32x2 dv = *(const LAS i32x2*)(da + t * 128 + 2 * lane);
                const float zs = sc[t] * rstd2;
                const float z0 = (float)dv.x * su2[j].x * zs, z1 = (float)dv.y * su2[j].y * zs;
                const float h0 = z0 * __builtin_amdgcn_rcpf(1.f + __builtin_amdgcn_exp2f(-1.4426950408889634f * 1.5957691216057308f * (z0 + 0.044715f * z0 * z0 * z0)));
                const float h1 = z1 * __builtin_amdgcn_rcpf(1.f + __builtin_amdgcn_exp2f(-1.4426950408889634f * 1.5957691216057308f * (z1 + 0.044715f * z1 * z1 * z1)));
                const float w0 = gt2[j].x * h0, w1 = gt2[j].y * h1;
                float wmax = fmaxf(fabsf(w0), fabsf(w1));
#pragma unroll
                for (int o = 1; o < 64; o <<= 1) wmax = fmaxf(wmax, __shfl_xor(wmax, o));
                const float winv = wmax > 0.f ? 127.0f / wmax : 0.f;
                const int q0 = (int)__builtin_rintf(w0 * winv), q1 = (int)__builtin_rintf(w1 * winv);
                *(LAS unsigned short*)(wq + t * 128 + 2 * lane) = (unsigned short)((q0 & 0xff) | ((q1 & 0xff) << 8));
                if (lane == 0) sc[16 + t] = wmax * (1.0f / 127.0f); }
        }
        {
            v4u uA[16], uB[16]; unsigned xA, xB; v4u dummy; unsigned pvA, pvB, pfacc = 0u;
            p6_load<true>(uA, dummy, xA, rv, XQ, X1B, ids, tok0, 0, g, m, ru, rv, pfbase, lane, pvA);
#pragma unroll 1
            for (int it = 0; it < 128; it += 2) {
                p6_load<true>(uB, dummy, xB, rv, XQ, X1B, ids, tok0, it + 1, g, m, ru, rv, pfbase, lane, pvB);
                p6_comp_v(uA, xA, img, wq, sc, XF, tok0, it, lane, g, m);
                pfacc ^= pvA; p6_load<true>(uA, dummy, xA, rv, XQ, X1B, ids, tok0, (it + 2 < 128) ? it + 2 : 127, g, m, ru, rv, pfbase, lane, pvA);
                p6_comp_v(uB, xB, img, wq, sc, XF, tok0, it + 1, lane, g, m); pfacc ^= pvB;
            }
            asm volatile("" :: "v"(pfacc ^ pvA));
        }
#pragma unroll 1
        for (int tb = 0; tb < 16; tb += 4) {
            unsigned xw[4][8];
#pragma unroll
            for (int j = 0; j < 4; ++j)
#pragma unroll
                for (int s = 0; s < 8; ++s) xw[j][s] = *(const GAS unsigned*)(XF + (size_t)(tok0 + tb + j) * D + 128 * s + 2 * lane);
            f32x2 gg[8];
#pragma unroll
            for (int s = 0; s < 8; ++s) gg[s] = *(const GAS f32x2*)(fg + 128 * s + 2 * lane);
#pragma unroll
            for (int j = 0; j < 4; ++j) {
                float ss = 0.f;
#pragma unroll
                for (int s = 0; s < 8; ++s) { const float a0 = __uint_as_float(xw[j][s] << 16), a1 = __uint_as_float(xw[j][s] & 0xffff0000u); ss += a0 * a0 + a1 * a1; }
                const float rstd = 1.f / sqrtf(wave_sum(ss) * (1.f / D) + RMS_EPS);
#pragma unroll
                for (int s = 0; s < 8; ++s) { const size_t off = (size_t)(tok0 + tb + j) * D + 128 * s + 2 * lane;
                    f32x2 ov = (f32x2){__uint_as_float(xw[j][s] << 16) * rstd * gg[s].x, __uint_as_float(xw[j][s] & 0xffff0000u) * rstd * gg[s].y};
                    __builtin_nontemporal_store(ov, (GAS f32x2*)(OUT + off)); }
            }
        }
    }
}

struct Args { const float* in[16]; float* out; unsigned char* ws; int ph_lo, ph_hi, li, pad; };
__global__ void __launch_bounds__(NWAVES * 64, 2) mk_fwd(Args args) {
    extern __shared__ __attribute__((aligned(16))) unsigned char lds[];
    Frame F;
    F.lds = (LAS unsigned char*)lds;
    F.MISC = (volatile LAS unsigned*)(F.lds + MISC_OFF);
    F.tid = threadIdx.x; F.lane = F.tid & 63; F.wave = __builtin_amdgcn_readfirstlane(F.tid >> 6);
    F.G = gridDim.x; { const int bx = blockIdx.x; F.vcu = (F.G % 8 == 0) ? (bx % 8) * (F.G / 8) + bx / 8 : bx; }
#define GRID_BAR(seam) do { if (N_LAUNCHES == PER_PHASE) { if (F.tid == 0) __hip_atomic_store(F.ctl + CW_TMO, 0xBADBA0u | (unsigned)(seam), RLX_AGENT); } \
    else { xcd_barrier(bar); } } while (0)
    unsigned char* ws = args.ws;
    F.ctl = (gu32*)(ws + WS_CTL); F.ws = ws; F.out = args.out;
#pragma unroll
    for (int i = 0; i < 16; ++i) F.in[i] = args.in[i];
    for (int u = F.tid; u < (LDS_BYTES - LDSCTL_OFF) / 4; u += NWAVES * 64) ((LAS unsigned*)(F.lds + LDSCTL_OFF))[u] = 0u;
    __syncthreads();
    XcdBarrier bar; bar.bar = (unsigned*)(F.ctl + CW_BAR); bar.x = 0; bar.st = nullptr;
    if (N_LAUNCHES != PER_PHASE) bar = xcd_barrier_post((unsigned*)(F.ctl + CW_BAR), F.MISC + 8);

    const pg8::WsSt WST{__builtin_amdgcn_make_buffer_rsrc((void*)ws, 0, (int)WS_END, 0x00020000), ws};
    const int lo = args.ph_lo, hi = args.ph_hi;
#define IN(k) (lo <= (k) && (k) < hi)
#define BOTH(k) (IN(k) && IN((k) + 1))

    if (IN(0)) { p0_prologue(F); if (BOTH(0)) GRID_BAR(0); }

    if (IN(1)) {
        pg8::Gemm g{(const pg8::bf16_t*)(ws + WS_XN), (const pg8::bf16_t*)(ws + WS_WIN), M, NIN, D}; pg8::StaticOrder S; S.init(M, NIN, F.G, (int)blockIdx.x);
        pg8::EpiP1 E{WST, WS_Q, WS_K, WS_V8T, WS_H, F.in[3], F.in[4], (const float*)(ws + WS_ROPE), attn_body::C2};
        pg8::gemm_phase<pg8::EpiP1, pg8::StaticOrder, PG8_ALIGN, PG8_SP2>(F.lds + RING_OFF, g, S, E);
        if (BOTH(1)) GRID_BAR(1);
    }

    if (IN(2)) {
        const attn_body::AttnTensors AT{(const attn_body::bf16*)(ws + WS_Q), (const attn_body::bf16*)(ws + WS_K), (const attn_body::bf16*)(ws + WS_V8T), (attn_body::bf16*)(ws + WS_MIX)};
        const attn_body::StaticOrder S((int)F.G, (int)blockIdx.x);
        bool attn_fast;
        { const float gq = fabsf(F.in[3][F.lane]), gk = fabsf(F.in[4][F.lane]); float mq = gq, mk = gk;
#pragma unroll
          for (int o = 1; o < 64; o <<= 1) { mq = fmaxf(mq, __shfl_xor(mq, o)); mk = fmaxf(mk, __shfl_xor(mk, o)); }
          attn_fast = (64.0f * attn_body::C2 * mq * mk <= 14.0f); }
#if defined(FORCE_ATTN_SLOW)
        attn_fast = false;
#endif
        attn_body::attn_phase<attn_body::StaticOrder>((char*)lds + RING_OFF, AT, S, attn_fast);
        __syncthreads();
        conv_phase(F);
        if (BOTH(2)) GRID_BAR(2);
    }

    if (IN(3)) {
        pg8::Gemm g{(const pg8::bf16_t*)(ws + WS_MIX), (const pg8::bf16_t*)(ws + WS_WOUT), M, D, D}; pg8::StaticOrder S; S.init(M, D, F.G, (int)blockIdx.x);
        pg8::EpiP3 E{WST, WS_XN, (pg8::bf16_t*)(ws + WS_XN), (const float*)(ws + WS_RSI), (const float*)(ws + WS_IG1), (float*)(ws + WS_SS)};
        pg8::gemm_phase<pg8::EpiP3, pg8::StaticOrder, PG8_ALIGN, PG8_SP2>(F.lds + RING_OFF, g, S, E);
        if (BOTH(3)) GRID_BAR(3);
    }

    if (IN(4)) {
        pg8::Gemm g{(const pg8::bf16_t*)(ws + WS_XN), (const pg8::bf16_t*)(ws + WS_WQ), M, NPQ, D}; pg8::StaticOrder S; S.init(M, NPQ, F.G, (int)blockIdx.x);
        pg8::EpiP4 E{WST, WS_QP, (const float*)(ws + WS_SS)};
        pg8::gemm_phase<pg8::EpiP4, pg8::StaticOrder, PG8_ALIGN, PG8_SP2>(F.lds + RING_OFF, g, S, E);
        if (BOTH(4)) GRID_BAR(4);
    }

    if (IN(5)) { topk_phase(F); if (BOTH(5)) { if (F.G == 256) { asm volatile("s_waitcnt vmcnt(0)" ::: "memory"); __syncthreads(); } else GRID_BAR(5); } }

    if (IN(6)) { peer_phase(F); }
#undef IN
#undef BOTH
}

extern "C" void kernel_launch(void* const* d_in, const int* in_sizes, int n_in, void* d_out, int out_size, void* d_ws, size_t ws_size, hipStream_t stream) {
    static int grid = 0;
    if (grid == 0) {
        if (n_in != 16 || in_sizes[0] != M * D || out_size != M * D || ws_size < WS_END) { fprintf(stderr, "kernel_launch: built for 16 inputs, x and out of %d floats, >= %zu bytes of workspace; got n_in %d, in0 %d, out %d, ws %zu; nothing launched\n", M * D, (size_t)WS_END, n_in, n_in > 0 ? in_sizes[0] : -1, out_size, ws_size); grid = -1; return; }
        int dev = 0, cus = 0, per_cu = 0;
        if (hipGetDevice(&dev) != hipSuccess || hipDeviceGetAttribute(&cus, hipDeviceAttributeMultiprocessorCount, dev) != hipSuccess) { fprintf(stderr, "kernel_launch: hipGetDevice / hipDeviceGetAttribute failed; nothing launched\n"); grid = -1; return; }
        if (hipFuncSetAttribute((const void*)mk_fwd, hipFuncAttributeMaxDynamicSharedMemorySize, LDS_BYTES) != hipSuccess) { fprintf(stderr, "kernel_launch: hipFuncSetAttribute failed\n"); grid = -1; return; }
        if (hipOccupancyMaxActiveBlocksPerMultiprocessor(&per_cu, (const void*)mk_fwd, NWAVES * 64, LDS_BYTES) != hipSuccess || per_cu < 1)
            fprintf(stderr, "kernel_launch: note: the occupancy query reports %d workgroups per CU\n", per_cu);
        (void)hipGetLastError();
        grid = cus;
        if (grid != 256) { fprintf(stderr, "kernel_launch: this kernel's static work deals are built for the 256 CUs of an MI355X; found %d; nothing launched\n", grid); grid = -1; return; }
    }
    if (grid < 0) return;
    if (hipMemsetAsync((char*)d_ws + WS_CTL, 0, CTL_ZERO_BYTES, stream) != hipSuccess) { fprintf(stderr, "kernel_launch: hipMemsetAsync of the control words failed; nothing launched\n"); return; }
    Args a{};
    for (int i = 0; i < 16; ++i) a.in[i] = (const float*)d_in[i];
    a.out = (float*)d_out; a.ws = (unsigned char*)d_ws;
    for (int li = 0; li < N_LAUNCHES; ++li) {
        a.ph_lo = (N_LAUNCHES == PER_PHASE) ? li : 0; a.ph_hi = (N_LAUNCHES == PER_PHASE) ? li + 1 : PER_PHASE; a.li = li;
        hipLaunchKernelGGL(mk_fwd, dim3(grid), dim3(NWAVES * 64), LDS_BYTES, stream, a);
        const hipError_t le = hipPeekAtLastError();
        if (le != hipSuccess) { fprintf(stderr, "kernel_launch: launch %d failed: %s\n", li, hipGetErrorName(le)); break; }
    }
}
```

```cpp
#include <hip/hip_runtime.h>
#include <cstdio>
#include <cstdint>
namespace pg8 {
#define PG8_LAS __attribute__((address_space(3)))
typedef unsigned short bf16_t;
typedef short bf16x8 __attribute__((ext_vector_type(8)));
typedef float f32x4 __attribute__((ext_vector_type(4)));
typedef unsigned u32x4 __attribute__((ext_vector_type(4)));
constexpr int BM = 256, BK = 64, HALF = 128, HTB = HALF * BK * 2  , STAGE_BYTES = 8 * HTB, NXCD = 8, WGM = 8;

__host__ __device__ __forceinline__ int lds_byte(int r, int c) { const int st = (r >> 4) * 2 + (c >> 5), rr = r & 15, cc = c & 31, ob = rr * 64 + cc * 2; return st * 1024 + (ob ^ (((ob >> 9) & 1) << 5)); }
__host__ __device__ __forceinline__ void stage_rc(int b, int& R, int& C) { const int st = b / 1024, sb = b % 1024, swz = sb ^ (((sb >> 9) & 1) << 5); R = (st >> 1) * 16 + swz / 64; C = (st & 1) * 32 + (swz % 64) / 2; }
__host__ __device__ __forceinline__ int perm32(int rho) { const int n = rho >> 4, i = rho & 15; return 8 * (i >> 2) + 4 * n + (i & 3); }

struct Unit { int pm, pn; };
struct Gemm { const bf16_t* A; const bf16_t* Bt; int M, N, K; };

struct StaticOrder {
    int nM, nN, nwg, G, c;
    __host__ __device__ void init(int M, int N, int G_, int c_) { nM = M / BM; nN = N / BM; nwg = nM * nN; G = G_; c = c_; }
    __host__ __device__ bool next(int i, Unit& u) const {
        const long L = (long)i * G + c; if (L >= nwg) return false;
        int wgid = (int)L; { const int q = nwg / NXCD, r = nwg % NXCD, xcd = wgid % NXCD, off = wgid / NXCD; wgid = (xcd < r ? xcd * (q + 1) : r * (q + 1) + (xcd - r) * q) + off; }
        const int nig = WGM * nN, gid = wgid / nig, fm = gid * WGM, gsz = (nM - fm) < WGM ? (nM - fm) : WGM;
        u.pm = fm + ((wgid % nig) % gsz); u.pn = (wgid % nig) / gsz; return true;
    }
    __device__ __forceinline__ void a_ready(const Unit&) const {}
    __device__ __forceinline__ void done(const Unit&) const {}
};


__device__ __forceinline__ unsigned cvt_pk_bf16(float lo, float hi) { unsigned r; asm volatile("v_cvt_pk_bf16_f32 %0, %1, %2" : "=v"(r) : "v"(lo), "v"(hi)); return r; }
typedef unsigned u32x2 __attribute__((ext_vector_type(2)));
__device__ __forceinline__ u32x4 pack8(const f32x4 a, const f32x4 b) { u32x4 w; w.x = cvt_pk_bf16(a[0], a[1]); w.y = cvt_pk_bf16(a[2], a[3]); w.z = cvt_pk_bf16(b[0], b[1]); w.w = cvt_pk_bf16(b[2], b[3]); return w; }

#ifndef WT_STORES
#define WT_STORES 0
#endif
struct WsSt { __amdgpu_buffer_rsrc_t rs; unsigned char* base;
    __device__ __forceinline__ void st16(size_t off, const u32x4 v) const {
#if WT_STORES
        __builtin_amdgcn_raw_buffer_store_b128(v, rs, (int)(unsigned)off, 0, 16);
#else
        *(u32x4*)(base + off) = v;
#endif
    } };
struct EpiP1 {
    static constexpr bool PERM = true, AFTER_DRAIN = false;
    WsSt W; size_t oQ, oK, oV, oH; const float *qg, *kg; const float* rope; float qscale;
    __device__ __forceinline__ void operator()(const f32x4 (&acc)[2][2][4][2], const Unit& u, int wr, int wc, int fr, int fq) const {
        const int row0 = u.pm * BM + wr * 64 + fr;
        if (u.pn < 2 || (u.pn == 2 && wc < 2)) {
            const bool isq = u.pn < 2;
            const float* g = isq ? qg : kg;
            f32x4 gv[2][2];
#pragma unroll
            for (int bj = 0; bj < 2; ++bj)
#pragma unroll
                for (int n = 0; n < 2; ++n) gv[bj][n] = *(const f32x4*)(g + 32 * bj + 16 * n + 4 * fq);
            const float sc = isq ? qscale : 1.f;
            const size_t base = isq ? (oQ + (size_t)(4 * u.pn + wc) * 64) : (oK + (size_t)wc * 64);
            const int pitch = isq ? 512 : 128;
            f32x4 rA[2][2], rB[4][2];
#pragma unroll
            for (int ai = 0; ai < 2; ++ai) { const int pos = ((row0 + ai * HALF) & 8191) >> 6; const f32x4* rp = (const f32x4*)(rope + (pos * 16 + 4 * fq) * 2); rA[ai][0] = rp[0]; rA[ai][1] = rp[1]; }
#pragma unroll
            for (int m = 0; m < 4; ++m) { const int pos = (row0 + m * 16) & 63; const f32x4* rp = (const f32x4*)(rope + (pos * 16 + 4 * fq) * 2); rB[m][0] = rp[0]; rB[m][1] = rp[1]; }
#pragma unroll
            for (int ai = 0; ai < 2; ++ai)
#pragma unroll
                for (int m = 0; m < 4; ++m) {
                    const int row = row0 + ai * HALF + m * 16;
                    float ss = 0.f;
#pragma unroll
                    for (int bj = 0; bj < 2; ++bj)
#pragma unroll
                        for (int n = 0; n < 2; ++n) { const f32x4 v = acc[ai][bj][m][n]; ss += (v[0] * v[0] + v[1] * v[1]) + (v[2] * v[2] + v[3] * v[3]); }
                    ss += __shfl_xor(ss, 16); ss += __shfl_xor(ss, 32);
                    const float rstd = __builtin_amdgcn_rsqf(ss * (1.0f / 64.0f) + 1e-6f) * sc;
#pragma unroll
                    for (int bj = 0; bj < 2; ++bj) {
                        const f32x4 r01 = bj ? rB[m][0] : rA[ai][0], r23 = bj ? rB[m][1] : rA[ai][1];
                        const f32x4 x1 = acc[ai][bj][m][0] * gv[bj][0] * rstd, x2 = acc[ai][bj][m][1] * gv[bj][1] * rstd;
                        const f32x4 cs = (f32x4){r01[0], r01[2], r23[0], r23[2]}, sn = (f32x4){r01[1], r01[3], r23[1], r23[3]};
                        const f32x4 o1 = x1 * cs - x2 * sn, o2 = x2 * cs + x1 * sn;
                        u32x2 w8; { int lo = 0, hi_ = 0;
                            lo = __builtin_amdgcn_cvt_pk_fp8_f32(o1[0], o1[1], lo, false); lo = __builtin_amdgcn_cvt_pk_fp8_f32(o1[2], o1[3], lo, true);
                            hi_ = __builtin_amdgcn_cvt_pk_fp8_f32(o2[0], o2[1], hi_, false); hi_ = __builtin_amdgcn_cvt_pk_fp8_f32(o2[2], o2[3], hi_, true); w8.x = (unsigned)lo; w8.y = (unsigned)hi_; }
                        *(u32x2*)(W.base + base + (size_t)row * pitch + 32 * bj + 8 * fq) = w8;
                    }
                }
        } else if (u.pn == 2) {
            const int hk = wc - 2, s0 = 32 * ((fr >> 2) & 1) + 4 * (fr >> 3) + (fr & 3);
#pragma unroll
            for (int ai = 0; ai < 2; ++ai) {
                const int rowa = row0 + ai * HALF;
                unsigned char* tb = W.base + oV + (size_t)((rowa >> 13) * 256 + hk * 128 + ((rowa & 8191) >> 6)) * 4096 + s0;
#pragma unroll
                for (int bj = 0; bj < 2; ++bj)
#pragma unroll
                    for (int n = 0; n < 2; ++n)
#pragma unroll
                        for (int e = 0; e < 4; ++e) {
                            int pk = 0;
                            pk = __builtin_amdgcn_cvt_pk_fp8_f32(acc[ai][bj][0][n][e], acc[ai][bj][1][n][e], pk, false); pk = __builtin_amdgcn_cvt_pk_fp8_f32(acc[ai][bj][2][n][e], acc[ai][bj][3][n][e], pk, true);
                            unsigned char* pd = tb + (32 * bj + 8 * fq + 4 * n + e) * 64;
                            pd[0] = (unsigned char)(pk & 0xff); pd[8] = (unsigned char)((pk >> 8) & 0xff); pd[16] = (unsigned char)((pk >> 16) & 0xff); pd[24] = (unsigned char)((unsigned)pk >> 24);
                        }
            }
        } else {
            const size_t base = oH + (size_t)((u.pn - 3) * 128 + wc * 32 + 8 * fq) * 2;
#pragma unroll
            for (int ai = 0; ai < 2; ++ai)
#pragma unroll
                for (int m = 0; m < 4; ++m) {
                    const int row = row0 + ai * HALF + m * 16;
                    f32x4 o[2];
#pragma unroll
                    for (int n = 0; n < 2; ++n) { const f32x4 a = acc[ai][0][m][n], b = acc[ai][1][m][n];
#pragma unroll
                        for (int e = 0; e < 4; ++e) o[n][e] = a[e] * __builtin_amdgcn_rcpf(1.0f + __builtin_amdgcn_exp2f(-1.4426950408889634f * b[e])); }
                    W.st16(base + (size_t)row * 1024, pack8(o[0], o[1]));
                }
        }
    }
};

struct EpiP3 {
    static constexpr bool PERM = true, AFTER_DRAIN = false;
    WsSt W; size_t oX; bf16_t* X1B; const float* rsi; const float* ig1; float* SS;
    __device__ __forceinline__ void operator()(const f32x4 (&acc)[2][2][4][2], const Unit& u, int wr, int wc, int fr, int fq) const {
        const int row0 = u.pm * BM + wr * 64 + fr, col0 = u.pn * BM + wc * 32 + 8 * fq;
        f32x4 ig[2][2];
#pragma unroll
        for (int bj = 0; bj < 2; ++bj)
#pragma unroll
            for (int n = 0; n < 2; ++n) ig[bj][n] = *(const f32x4*)(ig1 + col0 + bj * HALF + 4 * n);
#pragma unroll
        for (int ai = 0; ai < 2; ++ai) {
        u32x4 xw[2][4][2]; float ri[2][4];
#pragma unroll
            for (int m = 0; m < 4; ++m) { const int row = row0 + ai * HALF + m * 16; const size_t off = (size_t)row * 1024 + col0;
                ri[ai][m] = rsi[row];
#pragma unroll
                for (int bj = 0; bj < 2; ++bj) xw[ai][m][bj] = *(const u32x4*)(X1B + off + bj * HALF); }
            asm volatile("" ::: "memory");
#pragma unroll
            for (int m = 0; m < 4; ++m) {
                const int row = row0 + ai * HALF + m * 16; const size_t off = (size_t)row * 1024 + col0;
                float ss = 0.f;
#pragma unroll
                for (int bj = 0; bj < 2; ++bj) {
                    const u32x4 w_ = xw[ai][m][bj];
                    const f32x4 xa = (f32x4){__uint_as_float(w_.x << 16), __uint_as_float(w_.x & 0xffff0000u), __uint_as_float(w_.y << 16), __uint_as_float(w_.y & 0xffff0000u)};
                    const f32x4 xb = (f32x4){__uint_as_float(w_.z << 16), __uint_as_float(w_.z & 0xffff0000u), __uint_as_float(w_.w << 16), __uint_as_float(w_.w & 0xffff0000u)};
                    const f32x4 v0 = acc[ai][bj][m][0] + xa * ig[bj][0] * ri[ai][m], v1 = acc[ai][bj][m][1] + xb * ig[bj][1] * ri[ai][m];
                    W.st16(oX + (off + bj * HALF) * 2, pack8(v0, v1));
                    ss += (v0[0] * v0[0] + v0[1] * v0[1]) + (v0[2] * v0[2] + v0[3] * v0[3]) + (v1[0] * v1[0] + v1[1] * v1[1]) + (v1[2] * v1[2] + v1[3] * v1[3]);
                }
                ss += __shfl_xor(ss, 16); ss += __shfl_xor(ss, 32);
                if (fq == 0) SS[(size_t)row * 16 + u.pn * 4 + wc] = ss;
            }
        }
    }
};

struct EpiP4 {
    static constexpr bool PERM = true, AFTER_DRAIN = false;
    WsSt W; size_t oQP; const float* SS;
    __device__ __forceinline__ void operator()(const f32x4 (&acc)[2][2][4][2], const Unit& u, int wr, int wc, int fr, int fq) const {
        const int row0 = u.pm * BM + wr * 64 + fr, col0 = u.pn * BM + wc * 32 + 8 * fq;
        f32x4 sv[2][4];
#pragma unroll
        for (int ai = 0; ai < 2; ++ai)
#pragma unroll
            for (int m = 0; m < 4; ++m) sv[ai][m] = *(const f32x4*)(SS + (size_t)(row0 + ai * HALF + m * 16) * 16 + 4 * fq);
#pragma unroll
        for (int ai = 0; ai < 2; ++ai)
#pragma unroll
            for (int m = 0; m < 4; ++m) {
                const int row = row0 + ai * HALF + m * 16;
                float s = (sv[ai][m][0] + sv[ai][m][1]) + (sv[ai][m][2] + sv[ai][m][3]);
                s += __shfl_xor(s, 16); s += __shfl_xor(s, 32);
                const float rstd = __builtin_amdgcn_rsqf(s * (1.0f / 1024.0f) + 1e-6f);
#pragma unroll
                for (int bj = 0; bj < 2; ++bj)
                    W.st16(oQP + ((size_t)row * 2048 + col0 + bj * HALF) * 2, pack8(acc[ai][bj][m][0] * rstd, acc[ai][bj][m][1] * rstd));
            }
    }
};
template <class Epi, class Sched, bool ALIGN_EPI = false, bool SP2 = false>
__device__ __forceinline__ void gemm_phase(PG8_LAS unsigned char* lds, const Gemm g, const Sched& S, const Epi& E) {
    const int tid = threadIdx.x, wid = __builtin_amdgcn_readfirstlane(tid >> 6), lane = tid & 63, wr = wid >> 2, wc = wid & 3, fr = lane & 15, fq = lane >> 4;
    const int K = g.K, nt = K / BK;
    unsigned voffA[2], voffB[2];
#pragma unroll
    for (int i = 0; i < 2; ++i) { int R, C; stage_rc(tid * 16 + i * 8192, R, C); const int Rb = Epi::PERM ? ((R & ~31) + perm32(R & 31)) : R;
        voffA[i] = (unsigned)(R * K + C) * 2u; voffB[i] = (unsigned)(Rb * K + C) * 2u; }
    const size_t kstep = (size_t)(BK * 2);
    const size_t hstep = (size_t)HALF * K * 2;
    const size_t tstep = 2 * hstep;
    const unsigned ldsw = (unsigned)wid * 1024u;
    const int aoff = lds_byte(wr * 64 + fr, fq * 8), boff = lds_byte(wc * 32 + fr, fq * 8);
#define PG8_SA(b, h) (((b) * 2 + (h)) * HTB)
#define PG8_SB(b, h) ((4 + (b) * 2 + (h)) * HTB)
#define PG8_STAGE(bufoff, gbase, voff) do { _Pragma("unroll") for (int _i = 0; _i < 2; ++_i) \
        __builtin_amdgcn_global_load_lds((const unsigned*)((const char*)(gbase) + (voff)[_i]), (PG8_LAS unsigned*)(lds + (bufoff) + ldsw + _i * 8192), 16, 0, 0); } while (0)
#define PG8_LDA(dst, b, h) do { _Pragma("unroll") for (int m = 0; m < 4; ++m) _Pragma("unroll") for (int k = 0; k < 2; ++k) dst[m][k] = *(const PG8_LAS bf16x8*)(lds + PG8_SA(b, h) + aoff + m * 2048 + k * 1024); } while (0)
#define PG8_LDB(dst, b, h) do { _Pragma("unroll") for (int n = 0; n < 2; ++n) _Pragma("unroll") for (int k = 0; k < 2; ++k) dst[n][k] = *(const PG8_LAS bf16x8*)(lds + PG8_SB(b, h) + boff + n * 2048 + k * 1024); } while (0)
#define PG8_MMA(ai, bj, At, Bt) do { __builtin_amdgcn_s_setprio(1); _Pragma("unroll") for (int m = 0; m < 4; ++m) _Pragma("unroll") for (int n = 0; n < 2; ++n) _Pragma("unroll") for (int k = 0; k < 2; ++k) \
        acc[ai][bj][m][n] = __builtin_amdgcn_mfma_f32_16x16x32_bf16(Bt[n][k], At[m][k], acc[ai][bj][m][n], 0, 0, 0); __builtin_amdgcn_s_setprio(0); } while (0)
#define PG8_WAIT_V(n) asm volatile("s_waitcnt vmcnt(" #n ")" ::: "memory")
#define PG8_WAIT_L(n) asm volatile("s_waitcnt lgkmcnt(" #n ")" ::: "memory")
#define PG8_BAR __builtin_amdgcn_s_barrier()
#define PG8_SCHED __builtin_amdgcn_sched_barrier(0)
    Unit cur, nxt; int ui = 0;
    if (!S.next(0, cur)) return;
    f32x4 acc[2][2][4][2];
#pragma unroll
    for (int a = 0; a < 2; ++a)
#pragma unroll
        for (int b = 0; b < 2; ++b)
#pragma unroll
            for (int m = 0; m < 4; ++m)
#pragma unroll
                for (int n = 0; n < 2; ++n) acc[a][b][m][n] = (f32x4){0.f, 0.f, 0.f, 0.f};
    bf16x8 At[4][2], B0[2][2], B1[2][2];
    const char* cA = (const char*)g.A + (size_t)cur.pm * tstep; const char* cB = (const char*)g.Bt + (size_t)cur.pn * tstep;
    S.a_ready(cur);
    if constexpr (SP2) {
        PG8_STAGE(PG8_SB(0, 0), cB, voffB); PG8_STAGE(PG8_SB(0, 1), cB + hstep, voffB); PG8_STAGE(PG8_SA(0, 0), cA, voffA); PG8_STAGE(PG8_SA(0, 1), cA + hstep, voffA);
        if (wr == 1) PG8_BAR;
        PG8_WAIT_V(2); PG8_BAR;
        PG8_STAGE(PG8_SB(1, 0), cB + kstep, voffB); PG8_STAGE(PG8_SA(1, 0), cA + kstep, voffA); PG8_STAGE(PG8_SB(1, 1), cB + hstep + kstep, voffB);
        PG8_WAIT_V(6); PG8_BAR;
    } else {
        PG8_STAGE(PG8_SB(0, 0), cB, voffB); PG8_STAGE(PG8_SA(0, 0), cA, voffA); PG8_STAGE(PG8_SB(0, 1), cB + hstep, voffB); PG8_STAGE(PG8_SA(0, 1), cA + hstep, voffA);
        if (wr == 1) PG8_BAR;
        PG8_WAIT_V(4); PG8_BAR;
        PG8_STAGE(PG8_SB(1, 0), cB + kstep, voffB); PG8_STAGE(PG8_SA(1, 0), cA + kstep, voffA); PG8_STAGE(PG8_SB(1, 1), cB + hstep + kstep, voffB);
        PG8_WAIT_V(6); PG8_BAR;
    }
    for (;;) {
        const bool has_next = S.next(ui + 1, nxt);
        const char* nA = has_next ? (const char*)g.A + (size_t)nxt.pm * tstep : cA; const char* nB = has_next ? (const char*)g.Bt + (size_t)nxt.pn * tstep : cB;
        for (int t = 0; t < nt; t += 2) {
            const bool last = (t == nt - 2);
            const char* a1 = cA + (size_t)(t + 1) * kstep;
            const char* a2 = last ? nA : cA + (size_t)(t + 2) * kstep; const char* b2 = last ? nB : cB + (size_t)(t + 2) * kstep;
            const char* a3 = a2 + kstep; const char* b3 = b2 + kstep;
            if (last && has_next) S.a_ready(nxt);
            if constexpr (SP2) {
            PG8_LDB(B0, 0, 0); PG8_LDB(B1, 0, 1); PG8_SCHED; PG8_LDA(At, 0, 0); PG8_STAGE(PG8_SA(1, 1), a1 + hstep, voffA);
            PG8_WAIT_V(8); PG8_WAIT_L(0); PG8_BAR; PG8_MMA(0, 0, At, B0); PG8_MMA(0, 1, At, B1); PG8_BAR; PG8_SCHED;
            PG8_LDA(At, 0, 1); PG8_STAGE(PG8_SB(0, 0), b2, voffB); PG8_STAGE(PG8_SB(0, 1), b2 + hstep, voffB); PG8_STAGE(PG8_SA(0, 0), a2, voffA);
            PG8_WAIT_V(8); PG8_WAIT_L(0); PG8_BAR; PG8_MMA(1, 0, At, B0); PG8_MMA(1, 1, At, B1); PG8_BAR; PG8_SCHED;
            PG8_LDB(B0, 1, 0); PG8_LDB(B1, 1, 1); PG8_SCHED; PG8_LDA(At, 1, 0); PG8_STAGE(PG8_SA(0, 1), a2 + hstep, voffA);
            PG8_WAIT_V(8); PG8_WAIT_L(0); PG8_BAR; PG8_MMA(0, 0, At, B0); PG8_MMA(0, 1, At, B1); PG8_BAR; PG8_SCHED;
            PG8_LDA(At, 1, 1); PG8_STAGE(PG8_SB(1, 0), b3, voffB); PG8_STAGE(PG8_SB(1, 1), b3 + hstep, voffB); PG8_STAGE(PG8_SA(1, 0), a3, voffA);
            PG8_WAIT_V(8); PG8_WAIT_L(0); PG8_BAR; PG8_MMA(1, 0, At, B0); PG8_MMA(1, 1, At, B1); PG8_BAR; PG8_SCHED;
            } else {
            PG8_LDB(B0, 0, 0); PG8_SCHED; PG8_LDA(At, 0, 0); PG8_STAGE(PG8_SA(1, 1), a1 + hstep, voffA);
            PG8_WAIT_L(8); PG8_BAR; PG8_WAIT_L(0); PG8_MMA(0, 0, At, B0); PG8_BAR; PG8_SCHED;
            PG8_LDB(B1, 0, 1); PG8_STAGE(PG8_SB(0, 0), b2, voffB);
            PG8_BAR; PG8_WAIT_L(0); PG8_MMA(0, 1, At, B1); PG8_BAR;
            PG8_LDA(At, 0, 1); PG8_STAGE(PG8_SA(0, 0), a2, voffA);
            PG8_BAR; PG8_WAIT_L(0); PG8_MMA(1, 0, At, B0); PG8_BAR; PG8_SCHED;
            PG8_STAGE(PG8_SB(0, 1), b2 + hstep, voffB);
            PG8_WAIT_V(6); PG8_BAR; PG8_MMA(1, 1, At, B1); PG8_BAR;
            PG8_LDB(B0, 1, 0); PG8_SCHED; PG8_LDA(At, 1, 0); PG8_STAGE(PG8_SA(0, 1), a2 + hstep, voffA);
            PG8_WAIT_L(8); PG8_BAR; PG8_WAIT_L(0); PG8_MMA(0, 0, At, B0); PG8_BAR; PG8_SCHED;
            PG8_LDB(B1, 1, 1); PG8_STAGE(PG8_SB(1, 0), b3, voffB);
            PG8_BAR; PG8_WAIT_L(0); PG8_MMA(0, 1, At, B1); PG8_BAR;
            PG8_LDA(At, 1, 1); PG8_STAGE(PG8_SA(1, 0), a3, voffA);
            PG8_BAR; PG8_WAIT_L(0); PG8_MMA(1, 0, At, B0); PG8_BAR; PG8_SCHED;
            PG8_STAGE(PG8_SB(1, 1), b3 + hstep, voffB);
            PG8_WAIT_V(6); PG8_BAR; PG8_MMA(1, 1, At, B1); PG8_BAR;
            }
        }
        if constexpr (ALIGN_EPI) { if (wr == 0) PG8_BAR; }
        if constexpr (!Epi::AFTER_DRAIN) { E(acc, cur, wr, wc, fr, fq); S.done(cur); }
        if (!has_next) break;
#pragma unroll
        for (int a = 0; a < 2; ++a)
#pragma unroll
            for (int b = 0; b < 2; ++b)
#pragma unroll
                for (int m = 0; m < 4; ++m)
#pragma unroll
                    for (int n = 0; n < 2; ++n) acc[a][b][m][n] = (f32x4){0.f, 0.f, 0.f, 0.f};
        cur = nxt; cA = nA; cB = nB; ++ui;
        if constexpr (ALIGN_EPI) { if (wr == 1) PG8_BAR; }
    }
    PG8_WAIT_V(0);
    if constexpr (!ALIGN_EPI) { if (wr == 0) PG8_BAR; }
    PG8_BAR;
    if constexpr (Epi::AFTER_DRAIN) { E.fused(acc, cur, wr, wc, fr, fq, lds, wid, lane); S.done(cur); }
#undef PG8_SA
#undef PG8_SB
#undef PG8_STAGE
#undef PG8_LDA
#undef PG8_LDB
#undef PG8_MMA
#undef PG8_WAIT_V
#undef PG8_WAIT_L
#undef PG8_BAR
#undef PG8_SCHED
}
}
#ifndef PG8_SP2
#define PG8_SP2 true
#endif
#ifndef PG8_ALIGN
#define PG8_ALIGN true
#endif
#include <hip/hip_bf16.h>
#include <cmath>
namespace attn_body {
using bf16=__hip_bfloat16;
using bf16x8=__attribute__((ext_vector_type(8)))short;
using s16x4=__attribute__((ext_vector_type(4)))short;
using f32x16=__attribute__((ext_vector_type(16)))float;
using u32x4=__attribute__((ext_vector_type(4)))unsigned;
constexpr int BATCH=4,NHEAD=8,SEQ=8192,D=64,QPITCH=512,KVPITCH=128,OPITCH=1024;
constexpr int NW=8,QBLK=32,QB=QBLK*NW,KVBLK=64,NQB=SEQ/QB;
constexpr int ATTN_UNIT_ROWS=QB;
__device__ __forceinline__ int crow(int r,int hi){return (r&3)+8*(r>>2)+4*hi;}
#define SBAR() __builtin_amdgcn_sched_barrier(0)
__device__ __forceinline__ void cmask(f32x16&p0,f32x16&p1,int jb,int qrel,int hi){
  const float NEG=-INFINITY; int kb=64*jb+4*hi;
  #pragma unroll
  for(int r=0;r<16;++r){int kv=kb+(r&3)+8*(r>>2); if(kv>qrel)p0[r]=NEG; if(kv+32>qrel)p1[r]=NEG;}
}

constexpr int NSLOT=3, SLOTB=8192;
constexpr int LDS_K=0, LDS_V=NSLOT*SLOTB, LDS_WS=2*NSLOT*SLOTB, LDS_OST=LDS_WS+NW*64*4, LDS_BYTES=LDS_OST+NW*4096;
constexpr float C2=0.125f*1.4426950408889634f;
__device__ __forceinline__ void glds16(const void*gsrc,unsigned lds_dst){unsigned keep;
  asm volatile("s_mov_b32 %0, m0\n\ts_mov_b32 m0, %2\n\ts_nop 0\n\tglobal_load_lds_dwordx4 %1, off\n\ts_mov_b32 m0, %0":"=&s"(keep):"v"(gsrc),"s"(lds_dst):"memory");}
__device__ __forceinline__ float max3f(float a,float b,float c){float r;asm("v_max3_f32 %0, %1, %2, %3":"=v"(r):"v"(a),"v"(b),"v"(c));return r;}
__device__ __forceinline__ float max2f(float a,float b){float r;asm("v_max_f32_e32 %0, %1, %2":"=v"(r):"v"(a),"v"(b));return r;}
__device__ __forceinline__ float fadd_s(float a,float b){float r;asm("v_add_f32_e32 %0, %1, %2":"=v"(r):"v"(a),"v"(b));return r;}
__device__ __forceinline__ float fsub_s(float a,float b){float r;asm("v_sub_f32_e32 %0, %1, %2":"=v"(r):"v"(a),"v"(b));return r;}
typedef float f32x2_t __attribute__((ext_vector_type(2))); typedef __bf16 bf16x2_t __attribute__((ext_vector_type(2)));
__device__ __forceinline__ unsigned cvtpk_s(float lo,float hi){f32x2_t v={lo,hi};bf16x2_t b=__builtin_convertvector(v,bf16x2_t);return __builtin_bit_cast(unsigned,b);}
#define WAIT_BAR(N) asm volatile("s_waitcnt lgkmcnt(0)\n\ts_barrier":::"memory")
#define WAIT_BARC(N,NV) do{ if(kwave){WAIT_BAR(N);}else{WAIT_BAR(NV);} }while(0)

typedef int v8i_t __attribute__((ext_vector_type(8))); typedef int v4i_t __attribute__((ext_vector_type(4)));
__device__ __forceinline__ v8i_t cat8(const v4i_t a,const v4i_t b){return (v8i_t){a.x,a.y,a.z,a.w,b.x,b.y,b.z,b.w};}
__device__ __forceinline__ f32x16 qk8(const v8i_t kf,const v8i_t qf,const f32x16 c){return __builtin_amdgcn_mfma_scale_f32_32x32x64_f8f6f4(kf,qf,c,0,0,0,0,0,0);}
__device__ __forceinline__ void qkt(f32x16&p0,f32x16&p1,const char*Kslot,const v8i_t qr,const f32x16&negm,int r32,int hi){
  const char*kb=Kslot+hi*2048+r32*16;
  const v4i_t a0=*reinterpret_cast<const v4i_t*>(kb),a1=*reinterpret_cast<const v4i_t*>(kb+1024),b0=*reinterpret_cast<const v4i_t*>(kb+512),b1=*reinterpret_cast<const v4i_t*>(kb+1536);
  p0=qk8(cat8(a0,a1),qr,negm);p1=qk8(cat8(b0,b1),qr,negm);
}
typedef __attribute__((address_space(3))) const char* lds_cptr;
typedef short v4i16_t __attribute__((ext_vector_type(4)));
typedef __attribute__((address_space(3))) const v4i_t* lds_v4p;
__device__ __forceinline__ void kload2(v8i_t*kf,lds_cptr kp,int j){ kf[j]=cat8(*(lds_v4p)(kp+j*512),*(lds_v4p)(kp+j*512+1024)); }
__device__ __forceinline__ void kload8(v8i_t*kf,lds_cptr kp){ kload2(kf,kp,0); kload2(kf,kp,1); }
__device__ __forceinline__ s16x4 vtr(lds_cptr p){ return __builtin_bit_cast(s16x4,__builtin_amdgcn_ds_read_tr16_b64_v4i16((__attribute__((address_space(3))) v4i16_t*)p)); }
__device__ __forceinline__ float rowmax(const f32x16&p0,const f32x16&p1){
  float a=max3f(p0[0],p0[1],p1[0]),b=max3f(p0[2],p0[3],p1[1]);a=max3f(a,p1[2],p1[3]);
  #pragma unroll
  for(int r=4;r<16;r+=4){a=max3f(a,p0[r],p0[r+1]);b=max3f(b,p0[r+2],p0[r+3]);a=max3f(a,p1[r],p1[r+1]);b=max3f(b,p1[r+2],p1[r+3]);}
  const float m=max2f(a,b);
  auto rr=__builtin_amdgcn_permlane32_swap(__float_as_uint(m),__float_as_uint(m),false,false);
  return max2f(__uint_as_float(rr[0]),__uint_as_float(rr[1]));
}
__device__ __forceinline__ f32x16 pv8(const v8i_t pa,const v8i_t vb,const f32x16 c){return __builtin_amdgcn_mfma_scale_f32_32x32x64_f8f6f4(pa,vb,c,1,0,0,0,0,0);}
#define PKASM(w,a,b,c,d) do{ int t_; asm volatile("v_cvt_pkrtz_f16_f32 %0, %2, %3\n\tv_cvt_pkrtz_f16_f32 %1, %4, %5\n\tv_perm_b32 %0, %1, %0, %6":"=&v"(w),"=&v"(t_):"v"(a),"v"(b),"v"(c),"v"(d),"s"(0x07050301)); }while(0)
#define PKASML(w,a,b,c,d) do{ int t_; asm volatile("v_cvt_pkrtz_f16_f32 %0, %2, %3\n\tv_cvt_pkrtz_f16_f32 %1, %4, %5\n\tv_perm_b32 %0, %1, %0, %6\n\ts_nop 1":"=&v"(w),"=&v"(t_):"v"(a),"v"(b),"v"(c),"v"(d),"s"(0x07050301)); }while(0)
__device__ __forceinline__ int pk8(float a,float b,float c,float d){int w=0;w=__builtin_amdgcn_cvt_pk_bf8_f32(a,b,w,false);w=__builtin_amdgcn_cvt_pk_bf8_f32(c,d,w,true);return w;}
__device__ __forceinline__ void pv(f32x16*o,lds_cptr vp,const v8i_t pw){
  const v8i_t v0=cat8(*(lds_v4p)(vp),*(lds_v4p)(vp+1024)),v1=cat8(*(lds_v4p)(vp+512),*(lds_v4p)(vp+1536));
  o[0]=pv8(pw,v0,o[0]);o[1]=pv8(pw,v1,o[1]);
}
#ifndef ATTN_STORE16
#define ATTN_STORE16(p,v) (*(u32x4*)(p)=(v))
#endif
template<int THRL> __device__ __forceinline__ void attn_unit(int b,int h,int qb,const bf16*Q,const bf16*__restrict__ K,const bf16*__restrict__ V,bf16*O,char*shm){
  const int tid=threadIdx.x,lane=tid&63,r32=lane&31,hi=lane>>5; const int wid=__builtin_amdgcn_readfirstlane(tid>>6);
  const long rowbase=(long)b*SEQ; const int q0=qb*QB;
  const unsigned lds0=(unsigned)(uintptr_t)shm;
  float*wsf=(float*)(shm+LDS_WS)+wid*64;
  const bool kwave=wid<4;
  const unsigned char*ksrc=(const unsigned char*)K+(rowbase*128+(h>>2)*64)+(long)lane*128+(wid&3)*16;
  const unsigned char*vsrc=(const unsigned char*)V+((size_t)((b*2+(h>>2))*(SEQ/KVBLK))*4096)+(long)lane*64+(wid&3)*16;
  const unsigned char*ssrc=kwave?ksrc:vsrc; const long sstep=kwave?(long)KVBLK*128:4096L;
  typedef __attribute__((address_space(3))) u32x4* lds_w4p; const lds_w4p sdst=(lds_w4p)((__attribute__((address_space(3))) char*)shm+(kwave?LDS_K:LDS_V)+(wid&3)*1024+lane*16);
  #define LDT(t) (*reinterpret_cast<const u32x4*>(ssrc+(long)(t)*sstep))
  #define WRT(slot,reg) (*(lds_w4p)((__attribute__((address_space(3))) char*)sdst+(slot))=(reg))
  const char*Kbase=shm+LDS_K; v8i_t kf[2];
  const lds_cptr shm3=(lds_cptr)shm; const lds_cptr kp0=shm3+LDS_K+hi*2048+r32*16; const lds_cptr vp0=shm3+LDS_V+hi*2048+r32*16;
  const int NT=SEQ/KVBLK;
  u32x4 st0=LDT(0),st1=LDT(1),st2=LDT(kwave?2:1),st3=LDT(kwave?3:1),stn;
  v8i_t qr;{const unsigned char*q8=(const unsigned char*)Q+((rowbase+q0+wid*QBLK+r32)*512+h*64+hi*32);qr=cat8(*reinterpret_cast<const v4i_t*>(q8),*reinterpret_cast<const v4i_t*>(q8+16));}
  float mhat=0.f,l_reg=0.f;f32x16 o[2];o[0]=f32x16{};o[1]=f32x16{};f32x16 negm=f32x16{};asm volatile("":"+v"(negm));
  const int qrel=wid*QBLK+r32;
  #define CMASK(P0,P1,t) do{}while(0)
  bool resc=false;
  #define START(P0,P1) do{ const float rm=rowmax(P0,P1); resc=false; \
    { const float dl=rm; mhat=fadd_s(mhat,dl); \
      _Pragma("unroll") for(int r=0;r<16;++r){P0[r]=fsub_s(P0[r],dl);P1[r]=fsub_s(P1[r],dl);} \
      _Pragma("unroll") for(int r=0;r<16;++r)negm[r]=-mhat; asm volatile("":"+v"(negm)); } \
    _Pragma("unroll") for(int r=0;r<16;++r)P0[r]=__builtin_amdgcn_exp2f(P0[r]); }while(0)
  #define RESC() do{ if(resc){ asm volatile("s_waitcnt lgkmcnt(0)":::"memory"); \
      _Pragma("unroll") for(int d_=0;d_<2;++d_) _Pragma("unroll") for(int r=0;r<16;++r)o[d_][r]*=wsf[crow(r,hi)]; } }while(0)
  f32x16 pA0,pA1,pB0,pB1;
  int sl_prev=0,sl_cur=0,sl_next=SLOTB;
  #define ROT() do{sl_prev=sl_cur;sl_cur=sl_next;sl_next=(sl_next==(NSLOT-1)*SLOTB)?0:sl_next+SLOTB;}while(0)
  WRT(0,st0); if(kwave){WRT(SLOTB,st1);WRT(2*SLOTB,st2);}
  WAIT_BARC(3,0);
  qkt(pA0,pA1,Kbase,qr,negm,r32,hi);asm volatile("s_nop 15\n\ts_nop 7":"+v"(pA0),"+v"(pA1));CMASK(pA0,pA1,0);
  START(pA0,pA1);
  _Pragma("unroll") for(int r=0;r<16;++r)pA1[r]=__builtin_amdgcn_exp2f(pA1[r]);
  WAIT_BAR(0);
  if(kwave){WRT(0,st3);stn=LDT(4);}else{WRT(SLOTB,st1);stn=LDT(2);}
  ROT();
  kload8(kf,kp0+sl_cur);
  WAIT_BAR(1);
  v8i_t vf[2]; v8i_t pw8;
  #define PKW4(P,B) pk8(P[B],P[B+1],P[B+2],P[B+3])
  #define PIN(x) asm volatile("":"+v"(x))
  #define MX3(a,b,c) __builtin_fmaxf(__builtin_fmaxf((a),(b)),(c))
  #define GAPA(MF,A0,A1,A2,A3,W0,W1,PW) do{ MF; sacc+=A0; sacc+=A1; sacc+=A2; sacc+=A3; PIN(sacc); W0; W1; PIN(PW); SBAR(); }while(0)
  #define EX(v) __builtin_amdgcn_exp2f(v)
  #define GAPB(MF,X,B) do{ MF; X[B]=EX(X[B]); X[B+1]=EX(X[B+1]); X[B+2]=EX(X[B+2]); X[B+3]=EX(X[B+3]); PIN(X); SBAR(); }while(0)
  #define VRD8(j) do{ vf[j]=cat8(*(lds_v4p)(vp_+(j)*512),*(lds_v4p)(vp_+(j)*512+1024)); }while(0)
  #define KRD(G,j) do{ if(G){ kload2(kf,kp0+sl_next,j); SBAR(); } }while(0)
  #define STEP(C0,C1,P0,P1,t,GK,GV,GL) do{ SBAR(); \
    const lds_cptr vp_=vp0+sl_prev; \
    VRD8(0); SBAR(); float sacc=(P0[0]+P0[1]); \
    GAPA(C0=qk8(kf[0],qr,negm), P0[2],P0[3],P0[4],P0[5],     pw8[0]=PKW4(P0,0), (void)0, pw8); \
    VRD8(1); SBAR(); GAPA(C1=qk8(kf[1],qr,negm), P0[6],P0[7],P0[8],P0[9],     pw8[1]=PKW4(P0,4), (void)0, pw8); \
    GAPA((void)0,   P0[10],P0[11],P0[12],P0[13], pw8[2]=PKW4(P0,8), (void)0, pw8); \
    GAPA((void)0,   P0[14],P0[15],P1[0],P1[1],   pw8[3]=PKW4(P0,12), (void)0, pw8); \
    GAPA((void)0,   P1[2],P1[3],P1[4],P1[5],     pw8[4]=PKW4(P1,0), (void)0, pw8); \
    GAPA((void)0,   P1[6],P1[7],P1[8],P1[9],     pw8[5]=PKW4(P1,4), (void)0, pw8); \
    GAPA((void)0,   P1[10],P1[11],P1[12],P1[13], pw8[6]=PKW4(P1,8), (void)0, pw8); \
    GAPA((void)0,   P1[14],P1[15],0.f,0.f,       pw8[7]=PKW4(P1,12), (void)0, pw8); \
    l_reg+=sacc; \
    if(kwave){ if(GK){ WRT(sl_cur,stn); if((t)+4<NT) stn=LDT((t)+4); } } else { if(GV){ WRT(sl_next,stn); if((t)+2<NT) stn=LDT((t)+2); } } \
    CMASK(C0,C1,t); \
    { float a=MX3(C0[0],C0[1],C1[0]),b=MX3(C0[2],C0[3],C1[1]); a=MX3(a,C1[2],C1[3]); \
      _Pragma("unroll") for(int r=4;r<16;r+=4){a=MX3(a,C0[r],C0[r+1]);b=MX3(b,C0[r+2],C0[r+3]);a=MX3(a,C1[r],C1[r+1]);b=MX3(b,C1[r+2],C1[r+3]);} \
      float rm=__builtin_fmaxf(a,b); { auto rr=__builtin_amdgcn_permlane32_swap(__float_as_uint(rm),__float_as_uint(rm),false,false); rm=__builtin_fmaxf(__uint_as_float(rr[0]),__uint_as_float(rr[1])); } \
      resc=false; \
      if(__builtin_expect(__any(rm>(float)THRL),0)){ const float dl=__builtin_fmaxf(rm,0.f); mhat+=dl; \
        _Pragma("unroll") for(int r=0;r<16;++r){C0[r]-=dl;C1[r]-=dl;} \
        _Pragma("unroll") for(int r=0;r<16;++r)negm[r]=-mhat; asm volatile("":"+v"(negm)); \
        const float f=__builtin_amdgcn_exp2f(-dl); l_reg*=f; if(hi==0)wsf[r32]=f; resc=true; } } \
    SBAR(); \
    GAPB(o[0]=pv8(pw8,vf[0],o[0]), C0,0); \
    GAPB(o[1]=pv8(pw8,vf[1],o[1]), C0,4); \
    KRD(GL,0); GAPB((void)0, C0,8); \
    KRD(GL,1); GAPB((void)0, C0,12); \
    GAPB((void)0, C1,0); \
    GAPB((void)0, C1,4); \
    GAPB((void)0, C1,8); \
    GAPB((void)0, C1,12); \
    }while(0)
  int t=1;
  #undef CMASK
  #define CMASK(P0,P1,t) do{}while(0)
  for(;t+5<NT;t+=2){
    STEP(pB0,pB1,pA0,pA1,t,true,true,true);     WAIT_BAR(1); RESC(); ROT();
    STEP(pA0,pA1,pB0,pB1,t+1,true,true,true);   WAIT_BAR(1); RESC(); ROT();
  }
  #undef CMASK
  #define CMASK(P0,P1,t) do{}while(0)
  #define ENDW(tt) do{ if((tt)+3<NT){WAIT_BAR(1);} else if((tt)+2<NT){WAIT_BARC(0,1);} else {WAIT_BAR(0);} }while(0)
  for(;t+1<NT;t+=2){
    STEP(pB0,pB1,pA0,pA1,t,(t+3<NT),(t+1<NT),(t+1<NT));       ENDW(t);   RESC(); ROT();
    STEP(pA0,pA1,pB0,pB1,t+1,(t+4<NT),(t+2<NT),(t+2<NT));     ENDW(t+1); RESC(); ROT();
  }
  STEP(pB0,pB1,pA0,pA1,NT-1,false,false,false); RESC();
  { float sacc=pB0[0]+pB0[1]; _Pragma("unroll") for(int r=2;r<16;++r)sacc+=pB0[r]; _Pragma("unroll") for(int r=0;r<16;++r)sacc+=pB1[r]; l_reg+=sacc;
    pw8=(v8i_t){PKW4(pB0,0),PKW4(pB0,4),PKW4(pB0,8),PKW4(pB0,12),PKW4(pB1,0),PKW4(pB1,4),PKW4(pB1,8),PKW4(pB1,12)};
    SBAR(); pv(o,vp0+sl_cur,pw8); }
  #undef PKW4
  #undef PIN
  #undef MX3
  #undef GAPA
  #undef GAPB
  #undef EX
  #undef VRD8
  #undef KRD
  #undef STEP
  #undef ENDW
  {auto rr=__builtin_amdgcn_permlane32_swap(__float_as_uint(l_reg),__float_as_uint(l_reg),false,false);l_reg=__uint_as_float(rr[0])+__uint_as_float(rr[1]);}
  if(hi==0)wsf[32+r32]=l_reg;asm volatile("s_waitcnt lgkmcnt(0)":::"memory");
  float rli[16];
  #pragma unroll
  for(int r=0;r<16;++r)rli[r]=__builtin_amdgcn_rcpf(wsf[32+crow(r,hi)]);
  bf16*Ow=O+(rowbase+q0+wid*QBLK)*OPITCH+h*D;
  { bf16*stg=(bf16*)(shm+LDS_OST)+wid*2048;
    #pragma unroll
    for(int r=0;r<16;++r){const int orow=crow(r,hi);
      #pragma unroll
      for(int d0=0;d0<2;++d0)stg[orow*64+d0*32+r32]=__float2bfloat16(o[d0][r]*rli[r]);}
    asm volatile("s_waitcnt lgkmcnt(0)":::"memory");
    #pragma unroll
    for(int i=0;i<4;++i){const int row=i*8+(lane>>3),ch=lane&7; const u32x4 v=*(const u32x4*)(stg+row*64+ch*8); ATTN_STORE16(Ow+(long)row*OPITCH+ch*8,v);} }
  asm volatile("s_waitcnt lgkmcnt(0)\n\ts_barrier":::"memory");
  #undef LDT
  #undef WRT
  #undef CMASK
  #undef START
  #undef RESC
  #undef ROT
}
__device__ __forceinline__ void attn_unit_fast(int b,int h,int qb,const bf16*Q,const bf16*__restrict__ K,const bf16*__restrict__ V,bf16*O,char*shm){
  const int tid=threadIdx.x,lane=tid&63,r32=lane&31,hi=lane>>5; const int wid=__builtin_amdgcn_readfirstlane(tid>>6);
  const long rowbase=(long)b*SEQ; const int q0=qb*QB;
  const unsigned lds0=(unsigned)(uintptr_t)shm;
  float*wsf=(float*)(shm+LDS_WS)+wid*64;
  const bool kwave=wid<4;
  const unsigned char*sbase=kwave?(const unsigned char*)K+(rowbase*128+(h>>2)*64):(const unsigned char*)V+((size_t)((b*2+(h>>2))*(SEQ/KVBLK))*4096);
  const int svoff=kwave?lane*128+(wid&3)*16:lane*64+(wid&3)*16; const int sstep=kwave?KVBLK*128:4096;
  const __amdgpu_buffer_rsrc_t srs=__builtin_amdgcn_make_buffer_rsrc((void*)sbase,0,0x7fffffff,0x00020000);
  typedef __attribute__((address_space(3))) u32x4* lds_w4p; const lds_w4p sdst=(lds_w4p)((__attribute__((address_space(3))) char*)shm+(kwave?LDS_K:LDS_V)+(wid&3)*1024+lane*16);
  #define LDT(t) __builtin_bit_cast(u32x4,__builtin_amdgcn_raw_buffer_load_b128(srs,svoff,(t)*sstep,0))
  #define WRT(slot,reg) (*(lds_w4p)((__attribute__((address_space(3))) char*)sdst+(slot))=(reg))
  const char*Kbase=shm+LDS_K; v8i_t kf[2];
  const lds_cptr shm3=(lds_cptr)shm; const lds_cptr kp0=shm3+LDS_K+hi*2048+r32*16; const lds_cptr vp0=shm3+LDS_V+hi*2048+r32*16;
  const int NT=SEQ/KVBLK;
  u32x4 st0=LDT(0),st1=LDT(1),st2=LDT(kwave?2:1),st3=LDT(kwave?3:1),stn;
  v8i_t qr;{const unsigned char*q8=(const unsigned char*)Q+((rowbase+q0+wid*QBLK+r32)*512+h*64+hi*32);qr=cat8(*reinterpret_cast<const v4i_t*>(q8),*reinterpret_cast<const v4i_t*>(q8+16));}
  f32x16 o[2];o[0]=f32x16{};o[1]=f32x16{};f32x16 osum=f32x16{};const f32x16 negm=f32x16{};v8i_t ONES8=(v8i_t){0x38383838,0x38383838,0x38383838,0x38383838,0x38383838,0x38383838,0x38383838,0x38383838};asm volatile("":"+v"(ONES8));
  const int qrel=wid*QBLK+r32;
  #define CMASK(P0,P1,t) do{}while(0)
  #define START(P0,P1) do{ _Pragma("unroll") for(int r=0;r<16;++r)P0[r]=__builtin_amdgcn_exp2f(P0[r]); }while(0)
  #define RESC() do{}while(0)
  f32x16 pA0,pA1,pB0,pB1;
  int sl_prev=0,sl_cur=0,sl_next=SLOTB;
  #define ROT() do{sl_prev=sl_cur;sl_cur=sl_next;sl_next=(sl_next==(NSLOT-1)*SLOTB)?0:sl_next+SLOTB;}while(0)
  WRT(0,st0); if(kwave){WRT(SLOTB,st1);WRT(2*SLOTB,st2);}
  WAIT_BARC(3,0);
  qkt(pA0,pA1,Kbase,qr,negm,r32,hi);asm volatile("s_nop 15\n\ts_nop 7":"+v"(pA0),"+v"(pA1));CMASK(pA0,pA1,0);
  START(pA0,pA1);
  _Pragma("unroll") for(int r=0;r<16;++r)pA1[r]=__builtin_amdgcn_exp2f(pA1[r]);
  WAIT_BAR(0);
  if(kwave){WRT(0,st3);stn=LDT(4);}else{WRT(SLOTB,st1);stn=LDT(2);}
  ROT();
  kload8(kf,kp0+sl_cur);
  WAIT_BAR(1);
  v8i_t vf[2]; v8i_t pw8;
  #define PKW4(P,B) pk8(P[B],P[B+1],P[B+2],P[B+3])
  #define PIN(x) asm volatile("":"+v"(x))
  #define MX3(a,b,c) __builtin_fmaxf(__builtin_fmaxf((a),(b)),(c))
  #define GAPA(MF,A0,A1,A2,A3,W0,W1,PW) do{ MF; W0; W1; SBAR(); }while(0)
  #define EX(v) __builtin_amdgcn_exp2f(v)
  #define GAPB(MF,X,B) do{ MF; X[B]=EX(X[B]); X[B+1]=EX(X[B+1]); X[B+2]=EX(X[B+2]); X[B+3]=EX(X[B+3]); SBAR(); }while(0)
  #define VRD8(j) do{ vf[j]=cat8(*(lds_v4p)(vp_+(j)*512),*(lds_v4p)(vp_+(j)*512+1024)); }while(0)
  #define KRD(G,j,SN) do{ if(G){ kload2(kf,kp0+(SN),j); SBAR(); } }while(0)
  #define STEP_(C0,C1,P0,P1,t,GL,SLP,SLN,STG) do{ SBAR(); \
    const lds_cptr vp_=vp0+(SLP); \
    VRD8(0); SBAR(); \
    GAPA(C0=qk8(kf[0],qr,negm), P0[2],P0[3],P0[4],P0[5],     PKASM(pw8[0],P0[0],P0[0+1],P0[0+2],P0[0+3]), (void)0, pw8); \
    VRD8(1); SBAR(); GAPA(C1=qk8(kf[1],qr,negm), P0[6],P0[7],P0[8],P0[9],     PKASM(pw8[1],P0[4],P0[4+1],P0[4+2],P0[4+3]), (void)0, pw8); \
    GAPA((void)0,   P0[10],P0[11],P0[12],P0[13], PKASM(pw8[2],P0[8],P0[8+1],P0[8+2],P0[8+3]), (void)0, pw8); \
    GAPA((void)0,   P0[14],P0[15],P1[0],P1[1],   PKASM(pw8[3],P0[12],P0[12+1],P0[12+2],P0[12+3]), (void)0, pw8); \
    GAPA((void)0,   P1[2],P1[3],P1[4],P1[5],     PKASM(pw8[4],P1[0],P1[0+1],P1[0+2],P1[0+3]), (void)0, pw8); \
    GAPA((void)0,   P1[6],P1[7],P1[8],P1[9],     PKASM(pw8[5],P1[4],P1[4+1],P1[4+2],P1[4+3]), (void)0, pw8); \
    GAPA((void)0,   P1[10],P1[11],P1[12],P1[13], PKASM(pw8[6],P1[8],P1[8+1],P1[8+2],P1[8+3]), (void)0, pw8); \
    GAPA((void)0,   P1[14],P1[15],0.f,0.f,       PKASML(pw8[7],P1[12],P1[12+1],P1[12+2],P1[12+3]), (void)0, pw8); \
    STG; \
    CMASK(C0,C1,t); \
    SBAR(); \
    GAPB(o[0]=pv8(pw8,vf[0],o[0]), C0,0); \
    GAPB(o[1]=pv8(pw8,vf[1],o[1]), C0,4); \
    KRD(GL,0,SLN); GAPB(osum=pv8(pw8,ONES8,osum), C0,8); \
    KRD(GL,1,SLN); GAPB((void)0, C0,12); \
    GAPB((void)0, C1,0); \
    GAPB((void)0, C1,4); \
    GAPB((void)0, C1,8); \
    GAPB((void)0, C1,12); \
    }while(0)
  #define STEP(C0,C1,P0,P1,t,GK,GV,GL) STEP_(C0,C1,P0,P1,t,GL,sl_prev,sl_next, if(kwave){ if(GK){ WRT(sl_cur,stn); if((t)+4<NT) stn=LDT((t)+4); } } else { if(GV){ WRT(sl_next,stn); if((t)+2<NT) stn=LDT((t)+2); } })
  #define STEP6(C0,C1,P0,P1,t,SLP,SLN,WA) STEP_(C0,C1,P0,P1,t,true,SLP,SLN, { *(lds_w4p)(WA)=stn; stn=LDT((t)+kadd); })
  lds_w4p wa0=(lds_w4p)((__attribute__((address_space(3))) char*)sdst+(kwave?1:2)*SLOTB),wa1=(lds_w4p)((__attribute__((address_space(3))) char*)sdst+(kwave?2:0)*SLOTB),wa2=(lds_w4p)((__attribute__((address_space(3))) char*)sdst+(kwave?0:1)*SLOTB);
  asm volatile("":"+v"(wa0),"+v"(wa1),"+v"(wa2));
  const int kadd=kwave?4:2;
  int t=1;
  #undef CMASK
  #define CMASK(P0,P1,t) do{}while(0)
  for(;t+9<NT;t+=6){
    STEP6(pB0,pB1,pA0,pA1,t,  0,2*SLOTB,wa0);       WAIT_BAR(1);
    STEP6(pA0,pA1,pB0,pB1,t+1,SLOTB,0,wa1);         WAIT_BAR(1);
    STEP6(pB0,pB1,pA0,pA1,t+2,2*SLOTB,SLOTB,wa2);   WAIT_BAR(1);
    STEP6(pA0,pA1,pB0,pB1,t+3,0,2*SLOTB,wa0);       WAIT_BAR(1);
    STEP6(pB0,pB1,pA0,pA1,t+4,SLOTB,0,wa1);         WAIT_BAR(1);
    STEP6(pA0,pA1,pB0,pB1,t+5,2*SLOTB,SLOTB,wa2);   WAIT_BAR(1);
  }
  for(;t+5<NT;t+=2){
    STEP(pB0,pB1,pA0,pA1,t,true,true,true);     WAIT_BAR(1); RESC(); ROT();
    STEP(pA0,pA1,pB0,pB1,t+1,true,true,true);   WAIT_BAR(1); RESC(); ROT();
  }
  #undef CMASK
  #define CMASK(P0,P1,t) do{}while(0)
  #define ENDW(tt) do{ if((tt)+3<NT){WAIT_BAR(1);} else if((tt)+2<NT){WAIT_BARC(0,1);} else {WAIT_BAR(0);} }while(0)
  for(;t+1<NT;t+=2){
    STEP(pB0,pB1,pA0,pA1,t,(t+3<NT),(t+1<NT),(t+1<NT));       ENDW(t);   RESC(); ROT();
    STEP(pA0,pA1,pB0,pB1,t+1,(t+4<NT),(t+2<NT),(t+2<NT));     ENDW(t+1); RESC(); ROT();
  }
  STEP(pB0,pB1,pA0,pA1,NT-1,false,false,false); RESC();
  {
    pw8=(v8i_t){PKW4(pB0,0),PKW4(pB0,4),PKW4(pB0,8),PKW4(pB0,12),PKW4(pB1,0),PKW4(pB1,4),PKW4(pB1,8),PKW4(pB1,12)};
    SBAR(); pv(o,vp0+sl_cur,pw8); osum=pv8(pw8,ONES8,osum); }
  #undef PKW4
  #undef PIN
  #undef MX3
  #undef GAPA
  #undef GAPB
  #undef EX
  #undef VRD8
  #undef KRD
  #undef STEP
  #undef STEP_
  #undef STEP6
  #undef ENDW
  float rli[16];
  #pragma unroll
  for(int r=0;r<16;++r)rli[r]=__builtin_amdgcn_rcpf(osum[r]);
  bf16*Ow=O+(rowbase+q0+wid*QBLK)*OPITCH+h*D;
  { bf16*stg=(bf16*)(shm+LDS_OST)+wid*2048;
    #pragma unroll
    for(int r=0;r<16;++r){const int orow=crow(r,hi);
      #pragma unroll
      for(int d0=0;d0<2;++d0)stg[orow*64+d0*32+r32]=__float2bfloat16(o[d0][r]*rli[r]);}
    asm volatile("s_waitcnt lgkmcnt(0)":::"memory");
    #pragma unroll
    for(int i=0;i<4;++i){const int row=i*8+(lane>>3),ch=lane&7; const u32x4 v=*(const u32x4*)(stg+row*64+ch*8); ATTN_STORE16(Ow+(long)row*OPITCH+ch*8,v);} }
  asm volatile("s_waitcnt lgkmcnt(0)\n\ts_barrier":::"memory");
  #undef LDT
  #undef WRT
  #undef CMASK
  #undef START
  #undef RESC
  #undef ROT
}
constexpr int ATTN_LDS_BYTES=LDS_BYTES;
struct AttnTensors { const bf16* Q; const bf16* K; const bf16* V; bf16* O; };
struct AttnUnit { int bh; int qb; };
struct StaticOrder {
  int vcu;
  __device__ __forceinline__ explicit StaticOrder(int grid,int block):vcu((block%8)*(grid/8)+block/8){}
  __device__ __forceinline__ bool next(int i,AttnUnit&u)const{ if(i>=4)return false; const int s=vcu&7; u.bh=vcu>>3; u.qb=(i==0)?s:(i==1)?15-s:(i==2)?16+s:31-s; return true; }
  __device__ __forceinline__ void a_ready(const AttnUnit&)const{}
  __device__ __forceinline__ void done(const AttnUnit&)const{}
};
template<class Sched,int THRL=8> __device__ __forceinline__ void attn_phase(char*lds,const AttnTensors&T,const Sched&S,bool fast){
  AttnUnit u;
  if(fast){ for(int i=0;S.next(i,u);++i){ S.a_ready(u); attn_unit_fast(u.bh/NHEAD,u.bh%NHEAD,u.qb,T.Q,T.K,T.V,T.O,lds); S.done(u); } }
  else { for(int i=0;S.next(i,u);++i){ S.a_ready(u); attn_unit<THRL>(u.bh/NHEAD,u.bh%NHEAD,u.qb,T.Q,T.K,T.V,T.O,lds); S.done(u); } }
}
#undef SBAR
#undef WAIT_BAR
}

constexpr int NWAVES = 8;
#ifndef MK_N_LAUNCHES
#define MK_N_LAUNCHES 1
#endif
constexpr int N_LAUNCHES = MK_N_LAUNCHES;
constexpr int PER_PHASE = 7;

constexpr int BATCH = 4, T = 8192, D = 1024;
constexpr int M = BATCH * T;
constexpr int NIN = 1792;
constexpr int NPQ = 2048;
constexpr int NEXP = 16384;
constexpr float RMS_EPS = 1e-6f;

constexpr size_t MiB = 1u << 20;
constexpr size_t WS_CTL = 0, CTL_ZERO_BYTES = 64 * 1024;
constexpr size_t WS_WIN = 2 * MiB, WS_WOUT = 6 * MiB, WS_WQ = 8 * MiB;
constexpr size_t WS_KEYS = 12 * MiB, WS_SU = 12 * MiB + 512 * 1024, WS_ROPE = 13 * MiB, WS_IG1 = 13 * MiB + 64 * 1024, WS_RSI = 13 * MiB + 128 * 1024, WS_SS = 14 * MiB;
constexpr size_t WS_UT = 16 * MiB, WS_VT = 48 * MiB;
constexpr size_t WS_XN = 80 * MiB;
constexpr size_t WS_XQ = 144 * MiB;
constexpr size_t WS_V8T = 180 * MiB;
constexpr size_t WS_Q = 144 * MiB, WS_K = 176 * MiB, WS_H = 192 * MiB;
constexpr size_t WS_SUO = 192 * MiB;
constexpr size_t WS_MIX = 224 * MiB;
constexpr size_t WS_QP = 288 * MiB;
constexpr size_t WS_IDX = 416 * MiB, WS_GATE = 424 * MiB, WS_END = 440 * MiB;
constexpr int CW_TMO = 0, CW_CODE = 1;
constexpr int CW_BAR = 4096;
constexpr int RING_OFF = 0, RING_BYTES = 131072;
constexpr int LDSCTL_OFF = RING_BYTES, MISC_OFF = LDSCTL_OFF + 320;
constexpr int LDS_BYTES = 147456;
static_assert(MISC_OFF + 128 <= LDS_BYTES, "LDS map");
#define GAS __attribute__((address_space(1)))
#define LAS __attribute__((address_space(3)))
typedef unsigned short bf16;
typedef unsigned v4u __attribute__((ext_vector_type(4)));
typedef float f32x4 __attribute__((ext_vector_type(4)));
typedef short bf16x8 __attribute__((ext_vector_type(8)));
typedef GAS unsigned gu32;
typedef GAS unsigned long long gu64;
#define RLX_AGENT __ATOMIC_RELAXED, __HIP_MEMORY_SCOPE_AGENT
#define LDS_WAIT() asm volatile("s_waitcnt lgkmcnt(0)" ::: "memory")
#define VM_WAIT() asm volatile("s_waitcnt vmcnt(0)" ::: "memory")
__device__ __forceinline__ unsigned long long rt() { return __builtin_amdgcn_s_memrealtime(); }
__device__ __forceinline__ unsigned f2bf(float f) { unsigned u = __builtin_bit_cast(unsigned, f); return (u + 0x7fffu + ((u >> 16) & 1u)) >> 16; }
__device__ __forceinline__ unsigned pk2(float lo, float hi) { return f2bf(lo) | (f2bf(hi) << 16); }

#define XB_TMO      128
#define XB_XCNT(j)  (256  + 64 * (j))
#define XB_XSUB(j)  (1280 + 64 * (j))
#define XB_XGEN(j)  (2304 + 64 * (j))
#define XB_TOP      3328
#define XB_TOPGEN   3392
#define XCD_BAR_WORDS 3456
#define XB_SPIN_CAP (1u << 18)

__device__ __forceinline__ unsigned xb_ld(unsigned* p)              { return __hip_atomic_load(p, __ATOMIC_RELAXED, __HIP_MEMORY_SCOPE_AGENT); }
__device__ __forceinline__ unsigned xb_add(unsigned* p, unsigned v) { return __hip_atomic_fetch_add(p, v, __ATOMIC_RELAXED, __HIP_MEMORY_SCOPE_AGENT); }
__device__ __forceinline__ unsigned xb_xcc_id() { return (unsigned)__builtin_amdgcn_s_getreg((3 << 11) | 20) & 0xFu; }
#define XB_SPIN(cond, bar) do { unsigned _sp = 0; while (cond) { __builtin_amdgcn_s_sleep(1); \
    if ((++_sp & 255u) == 0u) { if (xb_ld(&(bar)[XB_TMO])) break; if (_sp > XB_SPIN_CAP) { atomicAdd(&(bar)[XB_TMO], 1u); break; } } } } while (0)

#ifndef BAR_EARLY_WB
#define BAR_EARLY_WB 0
#endif
struct XcdBarrier {
    unsigned* bar; unsigned x;
    volatile LAS unsigned* st;
};

__device__ __forceinline__ XcdBarrier xcd_barrier_post(unsigned* bar, volatile LAS unsigned* st) {
    XcdBarrier b; b.bar = bar; b.x = xb_xcc_id(); b.st = st;
    if (threadIdx.x == 0) (void)xb_add(&bar[XB_XCNT(b.x)], 1u);
    return b;
}
__device__ __forceinline__ void xcd_barrier_complete(unsigned* bar, unsigned x, unsigned& nloc, unsigned& nx) {
    const unsigned G = gridDim.x * gridDim.y * gridDim.z;
    unsigned sum, cnt, mine, sp = 0u;
    for (;;) {
        sum = 0u; cnt = 0u; mine = 0u;
#pragma unroll
        for (unsigned j = 0; j < 16; ++j) { const unsigned c = xb_ld(&bar[XB_XCNT(j)]); sum += c; cnt += (c > 0u) ? 1u : 0u; mine = (j == x) ? c : mine; }
        if (sum == G) break;
        __builtin_amdgcn_s_sleep(1);
        if ((++sp & 255u) == 0u) { if (xb_ld(&bar[XB_TMO])) break; if (sp > XB_SPIN_CAP) { atomicAdd(&bar[XB_TMO], 1u); break; } }
    }
    nloc = mine > 0u ? mine : 1u; nx = cnt > 0u ? cnt : 1u;
}

__device__ __forceinline__ void xcd_barrier(const XcdBarrier& b) {
    asm volatile("s_waitcnt vmcnt(0)" ::: "memory");
    __syncthreads();
    if (threadIdx.x == 0) {
        unsigned* bar = b.bar;
        __builtin_amdgcn_s_waitcnt(0);
        unsigned nloc = b.st[0], nx = b.st[1];
        if (nloc == 0u) { xcd_barrier_complete(bar, b.x, nloc, nx); b.st[0] = nloc; b.st[1] = nx; }
#if BAR_EARLY_WB
        __builtin_amdgcn_fence(__ATOMIC_RELEASE, "agent");
        asm volatile("s_waitcnt vmcnt(0)" ::: "memory");
#endif
        const unsigned old = xb_add(&bar[XB_XSUB(b.x)], 1u);
        const unsigned gen = old / nloc;
        if (old + 1u == (gen + 1u) * nloc) {
            __builtin_amdgcn_fence(__ATOMIC_RELEASE, "agent");
            asm volatile("s_waitcnt vmcnt(0)" ::: "memory");
            const unsigned og = xb_add(&bar[XB_TOP], 1u);
            const unsigned tg = og / nx;
            if (og + 1u == (tg + 1u) * nx) xb_add(&bar[XB_TOPGEN], 1u);
            else XB_SPIN(xb_ld(&bar[XB_TOPGEN]) == tg, bar);
            __builtin_amdgcn_fence(__ATOMIC_ACQUIRE, "agent");
            xb_add(&bar[XB_XGEN(b.x)], 1u);
            asm volatile("s_waitcnt vmcnt(0)" ::: "memory");
        } else {
            XB_SPIN(xb_ld(&bar[XB_XGEN(b.x)]) == gen, bar);
            __builtin_amdgcn_fence(__ATOMIC_ACQUIRE, "agent");
            asm volatile("s_waitcnt vmcnt(0)" ::: "memory");
        }
    }
    __syncthreads();
}

struct Frame {
    LAS unsigned char* lds;
    volatile LAS unsigned* MISC;
    gu32* ctl;
    int tid, lane, wave;
    int vcu, G;
    const float* in[16]; float* out; unsigned char* ws;
};

typedef __bf16 bf16x2_dg __attribute__((ext_vector_type(2)));
__device__ __forceinline__ float dot2bf_(unsigned a, unsigned b, float c) { return __builtin_amdgcn_fdot2_f32_bf16(__builtin_bit_cast(bf16x2_dg, a), __builtin_bit_cast(bf16x2_dg, b), c, false); }
__device__ __forceinline__ float wave_sum(float v) {
#pragma unroll
    for (int o = 1; o < 64; o <<= 1) v += __shfl_xor(v, o);
    return v;
}
__device__ __forceinline__ int win_src_col(int rho) {
    const int pn = rho >> 8, bj = (rho >> 7) & 1, wc = (rho >> 5) & 3, fq = (rho >> 3) & 3, n = (rho >> 2) & 1, e = rho & 3;
    if (pn < 2) return 64 * (4 * pn + wc) + 32 * bj + 16 * n + 4 * fq + e;
    if (pn == 2) { if (wc < 2) return 512 + 64 * wc + 32 * bj + 16 * n + 4 * fq + e; return 640 + 64 * (wc - 2) + 32 * bj + 8 * fq + 4 * n + e; }
    const int c = 128 * (pn - 3) + 32 * wc + 8 * fq + 4 * n + e;
    return (bj ? 1280 : 768) + c;
}
template <bool PERMW>
__device__ __forceinline__ void p0_transpose_item(const float* W, int K, int N, const float* ks, bf16* WT, LAS float* scr, int item, int lane) {
    const int nblk = N / 32, kb = item / nblk, nb = item % nblk, k0 = 64 * kb, n0 = 32 * nb;
    const int sc = PERMW ? win_src_col(n0 + (lane & 31)) : (n0 + (lane & 31));
#pragma unroll 8
    for (int i = 0; i < 32; ++i) { const int kk = 2 * i + (lane >> 5); float v = W[(size_t)(k0 + kk) * N + sc]; if (ks) v *= ks[k0 + kk]; scr[kk * 33 + (lane & 31)] = v; }
    LDS_WAIT(); asm volatile("" ::: "memory");
    const int c = lane & 7;
#pragma unroll
    for (int j = 0; j < 4; ++j) { const int n = (lane >> 3) + 8 * j; const LAS float* s = scr + (8 * c) * 33 + n;
        v4u o; o.x = pk2(s[0 * 33], s[1 * 33]); o.y = pk2(s[2 * 33], s[3 * 33]); o.z = pk2(s[4 * 33], s[5 * 33]); o.w = pk2(s[6 * 33], s[7 * 33]);
        *(GAS v4u*)(WT + (size_t)(n0 + n) * K + k0 + 8 * c) = o; }
    LDS_WAIT(); asm volatile("" ::: "memory");
}
template <int NR>
__device__ __forceinline__ void rms_rows_to_bf16(int lane, const float* x, const float* g, bf16* o, float* rsi, int row0, int rstride) {
    f32x4 v[NR][4];
#pragma unroll
    for (int r = 0; r < NR; ++r) { const GAS f32x4* xr = (const GAS f32x4*)(x + (size_t)(row0 + r * rstride) * D) + lane;
#pragma unroll
        for (int j = 0; j < 4; ++j) v[r][j] = xr[64 * j]; }
    f32x4 gg[4];
#pragma unroll
    for (int j = 0; j < 4; ++j) gg[j] = ((const GAS f32x4*)g + lane)[64 * j];
#pragma unroll
    for (int r = 0; r < NR; ++r) { float s = 0.f;
#pragma unroll
        for (int j = 0; j < 4; ++j) s += (v[r][j].x * v[r][j].x + v[r][j].y * v[r][j].y) + (v[r][j].z * v[r][j].z + v[r][j].w * v[r][j].w);
        const float rms = sqrtf(wave_sum(s) * (1.f / D) + RMS_EPS), rstd = 1.f / rms;
        if (lane == 0) rsi[row0 + r * rstride] = rms;
        GAS unsigned long long* o8 = (GAS unsigned long long*)(o + (size_t)(row0 + r * rstride) * D) + lane;
#pragma unroll
        for (int j = 0; j < 4; ++j) o8[64 * j] = (unsigned long long)pk2(v[r][j].x * rstd * gg[j].x, v[r][j].y * rstd * gg[j].y) | ((unsigned long long)pk2(v[r][j].z * rstd * gg[j].z, v[r][j].w * rstd * gg[j].w) << 32); }
}
__device__ __forceinline__ unsigned pack_i8x4(const f32x4 v) {
    unsigned w = 0u;
    w = __builtin_amdgcn_cvt_pk_u8_f32(__builtin_rintf(v.x) + 128.0f, 0u, w); w = __builtin_amdgcn_cvt_pk_u8_f32(__builtin_rintf(v.y) + 128.0f, 1u, w);
    w = __builtin_amdgcn_cvt_pk_u8_f32(__builtin_rintf(v.z) + 128.0f, 2u, w); w = __builtin_amdgcn_cvt_pk_u8_f32(__builtin_rintf(v.w) + 128.0f, 3u, w);
    return w ^ 0x80808080u;
}
__device__ __forceinline__ void expert_rows_load(f32x4 (&a)[2][4], const float* pu, const float* pv, int e, int lane) {
#pragma unroll
    for (int r = 0; r < 2; ++r) { const GAS f32x4* src = (const GAS f32x4*)(((r & 1) ? pv : pu) + (size_t)e * D + 16 * lane);
#pragma unroll
        for (int q = 0; q < 4; ++q) a[r][q] = src[q]; }
}
__device__ __forceinline__ void expert_rows_finish(f32x4 (&a)[2][4], const float* norm2_g, unsigned char* ut, unsigned char* vt, float* suv, int e, int lane) {
    const GAS f32x4* sg = (const GAS f32x4*)(norm2_g + 16 * lane); f32x4 gq[4];
#pragma unroll
    for (int q = 0; q < 4; ++q) gq[q] = sg[q];
#pragma unroll
    for (int r = 0; r < 2; ++r) { const bool isv = (r & 1) != 0; float amax = 0.f;
#pragma unroll
        for (int q = 0; q < 4; ++q) { if (!isv) a[r][q] = a[r][q] * gq[q];
            amax = fmaxf(amax, fmaxf(fmaxf(fabsf(a[r][q].x), fabsf(a[r][q].y)), fmaxf(fabsf(a[r][q].z), fabsf(a[r][q].w)))); }
#pragma unroll
        for (int o = 1; o < 64; o <<= 1) amax = fmaxf(amax, __shfl_xor(amax, o));
        const float scale = amax > 0.f ? amax * (1.0f / 127.0f) : 1.0f, inv = amax > 0.f ? 127.0f / amax : 0.f;
        v4u o4;
#pragma unroll
        for (int q = 0; q < 4; ++q) o4[q] = pack_i8x4(a[r][q] * inv);
        const int sl = lane >> 3, mm = lane & 7;
        if (!isv) *(GAS v4u*)(ut + ((size_t)sl * NEXP + e) * 128 + (size_t)mm * 16) = o4;
        else {
            typedef unsigned v2u_t __attribute__((ext_vector_type(2)));
            const v2u_t ev = (v2u_t){__builtin_amdgcn_perm(o4[1], o4[0], 0x06040200u), __builtin_amdgcn_perm(o4[3], o4[2], 0x06040200u)}, od = (v2u_t){__builtin_amdgcn_perm(o4[1], o4[0], 0x07050301u), __builtin_amdgcn_perm(o4[3], o4[2], 0x07050301u)};
            unsigned char* row = vt + ((size_t)sl * NEXP + e) * 128 + (size_t)(mm >> 1) * 32 + (size_t)(mm & 1) * 8;
            *(GAS v2u_t*)row = ev; *(GAS v2u_t*)(row + 16) = od; }
        if (lane == 0) suv[2 * e + (isv ? 1 : 0)] = scale; }
}
__device__ __forceinline__ void p0_prologue(Frame& F) {
    LAS float* scr = (LAS float*)(F.lds + RING_OFF + F.wave * 16384);
    const int gw = F.vcu * NWAVES + F.wave, NGW = F.G * NWAVES;
    const float* w_in = F.in[2]; const float* w_out = F.in[9]; const float* peer_wq = F.in[11]; const float* norm2_g = F.in[10];
    constexpr int I_IN = (D / 64) * (NIN / 32), I_OUT = (D / 64) * (D / 32), I_WQ = (D / 64) * (NPQ / 32);
    constexpr int NITEMS = I_IN + I_OUT + I_WQ;
    for (int it = gw; it < NITEMS; it += NGW) {
        int r = it;
        if (r < I_IN) { p0_transpose_item<true>(w_in, D, NIN, nullptr, (bf16*)(F.ws + WS_WIN), scr, r, F.lane); continue; } r -= I_IN;
        if (r < I_OUT) { p0_transpose_item<false>(w_out, D, D, nullptr, (bf16*)(F.ws + WS_WOUT), scr, r, F.lane); continue; } r -= I_OUT;
        p0_transpose_item<false>(peer_wq, D, NPQ, norm2_g, (bf16*)(F.ws + WS_WQ), scr, r, F.lane);
    }
    const int gt = F.vcu * (NWAVES * 64) + F.tid, NGT = F.G * NWAVES * 64;
    { float* ig = (float*)(F.ws + WS_IG1); for (int i = gt; i < D; i += NGT) ig[i] = 1.0f / F.in[1][i]; }
    { const float* pk = F.in[12]; bf16* kb = (bf16*)(F.ws + WS_KEYS);
      for (int i = gt; i < 2 * 128 * 128 / 2; i += NGT) { const float a = pk[2 * i], b = pk[2 * i + 1]; ((GAS unsigned*)kb)[i] = pk2(a, b); } }
    { float* rt_ = (float*)(F.ws + WS_ROPE);
      for (int i = gt; i < 128 * 16; i += NGT) { const int pos = i >> 4, k = i & 15; const float inv = powf(10000.0f, -(float)k / 16.0f); const float ang = (float)pos * inv; float s, c; sincosf(ang, &s, &c); rt_[2 * i] = c; rt_[2 * i + 1] = s; } }
    for (int m = gw; m < M; m += 4 * NGW) rms_rows_to_bf16<4>(F.lane, F.in[0], F.in[1], (bf16*)(F.ws + WS_XN), (float*)(F.ws + WS_RSI), m, NGW);
}

__device__ __forceinline__ void conv_phase(Frame& F) {
    const bf16* H = (const bf16*)(F.ws + WS_H); bf16* MIX = (bf16*)(F.ws + WS_MIX);
    const float* cw = F.in[5]; const float* cb = F.in[6]; const float* lg = F.in[7]; const float* lb = F.in[8];
    LAS unsigned short* hs = (LAS unsigned short*)(F.lds + RING_OFF);
    LAS float* co = (LAS float*)(F.lds + RING_OFF + 63488);
    const int c = F.tid;
    float w[31];
#pragma unroll
    for (int j = 0; j < 31; ++j) w[j] = cw[j * 512 + c];
    const float bias = cb[c];
    constexpr int NT_ = M / 32;
    v4u hreg[8];
#define CONV_LOADH(tile_) do { const int t0_ = (tile_) * 32, tb_ = t0_ & ~(T - 1); _Pragma("unroll") for (int q_ = 0; q_ < 8; ++q_) { const int i_ = F.tid + q_ * (NWAVES * 64); const int r_ = i_ >> 6, ch_ = i_ & 63, tk_ = t0_ - 15 + r_; \
        hreg[q_] = (v4u){0u, 0u, 0u, 0u}; if (i_ < 62 * 64 && tk_ >= tb_ && tk_ < tb_ + T) hreg[q_] = *(const GAS v4u*)(H + (size_t)tk_ * 512 + ch_ * 8); } } while (0)
    const float* pu_ = F.in[13]; const float* pv_ = F.in[14]; unsigned char* ut_ = F.ws + WS_UT; unsigned char* vt_ = F.ws + WS_VT; float* suv_ = (float*)(F.ws + WS_SU);
    const int gwv = F.vcu * NWAVES + F.wave, NGWv = F.G * NWAVES; int eb = gwv;
    f32x4 tq[2][4];
    if (F.vcu < NT_) CONV_LOADH(F.vcu);
    for (int tile = F.vcu; tile < NT_; tile += F.G) {
        const int t0 = tile * 32;
        bool tb_ = eb < NEXP;
        if (tb_) expert_rows_load(tq, pu_, pv_, eb, F.lane);
#pragma unroll
        for (int q = 0; q < 8; ++q) { const int i = F.tid + q * (NWAVES * 64); if (i < 62 * 64) *(LAS v4u*)(hs + (i >> 6) * 512 + (i & 63) * 8) = hreg[q]; }
        __syncthreads();
        if (tile + F.G < NT_) CONV_LOADH(tile + F.G);
#pragma unroll 1
        for (int g = 0; g < 4; ++g) {
            if (g == 2) { if (tb_) { expert_rows_finish(tq, F.in[10], ut_, vt_, suv_, eb, F.lane); eb += NGWv; }
                          tb_ = eb < NEXP; if (tb_) expert_rows_load(tq, pu_, pv_, eb, F.lane); }
            float hv[38];
#pragma unroll
            for (int r = 0; r < 38; ++r) hv[r] = __uint_as_float((unsigned)hs[(g * 8 + r) * 512 + c] << 16);
#pragma unroll
            for (int tt = 0; tt < 8; ++tt) { float a = bias;
#pragma unroll
                for (int j = 0; j < 31; ++j) a += w[j] * hv[tt + j];
                co[(g * 8 + tt) * 512 + c] = a; }
        }
        __syncthreads();
#pragma unroll 1
        for (int q = 0; q < 4; ++q) { const int tt = F.wave * 4 + q;
            const f32x4 a = *(const LAS f32x4*)(co + tt * 512 + 8 * F.lane), b = *(const LAS f32x4*)(co + tt * 512 + 8 * F.lane + 4);
            const float mean = wave_sum((a.x + a.y) + (a.z + a.w) + (b.x + b.y) + (b.z + b.w)) * (1.f / 512.f);
            const f32x4 da = a - mean, db = b - mean;
            const float var = wave_sum((da.x * da.x + da.y * da.y) + (da.z * da.z + da.w * da.w) + (db.x * db.x + db.y * db.y) + (db.z * db.z + db.w * db.w)) * (1.f / 512.f);
            const float rstd = 1.f / sqrtf(var + RMS_EPS);
            const f32x4 g0 = *(const GAS f32x4*)(lg + 8 * F.lane), g1 = *(const GAS f32x4*)(lg + 8 * F.lane + 4), b0 = *(const GAS f32x4*)(lb + 8 * F.lane), b1 = *(const GAS f32x4*)(lb + 8 * F.lane + 4);
            f32x4 y0 = da * rstd * g0 + b0, y1 = db * rstd * g1 + b1;
#pragma unroll
            for (int e = 0; e < 4; ++e) { y0[e] = y0[e] * __builtin_amdgcn_rcpf(1.f + __builtin_amdgcn_exp2f(-1.4426950408889634f * y0[e])); y1[e] = y1[e] * __builtin_amdgcn_rcpf(1.f + __builtin_amdgcn_exp2f(-1.4426950408889634f * y1[e])); }
            v4u o; o.x = pk2(y0.x, y0.y); o.y = pk2(y0.z, y0.w); o.z = pk2(y1.x, y1.y); o.w = pk2(y1.z, y1.w);
            *(GAS v4u*)(MIX + (size_t)(t0 + tt) * 1024 + 512 + 8 * F.lane) = o; }
        if (tb_) { expert_rows_finish(tq, F.in[10], ut_, vt_, suv_, eb, F.lane); eb += NGWv; }
        __syncthreads();
    }
    for (; eb < NEXP; eb += NGWv) { expert_rows_load(tq, pu_, pv_, eb, F.lane); expert_rows_finish(tq, F.in[10], ut_, vt_, suv_, eb, F.lane); }
}

__device__ __forceinline__ unsigned f2sort(float x) { const unsigned u = __float_as_uint(x); return (u & 0x80000000u) ? ~u : (u | 0x80000000u); }
__device__ __forceinline__ float sort2f(unsigned s) { const unsigned u = (s & 0x80000000u) ? (s & 0x7fffffffu) : ~s; return __uint_as_float(u); }
template <bool DESC> __device__ __forceinline__ void ce(unsigned& a, unsigned& b) { const unsigned hi = a > b ? a : b, lo = a > b ? b : a; if (DESC) { a = hi; b = lo; } else { a = lo; b = hi; } }
template <int K, int J, bool DESC> __device__ __forceinline__ void bst(unsigned (&a)[16]) {
#pragma unroll
    for (int i = 0; i < 16; ++i) { const int l = i ^ J; if (l > i) { if (((i & K) == 0) == DESC) ce<true>(a[i], a[l]); else ce<false>(a[i], a[l]); } }
}
template <bool DESC> __device__ __forceinline__ void sort16(unsigned (&a)[16]) { ce<DESC>(a[0], a[1]); ce<DESC>(a[2], a[3]); ce<DESC>(a[0], a[2]); ce<DESC>(a[1], a[3]); ce<DESC>(a[1], a[2]); ce<DESC>(a[4], a[5]); ce<DESC>(a[6], a[7]); ce<DESC>(a[4], a[6]); ce<DESC>(a[5], a[7]); ce<DESC>(a[5], a[6]); ce<DESC>(a[0], a[4]); ce<DESC>(a[2], a[6]); ce<DESC>(a[2], a[4]); ce<DESC>(a[1], a[5]); ce<DESC>(a[3], a[7]); ce<DESC>(a[3], a[5]); ce<DESC>(a[1], a[2]); ce<DESC>(a[3], a[4]); ce<DESC>(a[5], a[6]); ce<DESC>(a[8], a[9]); ce<DESC>(a[10], a[11]); ce<DESC>(a[8], a[10]); ce<DESC>(a[9], a[11]); ce<DESC>(a[9], a[10]); ce<DESC>(a[12], a[13]); ce<DESC>(a[14], a[15]); ce<DESC>(a[12], a[14]); ce<DESC>(a[13], a[15]); ce<DESC>(a[13], a[14]); ce<DESC>(a[8], a[12]); ce<DESC>(a[10], a[14]); ce<DESC>(a[10], a[12]); ce<DESC>(a[9], a[13]); ce<DESC>(a[11], a[15]); ce<DESC>(a[11], a[13]); ce<DESC>(a[9], a[10]); ce<DESC>(a[11], a[12]); ce<DESC>(a[13], a[14]); ce<DESC>(a[0], a[8]); ce<DESC>(a[4], a[12]); ce<DESC>(a[4], a[8]); ce<DESC>(a[2], a[10]); ce<DESC>(a[6], a[14]); ce<DESC>(a[6], a[10]); ce<DESC>(a[2], a[4]); ce<DESC>(a[6], a[8]); ce<DESC>(a[10], a[12]); ce<DESC>(a[1], a[9]); ce<DESC>(a[5], a[13]); ce<DESC>(a[5], a[9]); ce<DESC>(a[3], a[11]); ce<DESC>(a[7], a[15]); ce<DESC>(a[7], a[11]); ce<DESC>(a[3], a[5]); ce<DESC>(a[7], a[9]); ce<DESC>(a[11], a[13]); ce<DESC>(a[1], a[2]); ce<DESC>(a[3], a[4]); ce<DESC>(a[5], a[6]); ce<DESC>(a[7], a[8]); ce<DESC>(a[9], a[10]); ce<DESC>(a[11], a[12]); ce<DESC>(a[13], a[14]); }
template <bool DESC> __device__ __forceinline__ void merge16(unsigned (&a)[16]) { bst<16, 8, DESC>(a); bst<16, 4, DESC>(a); bst<16, 2, DESC>(a); bst<16, 1, DESC>(a); }
__device__ __forceinline__ void max16(unsigned (&a)[16], const unsigned (&b)[16]) {
#pragma unroll
    for (int i = 0; i < 16; ++i) a[i] = a[i] > b[i] ? a[i] : b[i];
}
__device__ __forceinline__ void top16_of_128(unsigned (&g)[8][16]) {
    sort16<true>(g[0]); sort16<false>(g[1]); sort16<true>(g[2]); sort16<false>(g[3]); sort16<true>(g[4]); sort16<false>(g[5]); sort16<true>(g[6]); sort16<false>(g[7]);
    max16(g[0], g[1]); merge16<true>(g[0]); max16(g[2], g[3]); merge16<false>(g[2]); max16(g[4], g[5]); merge16<true>(g[4]); max16(g[6], g[7]); merge16<false>(g[6]);
    max16(g[0], g[2]); merge16<true>(g[0]); max16(g[4], g[6]); merge16<false>(g[4]);
    max16(g[0], g[4]); merge16<true>(g[0]);
}
__device__ __forceinline__ void top16_of_64(unsigned (&g)[4][16]) {
    sort16<true>(g[0]); sort16<false>(g[1]); sort16<true>(g[2]); sort16<false>(g[3]);
    max16(g[0], g[1]); merge16<true>(g[0]); max16(g[2], g[3]); merge16<false>(g[2]);
    max16(g[0], g[2]); merge16<true>(g[0]);
}

constexpr int P5_KEYS_BYTES = 65536, P5_SCR_OFF = 65536;
typedef float f32x2p5 __attribute__((ext_vector_type(2)));
__device__ __forceinline__ void topk_phase(Frame& F) {
    typedef float f32x16 __attribute__((ext_vector_type(16)));
    const bf16* QP = (const bf16*)(F.ws + WS_QP); const bf16* KEYS = (const bf16*)(F.ws + WS_KEYS);
    unsigned short* IDX = (unsigned short*)(F.ws + WS_IDX); float* GATE = (float*)(F.ws + WS_GATE); float* SUO = (float*)(F.ws + WS_SUO);
    const GAS f32x2p5* SUVt = (const GAS f32x2p5*)(F.ws + WS_SU);
    for (int i = F.tid; i < 256 * 16; i += NWAVES * 64) { const int row = i >> 4, ch = i & 15;
        const v4u v = *(const GAS v4u*)(KEYS + row * 128 + ch * 8); *(LAS v4u*)(F.lds + RING_OFF + row * 256 + ((ch ^ (row & 15)) << 4)) = v; }
    __syncthreads();
    const int lane = F.lane, r32 = lane & 31, hi = lane >> 5, h = F.wave;
    LAS unsigned char* scr = F.lds + RING_OFF + P5_SCR_OFF + F.wave * 2048 + lane * 32;
    const bool own = (F.G == 256); const int g_lo = own ? 4 * F.vcu : F.vcu, g_hi = own ? 4 * F.vcu + 4 : M / 32, g_st = own ? 1 : F.G;
    bf16x8 qf[2][8];
#define P5_LOADQ(grp_) do { const size_t tk_ = (size_t)((grp_) * 32 + r32); _Pragma("unroll") for (int s = 0; s < 2; ++s) _Pragma("unroll") for (int ks = 0; ks < 8; ++ks) \
        qf[s][ks] = *(const GAS bf16x8*)(QP + tk_ * NPQ + 256 * h + 128 * s + 16 * ks + 8 * hi); } while (0)
    for (int grp = g_lo; grp < g_hi; grp += g_st) {
        const int tok = grp * 32 + r32;
        P5_LOADQ(grp);
        f32x16 sc[2][4];
#pragma unroll
        for (int s = 0; s < 2; ++s)
#pragma unroll
            for (int kb = 0; kb < 4; ++kb) {
                f32x16 a = {};
                const int row = s * 128 + kb * 32 + r32;
#pragma unroll
                for (int ks = 0; ks < 8; ++ks) {
                    const bf16x8 kf = *(const LAS bf16x8*)(F.lds + RING_OFF + row * 256 + (((2 * ks + hi) ^ (row & 15)) << 4));
                    a = __builtin_amdgcn_mfma_f32_32x32x16_bf16(kf, qf[s][ks], a, 0, 0, 0);
                }
                sc[s][kb] = a;
            }
        unsigned g[8][16];
#pragma unroll
        for (int kb = 0; kb < 4; ++kb)
#pragma unroll
            for (int r = 0; r < 16; ++r) {
                auto rr = __builtin_amdgcn_permlane32_swap(__float_as_uint(sc[0][kb][r]), __float_as_uint(sc[1][kb][r]), false, false);
                const int key0 = 32 * kb + (r & 3) + 8 * (r >> 2);
                g[2 * kb][r] = (f2sort(__uint_as_float(rr[0])) & ~127u) | (unsigned)(127 - key0);
                g[2 * kb + 1][r] = (f2sort(__uint_as_float(rr[1])) & ~127u) | (unsigned)(127 - (key0 + 4));
            }
        top16_of_128(g);
        unsigned s1[16], s2[16];
#pragma unroll
        for (int i = 0; i < 16; ++i) { auto rr = __builtin_amdgcn_permlane32_swap(g[0][i], g[0][i], false, false); s1[i] = rr[0]; s2[i] = rr[1]; }
        {
            unsigned w1[4], w2[4];
#pragma unroll
            for (int q = 0; q < 4; ++q) {
                w1[q] = (127u - (s1[4 * q] & 127u)) | ((127u - (s1[4 * q + 1] & 127u)) << 8) | ((127u - (s1[4 * q + 2] & 127u)) << 16) | ((127u - (s1[4 * q + 3] & 127u)) << 24);
                w2[q] = (127u - (s2[4 * q] & 127u)) | ((127u - (s2[4 * q + 1] & 127u)) << 8) | ((127u - (s2[4 * q + 2] & 127u)) << 16) | ((127u - (s2[4 * q + 3] & 127u)) << 24);
            }
            *(LAS v4u*)(scr) = (v4u){w1[0], w1[1], w1[2], w1[3]}; *(LAS v4u*)(scr + 16) = (v4u){w2[0], w2[1], w2[2], w2[3]};
        }
        float v1[16], v2[16];
#pragma unroll
        for (int i = 0; i < 16; ++i) { v1[i] = sort2f(s1[i] & ~127u); v2[i] = sort2f(s2[i] & ~127u); }
        unsigned c[4][16];
        {
            int n = 0;
#pragma unroll
            for (int a = 0; a < 16; ++a)
#pragma unroll
                for (int b = 0; b < 16; ++b)
                    if ((a + 1) * (b + 1) <= 16) { c[n >> 4][n & 15] = (f2sort(v1[a] + v2[b]) & ~255u) | (unsigned)(255 - (16 * a + b)); ++n; }
#pragma unroll
            for (int q = 50; q < 64; ++q) c[q >> 4][q & 15] = 0u;
        }
        top16_of_64(c);
        asm volatile("s_waitcnt lgkmcnt(0)" ::: "memory");
        float ts[16]; unsigned ex[16];
#pragma unroll
        for (int k = 0; k < 16; ++k) {
            const unsigned ab = 255u - (c[0][k] & 255u); const unsigned a = ab >> 4, b = ab & 15u;
            const unsigned i1 = *(const LAS unsigned char*)(scr + a), i2 = *(const LAS unsigned char*)(scr + 16 + b);
            ex[k] = i1 * 128u + i2; ts[k] = sort2f(c[0][k] & ~255u);
        }
        float den = 0.f; const float tmax = ts[0];
#pragma unroll
        for (int k = 0; k < 16; ++k) { ts[k] = __builtin_amdgcn_exp2f((ts[k] - tmax) * 1.4426950408889634f); den += ts[k]; }
        const float rden = __builtin_amdgcn_rcpf(den);
        unsigned eo[8]; float go[8];
#pragma unroll
        for (int k = 0; k < 8; ++k) { eo[k] = hi ? ex[k + 8] : ex[k]; go[k] = (hi ? ts[k + 8] : ts[k]) * rden; }
        float so[8];
#pragma unroll
        for (int k = 0; k < 8; ++k) { const f32x2p5 sv2 = SUVt[eo[k]]; so[k] = sv2.x; go[k] *= sv2.y; }
        const size_t ob = (size_t)tok * 128 + h * 16 + hi * 8;
        *(GAS v4u*)(IDX + ob) = (v4u){eo[0] | (eo[1] << 16), eo[2] | (eo[3] << 16), eo[4] | (eo[5] << 16), eo[6] | (eo[7] << 16)};
        *(GAS f32x4*)(GATE + ob) = (f32x4){go[0], go[1], go[2], go[3]}; *(GAS f32x4*)(GATE + ob + 4) = (f32x4){go[4], go[5], go[6], go[7]};
        *(GAS f32x4*)(SUO + ob) = (f32x4){so[0], so[1], so[2], so[3]}; *(GAS f32x4*)(SUO + ob + 4) = (f32x4){so[4], so[5], so[6], so[7]};
    }
#undef P5_LOADQ
    __syncthreads();
}

typedef float f32x2 __attribute__((ext_vector_type(2)));
__device__ __forceinline__ v4u bufload16(__amdgpu_buffer_rsrc_t rsrc, unsigned voff, unsigned soff) { return __builtin_bit_cast(v4u, __builtin_amdgcn_raw_buffer_load_b128(rsrc, (int)voff, (int)soff, 0)); }
__device__ __forceinline__ int dot4(unsigned a, unsigned b, int c) { return __builtin_amdgcn_sdot4((int)a, (int)b, c, false); }
template <int CTRL> __device__ __forceinline__ int dpp_mov(int v) { return __builtin_amdgcn_update_dpp(0, v, CTRL, 0xf, 0xf, false); }
#ifndef P6_PREFETCH
#define P6_PREFETCH 0
#endif
template <bool VPASS>
__device__ __forceinline__ void p6_load(v4u (&u)[16], v4u& xq, unsigned& x1w, const __amdgpu_buffer_rsrc_t rt, const unsigned char* XQ, const bf16* X1B, LAS unsigned* ids, int tok0, int it, int g, int m,
                                        const __amdgpu_buffer_rsrc_t rpf_u, const __amdgpu_buffer_rsrc_t rpf_v, unsigned pfbase, int lane, unsigned& pv) {
    const int s = it >> 4, t = it & 15; const unsigned soff = (unsigned)s << 21;
    pv = 0u;
#if P6_PREFETCH
    if (lane < 4) {
        const bool last = (s == 7);
        if (!(VPASS && last)) {
            const unsigned nso = last ? 0u : (unsigned)(s + 1) << 21;
            pv = (unsigned)__builtin_amdgcn_raw_buffer_load_b32((!VPASS && !last) ? rpf_u : rpf_v, (int)(pfbase + 512u * (unsigned)t + 128u * (unsigned)lane), (int)nso, 0);
        }
    }
#endif
    if (VPASS) x1w = __builtin_nontemporal_load((const GAS unsigned*)(X1B + (size_t)(tok0 + t) * D + 128 * s + 2 * lane));
    else xq = __builtin_nontemporal_load((const GAS v4u*)(XQ + (size_t)(tok0 + t) * D + 128 * s + 16 * m));
    const v4u ia = *(const LAS v4u*)(ids + t * 64 + 8 * g), ib = *(const LAS v4u*)(ids + t * 64 + 8 * g + 4);
    const unsigned idw[8] = {ia.x, ia.y, ia.z, ia.w, ib.x, ib.y, ib.z, ib.w};
#pragma unroll
    for (int k = 0; k < 16; ++k) { const unsigned id = (k & 1) ? (idw[k >> 1] >> 16) : (idw[k >> 1] & 0xffffu); u[k] = bufload16(rt, (id << 7) | ((unsigned)m << 4), soff); }
}
__device__ __forceinline__ void p6_comp_u(const v4u (&u)[16], const v4u xq, LAS int* da, int it, int lane) {
    const int t = it & 15;
    int p[16];
#pragma unroll
    for (int k = 0; k < 16; ++k) { int q0; asm("v_dot4_i32_i8 %0, %1, %2, 0" : "=v"(q0) : "v"(u[k].x), "v"(xq.x));
        p[k] = dot4(u[k].w, xq.w, dot4(u[k].z, xq.z, dot4(u[k].y, xq.y, q0))); }
    asm volatile("s_nop 1\n\t"
        "v_add_u32_dpp %0, %0, %0 row_half_mirror row_mask:0xf bank_mask:0x5\n\tv_add_u32_dpp %1, %1, %1 row_half_mirror row_mask:0xf bank_mask:0x5\n\t"
        "v_add_u32_dpp %2, %2, %2 row_half_mirror row_mask:0xf bank_mask:0x5\n\tv_add_u32_dpp %3, %3, %3 row_half_mirror row_mask:0xf bank_mask:0x5\n\t"
        "v_add_u32_dpp %4, %4, %4 row_half_mirror row_mask:0xf bank_mask:0x5\n\tv_add_u32_dpp %5, %5, %5 row_half_mirror row_mask:0xf bank_mask:0x5\n\t"
        "v_add_u32_dpp %6, %6, %6 row_half_mirror row_mask:0xf bank_mask:0x5\n\tv_add_u32_dpp %7, %7, %7 row_half_mirror row_mask:0xf bank_mask:0x5\n\t"
        "v_add_u32_dpp %0, %8, %8 row_half_mirror row_mask:0xf bank_mask:0xa\n\tv_add_u32_dpp %1, %9, %9 row_half_mirror row_mask:0xf bank_mask:0xa\n\t"
        "v_add_u32_dpp %2, %10, %10 row_half_mirror row_mask:0xf bank_mask:0xa\n\tv_add_u32_dpp %3, %11, %11 row_half_mirror row_mask:0xf bank_mask:0xa\n\t"
        "v_add_u32_dpp %4, %12, %12 row_half_mirror row_mask:0xf bank_mask:0xa\n\tv_add_u32_dpp %5, %13, %13 row_half_mirror row_mask:0xf bank_mask:0xa\n\t"
        "v_add_u32_dpp %6, %14, %14 row_half_mirror row_mask:0xf bank_mask:0xa\n\tv_add_u32_dpp %7, %15, %15 row_half_mirror row_mask:0xf bank_mask:0xa\n\ts_nop 1"
        : "+v"(p[0]), "+v"(p[1]), "+v"(p[2]), "+v"(p[3]), "+v"(p[4]), "+v"(p[5]), "+v"(p[6]), "+v"(p[7])
        : "v"(p[8]), "v"(p[9]), "v"(p[10]), "v"(p[11]), "v"(p[12]), "v"(p[13]), "v"(p[14]), "v"(p[15]));
    { const bool up = (lane & 2) != 0;
#pragma unroll
      for (int k = 0; k < 4; ++k) { const int keep = up ? p[k + 4] : p[k], send = up ? p[k] : p[k + 4]; p[k] = keep + dpp_mov<0x4E>(send); } }
    { const bool up = (lane & 1) != 0;
#pragma unroll
      for (int k = 0; k < 2; ++k) { const int keep = up ? p[k + 2] : p[k], send = up ? p[k] : p[k + 2]; p[k] = keep + dpp_mov<0xB1>(send); } }
    typedef int i32x2 __attribute__((ext_vector_type(2)));
    LAS i32x2* dp = (LAS i32x2*)(da + t * 128 + 2 * lane); i32x2 dv = *dp; dv.x += p[0]; dv.y += p[1]; *dp = dv;
}
typedef int v2i32_t __attribute__((ext_vector_type(2)));
constexpr int P6_PLANE = 1040;
__device__ __forceinline__ void p6_comp_v(const v4u (&u)[16], const unsigned x1w, LAS unsigned char* img, const LAS unsigned char* wq, const LAS float* sc, bf16* XF, int tok0, int it, int lane, int g, int m) {
    const int s = it >> 4, t = it & 15;
    const int h = lane >> 5, pp = (lane >> 4) & 1, i16 = lane & 15;
    LAS unsigned char* wa = img + m * P6_PLANE + (8 * g) * 16;
    const LAS unsigned char* ra = img + (4 * h) * P6_PLANE + (8 * pp + (i16 >> 1)) * 16 + 8 * (i16 & 1);
    v4u W4[4];
#pragma unroll
    for (int n = 0; n < 4; ++n) W4[n] = *(const LAS v4u*)(wq + t * 128 + (2 * n + pp) * 16);
    int a[4] = {0, 0, 0, 0};
#pragma unroll
    for (int hf = 0; hf < 2; ++hf) {
#pragma unroll
        for (int k = 0; k < 8; ++k) *(LAS v4u*)(wa + 16 * k) = u[8 * hf + k];
#pragma unroll
        for (int n = 0; n < 4; ++n)
#pragma unroll
            for (int dbi = 0; dbi < 4; ++dbi) {
                const v2i32_t v = __builtin_amdgcn_ds_read_tr8_b64_v2i32((LAS v2i32_t*)(ra + dbi * P6_PLANE + 256 * n));
                a[dbi] = dot4((unsigned)v.y, W4[n][2 * hf + 1], dot4((unsigned)v.x, W4[n][2 * hf], a[dbi]));
            }
    }
    int tot[2];
#pragma unroll
    for (int d = 0; d < 2; ++d) { auto rr = __builtin_amdgcn_permlane16_swap((unsigned)a[d], (unsigned)a[d + 2], false, false); tot[d] = (int)rr[0] + (int)rr[1]; }
    const float sw = sc[16 + t];
    const float xf0 = __uint_as_float(x1w << 16) + (float)tot[0] * sw, xf1 = __uint_as_float(x1w & 0xffff0000u) + (float)tot[1] * sw;
    __builtin_nontemporal_store(pk2(xf0, xf1), (GAS unsigned*)(XF + (size_t)(tok0 + t) * D + 128 * s + 2 * lane));
}
__device__ __forceinline__ void peer_phase(Frame& F) {
    const bf16* X1B = (const bf16*)(F.ws + WS_XN); bf16* XF = (bf16*)(F.ws + WS_MIX);
    unsigned char* XQ = F.ws + WS_XQ;
    const unsigned short* IDX = (const unsigned short*)(F.ws + WS_IDX); const float* GATE = (const float*)(F.ws + WS_GATE); const float* SS = (const float*)(F.ws + WS_SS);
    const float* SUO = (const float*)(F.ws + WS_SUO);
    const float* fg = F.in[15]; float* OUT = F.out;
    const int lane = F.lane, g = lane >> 3, m = lane & 7;
    const __amdgpu_buffer_rsrc_t ru = __builtin_amdgcn_make_buffer_rsrc((void*)(F.ws + WS_UT), 0, 16 << 20, 0x00020000);
    const __amdgpu_buffer_rsrc_t rv = __builtin_amdgcn_make_buffer_rsrc((void*)(F.ws + WS_VT), 0, 16 << 20, 0x00020000);
    LAS unsigned char* wl = F.lds + RING_OFF + F.wave * 16384;
    LAS unsigned* ids = (LAS unsigned*)wl;
    LAS int* da = (LAS int*)(wl + 4096);
    LAS unsigned char* img = wl + 4096;
    LAS unsigned char* wq = wl + 12416;
    LAS float* sc = (LAS float*)(wl + 14464);
    const int gw = F.vcu * NWAVES + F.wave, NGW = F.G * NWAVES;
    const unsigned pfbase = (unsigned)(((F.vcu & 31) * NWAVES + F.wave) * 8192);
    for (int tg = gw; tg < M / 16; tg += NGW) {
        const int tok0 = tg * 16;
#pragma unroll 1
        for (int tb = 0; tb < 16; tb += 4) {
            v4u xa[4], xb[4]; unsigned idv[4];
#pragma unroll
            for (int j = 0; j < 4; ++j) { const int t = tb + j;
                idv[j] = *(const GAS unsigned*)(IDX + (size_t)(tok0 + t) * 128 + 2 * lane);
                const GAS v4u* xp = (const GAS v4u*)(X1B + (size_t)(tok0 + t) * D + 16 * lane); xa[j] = xp[0]; xb[j] = xp[1]; }
#pragma unroll
            for (int j = 0; j < 4; ++j) { const int t = tb + j;
                ids[t * 64 + lane] = idv[j];
                typedef int i32x2 __attribute__((ext_vector_type(2)));
                *(LAS i32x2*)(da + t * 128 + 2 * lane) = (i32x2){0, 0};
                const unsigned xw[8] = {xa[j].x, xa[j].y, xa[j].z, xa[j].w, xb[j].x, xb[j].y, xb[j].z, xb[j].w};
                float xv[16]; float amax = 0.f;
#pragma unroll
                for (int q = 0; q < 8; ++q) { xv[2 * q] = __uint_as_float(xw[q] << 16); xv[2 * q + 1] = __uint_as_float(xw[q] & 0xffff0000u); amax = fmaxf(amax, fmaxf(fabsf(xv[2 * q]), fabsf(xv[2 * q + 1]))); }
#pragma unroll
                for (int o = 1; o < 64; o <<= 1) amax = fmaxf(amax, __shfl_xor(amax, o));
                const float inv = amax > 0.f ? 127.0f / amax : 0.f;
                v4u o4;
#pragma unroll
                for (int q = 0; q < 4; ++q) o4[q] = pack_i8x4((f32x4){xv[4 * q], xv[4 * q + 1], xv[4 * q + 2], xv[4 * q + 3]} * inv);
                *(GAS v4u*)(XQ + (size_t)(tok0 + t) * D + 16 * lane) = o4;
                if (lane == 0) sc[t] = amax > 0.f ? amax * (1.0f / 127.0f) : 1.0f; }
        }
        asm volatile("s_waitcnt vmcnt(0)" ::: "memory");
        {
            v4u uA[16], uB[16]; v4u xA, xB; unsigned dummy; unsigned pvA, pvB, pfacc = 0u;
            p6_load<false>(uA, xA, dummy, ru, XQ, X1B, ids, tok0, 0, g, m, ru, rv, pfbase, lane, pvA);
#pragma unroll 1
            for (int it = 0; it < 128; it += 2) {
                p6_load<false>(uB, xB, dummy, ru, XQ, X1B, ids, tok0, it + 1, g, m, ru, rv, pfbase, lane, pvB);
                p6_comp_u(uA, xA, da, it, lane);
                pfacc ^= pvA; p6_load<false>(uA, xA, dummy, ru, XQ, X1B, ids, tok0, (it + 2 < 128) ? it + 2 : 127, g, m, ru, rv, pfbase, lane, pvA);
                p6_comp_u(uB, xB, da, it + 1, lane); pfacc ^= pvB;
            }
            asm volatile("" :: "v"(pfacc ^ pvA));
        }
#pragma unroll 1
        for (int tb = 0; tb < 16; tb += 4) {
            float ssv[4]; f32x2 gt2[4]; f32x2 su2[4];
#pragma unroll
            for (int j = 0; j < 4; ++j) { const int t = tb + j, tok = tok0 + t;
                ssv[j] = (lane < 16) ? SS[(size_t)tok * 16 + lane] : 0.f;
                gt2[j] = *(const GAS f32x2*)(GATE + (size_t)tok * 128 + 2 * lane);
                su2[j] = *(const GAS f32x2*)(SUO + (size_t)tok * 128 + 2 * lane); }
#pragma unroll
            for (int j = 0; j < 4; ++j) { const int t = tb + j;
                const float rstd2 = 1.f / sqrtf(wave_sum(ssv[j]) * (1.f / D) + RMS_EPS);
                typedef int i32x2 __attribute__((ext_vector_type(2)));
                const i32x2 dv = *(const LAS i32x2*)(da + t * 128 + 2 * lane);
                const float zs = sc[t] * rstd2;
                const float z0 = (float)dv.x * su2[j].x * zs, z1 = (float)dv.y * su2[j].y * zs;
                const float h0 = z0 * __builtin_amdgcn_rcpf(1.f + __builtin_amdgcn_exp2f(-1.4426950408889634f * 1.5957691216057308f * (z0 + 0.044715f * z0 * z0 * z0)));
                const float h1 = z1 * __builtin_amdgcn_rcpf(1.f + __builtin_amdgcn_exp2f(-1.4426950408889634f * 1.5957691216057308f * (z1 + 0.044715f * z1 * z1 * z1)));
                const float w0 = gt2[j].x * h0, w1 = gt2[j].y * h1;
                float wmax = fmaxf(fabsf(w0), fabsf(w1));
#pragma unroll
                for (int o = 1; o < 64; o <<= 1) wmax = fmaxf(wmax, __shfl_xor(wmax, o));
                const float winv = wmax > 0.f ? 127.0f / wmax : 0.f;
                const int q0 = (int)__builtin_rintf(w0 * winv), q1 = (int)__builtin_rintf(w1 * winv);
                *(LAS unsigned short*)(wq + t * 128 + 2 * lane) = (unsigned short)((q0 & 0xff) | ((q1 & 0xff) << 8));
                if (lane == 0) sc[16 + t] = wmax * (1.0f / 127.0f); }
        }
        {
            v4u uA[16], uB[16]; unsigned xA, xB; v4u dummy; unsigned pvA, pvB, pfacc = 0u;
            p6_load<true>(uA, dummy, xA, rv, XQ, X1B, ids, tok0, 0, g, m, ru, rv, pfbase, lane, pvA);
#pragma unroll 1
            for (int it = 0; it < 128; it += 2) {
                p6_load<true>(uB, dummy, xB, rv, XQ, X1B, ids, tok0, it + 1, g, m, ru, rv, pfbase, lane, pvB);
                p6_comp_v(uA, xA, img, wq, sc, XF, tok0, it, lane, g, m);
                pfacc ^= pvA; p6_load<true>(uA, dummy, xA, rv, XQ, X1B, ids, tok0, (it + 2 < 128) ? it + 2 : 127, g, m, ru, rv, pfbase, lane, pvA);
                p6_comp_v(uB, xB, img, wq, sc, XF, tok0, it + 1, lane, g, m); pfacc ^= pvB;
            }
            asm volatile("" :: "v"(pfacc ^ pvA));
        }
#pragma unroll 1
        for (int tb = 0; tb < 16; tb += 4) {
            unsigned xw[4][8];
#pragma unroll
            for (int j = 0; j < 4; ++j)
#pragma unroll
                for (int s = 0; s < 8; ++s) xw[j][s] = *(const GAS unsigned*)(XF + (size_t)(tok0 + tb + j) * D + 128 * s + 2 * lane);
            f32x2 gg[8];
#pragma unroll
            for (int s = 0; s < 8; ++s) gg[s] = *(const GAS f32x2*)(fg + 128 * s + 2 * lane);
#pragma unroll
            for (int j = 0; j < 4; ++j) {
                float ss = 0.f;
#pragma unroll
                for (int s = 0; s < 8; ++s) { const float a0 = __uint_as_float(xw[j][s] << 16), a1 = __uint_as_float(xw[j][s] & 0xffff0000u); ss += a0 * a0 + a1 * a1; }
                const float rstd = 1.f / sqrtf(wave_sum(ss) * (1.f / D) + RMS_EPS);
#pragma unroll
                for (int s = 0; s < 8; ++s) { const size_t off = (size_t)(tok0 + tb + j) * D + 128 * s + 2 * lane;
                    f32x2 ov = (f32x2){__uint_as_float(xw[j][s] << 16) * rstd * gg[s].x, __uint_as_float(xw[j][s] & 0xffff0000u) * rstd * gg[s].y};
                    __builtin_nontemporal_store(ov, (GAS f32x2*)(OUT + off)); }
            }
        }
    }
}

struct Args { const float* in[16]; float* out; unsigned char* ws; int ph_lo, ph_hi, li, pad; };
__global__ void __launch_bounds__(NWAVES * 64, 2) mk_fwd(Args args) {
    extern __shared__ __attribute__((aligned(16))) unsigned char lds[];
    Frame F;
    F.lds = (LAS unsigned char*)lds;
    F.MISC = (volatile LAS unsigned*)(F.lds + MISC_OFF);
    F.tid = threadIdx.x; F.lane = F.tid & 63; F.wave = __builtin_amdgcn_readfirstlane(F.tid >> 6);
    F.G = gridDim.x; { const int bx = blockIdx.x; F.vcu = (F.G % 8 == 0) ? (bx % 8) * (F.G / 8) + bx / 8 : bx; }
#define GRID_BAR(seam) do { if (N_LAUNCHES == PER_PHASE) { if (F.tid == 0) __hip_atomic_store(F.ctl + CW_TMO, 0xBADBA0u | (unsigned)(seam), RLX_AGENT); } \
    else { xcd_barrier(bar); } } while (0)
    unsigned char* ws = args.ws;
    F.ctl = (gu32*)(ws + WS_CTL); F.ws = ws; F.out = args.out;
#pragma unroll
    for (int i = 0; i < 16; ++i) F.in[i] = args.in[i];
    for (int u = F.tid; u < (LDS_BYTES - LDSCTL_OFF) / 4; u += NWAVES * 64) ((LAS unsigned*)(F.lds + LDSCTL_OFF))[u] = 0u;
    __syncthreads();
    XcdBarrier bar; bar.bar = (unsigned*)(F.ctl + CW_BAR); bar.x = 0; bar.st = nullptr;
    if (N_LAUNCHES != PER_PHASE) bar = xcd_barrier_post((unsigned*)(F.ctl + CW_BAR), F.MISC + 8);

    const pg8::WsSt WST{__builtin_amdgcn_make_buffer_rsrc((void*)ws, 0, (int)WS_END, 0x00020000), ws};
    const int lo = args.ph_lo, hi = args.ph_hi;
#define IN(k) (lo <= (k) && (k) < hi)
#define BOTH(k) (IN(k) && IN((k) + 1))

    if (IN(0)) { p0_prologue(F); if (BOTH(0)) GRID_BAR(0); }

    if (IN(1)) {
        pg8::Gemm g{(const pg8::bf16_t*)(ws + WS_XN), (const pg8::bf16_t*)(ws + WS_WIN), M, NIN, D}; pg8::StaticOrder S; S.init(M, NIN, F.G, (int)blockIdx.x);
        pg8::EpiP1 E{WST, WS_Q, WS_K, WS_V8T, WS_H, F.in[3], F.in[4], (const float*)(ws + WS_ROPE), attn_body::C2};
        pg8::gemm_phase<pg8::EpiP1, pg8::StaticOrder, PG8_ALIGN, PG8_SP2>(F.lds + RING_OFF, g, S, E);
        if (BOTH(1)) GRID_BAR(1);
    }

    if (IN(2)) {
        const attn_body::AttnTensors AT{(const attn_body::bf16*)(ws + WS_Q), (const attn_body::bf16*)(ws + WS_K), (const attn_body::bf16*)(ws + WS_V8T), (attn_body::bf16*)(ws + WS_MIX)};
        const attn_body::StaticOrder S((int)F.G, (int)blockIdx.x);
        bool attn_fast;
        { const float gq = fabsf(F.in[3][F.lane]), gk = fabsf(F.in[4][F.lane]); float mq = gq, mk = gk;
#pragma unroll
          for (int o = 1; o < 64; o <<= 1) { mq = fmaxf(mq, __shfl_xor(mq, o)); mk = fmaxf(mk, __shfl_xor(mk, o)); }
          attn_fast = (64.0f * attn_body::C2 * mq * mk <= 14.0f); }
#if defined(FORCE_ATTN_SLOW)
        attn_fast = false;
#endif
        attn_body::attn_phase<attn_body::StaticOrder>((char*)lds + RING_OFF, AT, S, attn_fast);
        __syncthreads();
        conv_phase(F);
        if (BOTH(2)) GRID_BAR(2);
    }

    if (IN(3)) {
        pg8::Gemm g{(const pg8::bf16_t*)(ws + WS_MIX), (const pg8::bf16_t*)(ws + WS_WOUT), M, D, D}; pg8::StaticOrder S; S.init(M, D, F.G, (int)blockIdx.x);
        pg8::EpiP3 E{WST, WS_XN, (pg8::bf16_t*)(ws + WS_XN), (const float*)(ws + WS_RSI), (const float*)(ws + WS_IG1), (float*)(ws + WS_SS)};
        pg8::gemm_phase<pg8::EpiP3, pg8::StaticOrder, PG8_ALIGN, PG8_SP2>(F.lds + RING_OFF, g, S, E);
        if (BOTH(3)) GRID_BAR(3);
    }

    if (IN(4)) {
        pg8::Gemm g{(const pg8::bf16_t*)(ws + WS_XN), (const pg8::bf16_t*)(ws + WS_WQ), M, NPQ, D}; pg8::StaticOrder S; S.init(M, NPQ, F.G, (int)blockIdx.x);
        pg8::EpiP4 E{WST, WS_QP, (const float*)(ws + WS_SS)};
        pg8::gemm_phase<pg8::EpiP4, pg8::StaticOrder, PG8_ALIGN, PG8_SP2>(F.lds + RING_OFF, g, S, E);
        if (BOTH(4)) GRID_BAR(4);
    }

    if (IN(5)) { topk_phase(F); if (BOTH(5)) { if (F.G == 256) { asm volatile("s_waitcnt vmcnt(0)" ::: "memory"); __syncthreads(); } else GRID_BAR(5); } }

    if (IN(6)) { peer_phase(F); }
#undef IN
#undef BOTH
}

extern "C" void kernel_launch(void* const* d_in, const int* in_sizes, int n_in, void* d_out, int out_size, void* d_ws, size_t ws_size, hipStream_t stream) {
    static int grid = 0;
    if (grid == 0) {
        if (n_in != 16 || in_sizes[0] != M * D || out_size != M * D || ws_size < WS_END) { fprintf(stderr, "kernel_launch: built for 16 inputs, x and out of %d floats, >= %zu bytes of workspace; got n_in %d, in0 %d, out %d, ws %zu; nothing launched\n", M * D, (size_t)WS_END, n_in, n_in > 0 ? in_sizes[0] : -1, out_size, ws_size); grid = -1; return; }
        int dev = 0, cus = 0, per_cu = 0;
        if (hipGetDevice(&dev) != hipSuccess || hipDeviceGetAttribute(&cus, hipDeviceAttributeMultiprocessorCount, dev) != hipSuccess) { fprintf(stderr, "kernel_launch: hipGetDevice / hipDeviceGetAttribute failed; nothing launched\n"); grid = -1; return; }
        if (hipFuncSetAttribute((const void*)mk_fwd, hipFuncAttributeMaxDynamicSharedMemorySize, LDS_BYTES) != hipSuccess) { fprintf(stderr, "kernel_launch: hipFuncSetAttribute failed\n"); grid = -1; return; }
        if (hipOccupancyMaxActiveBlocksPerMultiprocessor(&per_cu, (const void*)mk_fwd, NWAVES * 64, LDS_BYTES) != hipSuccess || per_cu < 1)
            fprintf(stderr, "kernel_launch: note: the occupancy query reports %d workgroups per CU\n", per_cu);
        (void)hipGetLastError();
        grid = cus;
        if (grid != 256) { fprintf(stderr, "kernel_launch: this kernel's static work deals are built for the 256 CUs of an MI355X; found %d; nothing launched\n", grid); grid = -1; return; }
    }
    if (grid < 0) return;
    if (hipMemsetAsync((char*)d_ws + WS_CTL, 0, CTL_ZERO_BYTES, stream) != hipSuccess) { fprintf(stderr, "kernel_launch: hipMemsetAsync of the control words failed; nothing launched\n"); return; }
    Args a{};
    for (int i = 0; i < 16; ++i) a.in[i] = (const float*)d_in[i];
    a.out = (float*)d_out; a.ws = (unsigned char*)d_ws;
    for (int li = 0; li < N_LAUNCHES; ++li) {
        a.ph_lo = (N_LAUNCHES == PER_PHASE) ? li : 0; a.ph_hi = (N_LAUNCHES == PER_PHASE) ? li + 1 : PER_PHASE; a.li = li;
        hipLaunchKernelGGL(mk_fwd, dim3(grid), dim3(NWAVES * 64), LDS_BYTES, stream, a);
        const hipError_t le = hipPeekAtLastError();
        if (le != hipSuccess) { fprintf(stderr, "kernel_launch: launch %d failed: %s\n", li, hipGetErrorName(le)); break; }
    }
}
```

```cpp
#include <hip/hip_runtime.h>
#include <cstdio>
#include <cstdint>
namespace pg8 {
#define PG8_LAS __attribute__((address_space(3)))
typedef unsigned short bf16_t;
typedef short bf16x8 __attribute__((ext_vector_type(8)));
typedef float f32x4 __attribute__((ext_vector_type(4)));
typedef unsigned u32x4 __attribute__((ext_vector_type(4)));
constexpr int BM = 256, BK = 64, HALF = 128, HTB = HALF * BK * 2  , STAGE_BYTES = 8 * HTB, NXCD = 8, WGM = 8;

__host__ __device__ __forceinline__ int lds_byte(int r, int c) { const int st = (r >> 4) * 2 + (c >> 5), rr = r & 15, cc = c & 31, ob = rr * 64 + cc * 2; return st * 1024 + (ob ^ (((ob >> 9) & 1) << 5)); }
__host__ __device__ __forceinline__ void stage_rc(int b, int& R, int& C) { const int st = b / 1024, sb = b % 1024, swz = sb ^ (((sb >> 9) & 1) << 5); R = (st >> 1) * 16 + swz / 64; C = (st & 1) * 32 + (swz % 64) / 2; }
__host__ __device__ __forceinline__ int perm32(int rho) { const int n = rho >> 4, i = rho & 15; return 8 * (i >> 2) + 4 * n + (i & 3); }

struct Unit { int pm, pn; };
struct Gemm { const bf16_t* A; const bf16_t* Bt; int M, N, K; };

struct StaticOrder {
    int nM, nN, nwg, G, c;
    __host__ __device__ void init(int M, int N, int G_, int c_) { nM = M / BM; nN = N / BM; nwg = nM * nN; G = G_; c = c_; }
    __host__ __device__ bool next(int i, Unit& u) const {
        const long L = (long)i * G + c; if (L >= nwg) return false;
        int wgid = (int)L; { const int q = nwg / NXCD, r = nwg % NXCD, xcd = wgid % NXCD, off = wgid / NXCD; wgid = (xcd < r ? xcd * (q + 1) : r * (q + 1) + (xcd - r) * q) + off; }
        const int nig = WGM * nN, gid = wgid / nig, fm = gid * WGM, gsz = (nM - fm) < WGM ? (nM - fm) : WGM;
        u.pm = fm + ((wgid % nig) % gsz); u.pn = (wgid % nig) / gsz; return true;
    }
    __device__ __forceinline__ void a_ready(const Unit&) const {}
    __device__ __forceinline__ void done(const Unit&) const {}
};


__device__ __forceinline__ unsigned cvt_pk_bf16(float lo, float hi) { unsigned r; asm volatile("v_cvt_pk_bf16_f32 %0, %1, %2" : "=v"(r) : "v"(lo), "v"(hi)); return r; }
typedef unsigned u32x2 __attribute__((ext_vector_type(2)));
__device__ __forceinline__ u32x4 pack8(const f32x4 a, const f32x4 b) { u32x4 w; w.x = cvt_pk_bf16(a[0], a[1]); w.y = cvt_pk_bf16(a[2], a[3]); w.z = cvt_pk_bf16(b[0], b[1]); w.w = cvt_pk_bf16(b[2], b[3]); return w; }

#ifndef WT_STORES
#define WT_STORES 0
#endif
struct WsSt { __amdgpu_buffer_rsrc_t rs; unsigned char* base;
    __device__ __forceinline__ void st16(size_t off, const u32x4 v) const {
#if WT_STORES
        __builtin_amdgcn_raw_buffer_store_b128(v, rs, (int)(unsigned)off, 0, 16);
#else
        *(u32x4*)(base + off) = v;
#endif
    } };
struct EpiP1 {
    static constexpr bool PERM = true, AFTER_DRAIN = false;
    WsSt W; size_t oQ, oK, oV, oH; const float *qg, *kg; const float* rope; float qscale;
    __device__ __forceinline__ void operator()(const f32x4 (&acc)[2][2][4][2], const Unit& u, int wr, int wc, int fr, int fq) const {
        const int row0 = u.pm * BM + wr * 64 + fr;
        if (u.pn < 2 || (u.pn == 2 && wc < 2)) {
            const bool isq = u.pn < 2;
            const float* g = isq ? qg : kg;
            f32x4 gv[2][2];
#pragma unroll
            for (int bj = 0; bj < 2; ++bj)
#pragma unroll
                for (int n = 0; n < 2; ++n) gv[bj][n] = *(const f32x4*)(g + 32 * bj + 16 * n + 4 * fq);
            const float sc = isq ? qscale : 1.f;
            const size_t base = isq ? (oQ + (size_t)(4 * u.pn + wc) * 64) : (oK + (size_t)wc * 64);
            const int pitch = isq ? 512 : 128;
            f32x4 rA[2][2], rB[4][2];
#pragma unroll
            for (int ai = 0; ai < 2; ++ai) { const int pos = ((row0 + ai * HALF) & 8191) >> 6; const f32x4* rp = (const f32x4*)(rope + (pos * 16 + 4 * fq) * 2); rA[ai][0] = rp[0]; rA[ai][1] = rp[1]; }
#pragma unroll
            for (int m = 0; m < 4; ++m) { const int pos = (row0 + m * 16) & 63; const f32x4* rp = (const f32x4*)(rope + (pos * 16 + 4 * fq) * 2); rB[m][0] = rp[0]; rB[m][1] = rp[1]; }
#pragma unroll
            for (int ai = 0; ai < 2; ++ai)
#pragma unroll
                for (int m = 0; m < 4; ++m) {
                    const int row = row0 + ai * HALF + m * 16;
                    float ss = 0.f;
#pragma unroll
                    for (int bj = 0; bj < 2; ++bj)
#pragma unroll
                        for (int n = 0; n < 2; ++n) { const f32x4 v = acc[ai][bj][m][n]; ss += (v[0] * v[0] + v[1] * v[1]) + (v[2] * v[2] + v[3] * v[3]); }
                    ss += __shfl_xor(ss, 16); ss += __shfl_xor(ss, 32);
                    const float rstd = __builtin_amdgcn_rsqf(ss * (1.0f / 64.0f) + 1e-6f) * sc;
#pragma unroll
                    for (int bj = 0; bj < 2; ++bj) {
                        const f32x4 r01 = bj ? rB[m][0] : rA[ai][0], r23 = bj ? rB[m][1] : rA[ai][1];
                        const f32x4 x1 = acc[ai][bj][m][0] * gv[bj][0] * rstd, x2 = acc[ai][bj][m][1] * gv[bj][1] * rstd;
                        const f32x4 cs = (f32x4){r01[0], r01[2], r23[0], r23[2]}, sn = (f32x4){r01[1], r01[3], r23[1], r23[3]};
                        const f32x4 o1 = x1 * cs - x2 * sn, o2 = x2 * cs + x1 * sn;
                        u32x2 w8; { int lo = 0, hi_ = 0;
                            lo = __builtin_amdgcn_cvt_pk_fp8_f32(o1[0], o1[1], lo, false); lo = __builtin_amdgcn_cvt_pk_fp8_f32(o1[2], o1[3], lo, true);
                            hi_ = __builtin_amdgcn_cvt_pk_fp8_f32(o2[0], o2[1], hi_, false); hi_ = __builtin_amdgcn_cvt_pk_fp8_f32(o2[2], o2[3], hi_, true); w8.x = (unsigned)lo; w8.y = (unsigned)hi_; }
                        *(u32x2*)(W.base + base + (size_t)row * pitch + 32 * bj + 8 * fq) = w8;
                    }
                }
        } else if (u.pn == 2) {
            const int hk = wc - 2, s0 = 32 * ((fr >> 2) & 1) + 4 * (fr >> 3) + (fr & 3);
#pragma unroll
            for (int ai = 0; ai < 2; ++ai) {
                const int rowa = row0 + ai * HALF;
                unsigned char* tb = W.base + oV + (size_t)((rowa >> 13) * 256 + hk * 128 + ((rowa & 8191) >> 6)) * 4096 + s0;
#pragma unroll
                for (int bj = 0; bj < 2; ++bj)
#pragma unroll
                    for (int n = 0; n < 2; ++n)
#pragma unroll
                        for (int e = 0; e < 4; ++e) {
                            int pk = 0;
                            pk = __builtin_amdgcn_cvt_pk_fp8_f32(acc[ai][bj][0][n][e], acc[ai][bj][1][n][e], pk, false); pk = __builtin_amdgcn_cvt_pk_fp8_f32(acc[ai][bj][2][n][e], acc[ai][bj][3][n][e], pk, true);
                            unsigned char* pd = tb + (32 * bj + 8 * fq + 4 * n + e) * 64;
                            pd[0] = (unsigned char)(pk & 0xff); pd[8] = (unsigned char)((pk >> 8) & 0xff); pd[16] = (unsigned char)((pk >> 16) & 0xff); pd[24] = (unsigned char)((unsigned)pk >> 24);
                        }
            }
        } else {
            const size_t base = oH + (size_t)((u.pn - 3) * 128 + wc * 32 + 8 * fq) * 2;
#pragma unroll
            for (int ai = 0; ai < 2; ++ai)
#pragma unroll
                for (int m = 0; m < 4; ++m) {
                    const int row = row0 + ai * HALF + m * 16;
                    f32x4 o[2];
#pragma unroll
                    for (int n = 0; n < 2; ++n) { const f32x4 a = acc[ai][0][m][n], b = acc[ai][1][m][n];
#pragma unroll
                        for (int e = 0; e < 4; ++e) o[n][e] = a[e] * __builtin_amdgcn_rcpf(1.0f + __builtin_amdgcn_exp2f(-1.4426950408889634f * b[e])); }
                    W.st16(base + (size_t)row * 1024, pack8(o[0], o[1]));
                }
        }
    }
};

struct EpiP3 {
    static constexpr bool PERM = true, AFTER_DRAIN = false;
    WsSt W; size_t oX; bf16_t* X1B; const float* rsi; const float* ig1; float* SS;
    __device__ __forceinline__ void operator()(const f32x4 (&acc)[2][2][4][2], const Unit& u, int wr, int wc, int fr, int fq) const {
        const int row0 = u.pm * BM + wr * 64 + fr, col0 = u.pn * BM + wc * 32 + 8 * fq;
        f32x4 ig[2][2];
#pragma unroll
        for (int bj = 0; bj < 2; ++bj)
#pragma unroll
            for (int n = 0; n < 2; ++n) ig[bj][n] = *(const f32x4*)(ig1 + col0 + bj * HALF + 4 * n);
#pragma unroll
        for (int ai = 0; ai < 2; ++ai) {
        u32x4 xw[2][4][2]; float ri[2][4];
#pragma unroll
            for (int m = 0; m < 4; ++m) { const int row = row0 + ai * HALF + m * 16; const size_t off = (size_t)row * 1024 + col0;
                ri[ai][m] = rsi[row];
#pragma unroll
                for (int bj = 0; bj < 2; ++bj) xw[ai][m][bj] = *(const u32x4*)(X1B + off + bj * HALF); }
            asm volatile("" ::: "memory");
#pragma unroll
            for (int m = 0; m < 4; ++m) {
                const int row = row0 + ai * HALF + m * 16; const size_t off = (size_t)row * 1024 + col0;
                float ss = 0.f;
#pragma unroll
                for (int bj = 0; bj < 2; ++bj) {
                    const u32x4 w_ = xw[ai][m][bj];
                    const f32x4 xa = (f32x4){__uint_as_float(w_.x << 16), __uint_as_float(w_.x & 0xffff0000u), __uint_as_float(w_.y << 16), __uint_as_float(w_.y & 0xffff0000u)};
                    const f32x4 xb = (f32x4){__uint_as_float(w_.z << 16), __uint_as_float(w_.z & 0xffff0000u), __uint_as_float(w_.w << 16), __uint_as_float(w_.w & 0xffff0000u)};
                    const f32x4 v0 = acc[ai][bj][m][0] + xa * ig[bj][0] * ri[ai][m], v1 = acc[ai][bj][m][1] + xb * ig[bj][1] * ri[ai][m];
                    W.st16(oX + (off + bj * HALF) * 2, pack8(v0, v1));
                    ss += (v0[0] * v0[0] + v0[1] * v0[1]) + (v0[2] * v0[2] + v0[3] * v0[3]) + (v1[0] * v1[0] + v1[1] * v1[1]) + (v1[2] * v1[2] + v1[3] * v1[3]);
                }
                ss += __shfl_xor(ss, 16); ss += __shfl_xor(ss, 32);
                if (fq == 0) SS[(size_t)row * 16 + u.pn * 4 + wc] = ss;
            }
        }
    }
};

struct EpiP4 {
    static constexpr bool PERM = true, AFTER_DRAIN = false;
    WsSt W; size_t oQP; const float* SS;
    __device__ __forceinline__ void operator()(const f32x4 (&acc)[2][2][4][2], const Unit& u, int wr, int wc, int fr, int fq) const {
        const int row0 = u.pm * BM + wr * 64 + fr, col0 = u.pn * BM + wc * 32 + 8 * fq;
        f32x4 sv[2][4];
#pragma unroll
        for (int ai = 0; ai < 2; ++ai)
#pragma unroll
            for (int m = 0; m < 4; ++m) sv[ai][m] = *(const f32x4*)(SS + (size_t)(row0 + ai * HALF + m * 16) * 16 + 4 * fq);
#pragma unroll
        for (int ai = 0; ai < 2; ++ai)
#pragma unroll
            for (int m = 0; m < 4; ++m) {
                const int row = row0 + ai * HALF + m * 16;
                float s = (sv[ai][m][0] + sv[ai][m][1]) + (sv[ai][m][2] + sv[ai][m][3]);
                s += __shfl_xor(s, 16); s += __shfl_xor(s, 32);
                const float rstd = __builtin_amdgcn_rsqf(s * (1.0f / 1024.0f) + 1e-6f);
#pragma unroll
                for (int bj = 0; bj < 2; ++bj)
                    W.st16(oQP + ((size_t)row * 2048 + col0 + bj * HALF) * 2, pack8(acc[ai][bj][m][0] * rstd, acc[ai][bj][m][1] * rstd));
            }
    }
};
template <class Epi, class Sched, bool ALIGN_EPI = false, bool SP2 = false>
__device__ __forceinline__ void gemm_phase(PG8_LAS unsigned char* lds, const Gemm g, const Sched& S, const Epi& E) {
    const int tid = threadIdx.x, wid = __builtin_amdgcn_readfirstlane(tid >> 6), lane = tid & 63, wr = wid >> 2, wc = wid & 3, fr = lane & 15, fq = lane >> 4;
    const int K = g.K, nt = K / BK;
    unsigned voffA[2], voffB[2];
#pragma unroll
    for (int i = 0; i < 2; ++i) { int R, C; stage_rc(tid * 16 + i * 8192, R, C); const int Rb = Epi::PERM ? ((R & ~31) + perm32(R & 31)) : R;
        voffA[i] = (unsigned)(R * K + C) * 2u; voffB[i] = (unsigned)(Rb * K + C) * 2u; }
    const size_t kstep = (size_t)(BK * 2);
    const size_t hstep = (size_t)HALF * K * 2;
    const size_t tstep = 2 * hstep;
    const unsigned ldsw = (unsigned)wid * 1024u;
    const int aoff = lds_byte(wr * 64 + fr, fq * 8), boff = lds_byte(wc * 32 + fr, fq * 8);
#define PG8_SA(b, h) (((b) * 2 + (h)) * HTB)
#define PG8_SB(b, h) ((4 + (b) * 2 + (h)) * HTB)
#define PG8_STAGE(bufoff, gbase, voff) do { _Pragma("unroll") for (int _i = 0; _i < 2; ++_i) \
        __builtin_amdgcn_global_load_lds((const unsigned*)((const char*)(gbase) + (voff)[_i]), (PG8_LAS unsigned*)(lds + (bufoff) + ldsw + _i * 8192), 16, 0, 0); } while (0)
#define PG8_LDA(dst, b, h) do { _Pragma("unroll") for (int m = 0; m < 4; ++m) _Pragma("unroll") for (int k = 0; k < 2; ++k) dst[m][k] = *(const PG8_LAS bf16x8*)(lds + PG8_SA(b, h) + aoff + m * 2048 + k * 1024); } while (0)
#define PG8_LDB(dst, b, h) do { _Pragma("unroll") for (int n = 0; n < 2; ++n) _Pragma("unroll") for (int k = 0; k < 2; ++k) dst[n][k] = *(const PG8_LAS bf16x8*)(lds + PG8_SB(b, h) + boff + n * 2048 + k * 1024); } while (0)
#define PG8_MMA(ai, bj, At, Bt) do { __builtin_amdgcn_s_setprio(1); _Pragma("unroll") for (int m = 0; m < 4; ++m) _Pragma("unroll") for (int n = 0; n < 2; ++n) _Pragma("unroll") for (int k = 0; k < 2; ++k) \
        acc[ai][bj][m][n] = __builtin_amdgcn_mfma_f32_16x16x32_bf16(Bt[n][k], At[m][k], acc[ai][bj][m][n], 0, 0, 0); __builtin_amdgcn_s_setprio(0); } while (0)
#define PG8_WAIT_V(n) asm volatile("s_waitcnt vmcnt(" #n ")" ::: "memory")
#define PG8_WAIT_L(n) asm volatile("s_waitcnt lgkmcnt(" #n ")" ::: "memory")
#define PG8_BAR __builtin_amdgcn_s_barrier()
#define PG8_SCHED __builtin_amdgcn_sched_barrier(0)
    Unit cur, nxt; int ui = 0;
    if (!S.next(0, cur)) return;
    f32x4 acc[2][2][4][2];
#pragma unroll
    for (int a = 0; a < 2; ++a)
#pragma unroll
        for (int b = 0; b < 2; ++b)
#pragma unroll
            for (int m = 0; m < 4; ++m)
#pragma unroll
                for (int n = 0; n < 2; ++n) acc[a][b][m][n] = (f32x4){0.f, 0.f, 0.f, 0.f};
    bf16x8 At[4][2], B0[2][2], B1[2][2];
    const char* cA = (const char*)g.A + (size_t)cur.pm * tstep; const char* cB = (const char*)g.Bt + (size_t)cur.pn * tstep;
    S.a_ready(cur);
    if constexpr (SP2) {
        PG8_STAGE(PG8_SB(0, 0), cB, voffB); PG8_STAGE(PG8_SB(0, 1), cB + hstep, voffB); PG8_STAGE(PG8_SA(0, 0), cA, voffA); PG8_STAGE(PG8_SA(0, 1), cA + hstep, voffA);
        if (wr == 1) PG8_BAR;
        PG8_WAIT_V(2); PG8_BAR;
        PG8_STAGE(PG8_SB(1, 0), cB + kstep, voffB); PG8_STAGE(PG8_SA(1, 0), cA + kstep, voffA); PG8_STAGE(PG8_SB(1, 1), cB + hstep + kstep, voffB);
        PG8_WAIT_V(6); PG8_BAR;
    } else {
        PG8_STAGE(PG8_SB(0, 0), cB, voffB); PG8_STAGE(PG8_SA(0, 0), cA, voffA); PG8_STAGE(PG8_SB(0, 1), cB + hstep, voffB); PG8_STAGE(PG8_SA(0, 1), cA + hstep, voffA);
        if (wr == 1) PG8_BAR;
        PG8_WAIT_V(4); PG8_BAR;
        PG8_STAGE(PG8_SB(1, 0), cB + kstep, voffB); PG8_STAGE(PG8_SA(1, 0), cA + kstep, voffA); PG8_STAGE(PG8_SB(1, 1), cB + hstep + kstep, voffB);
        PG8_WAIT_V(6); PG8_BAR;
    }
    for (;;) {
        const bool has_next = S.next(ui + 1, nxt);
        const char* nA = has_next ? (const char*)g.A + (size_t)nxt.pm * tstep : cA; const char* nB = has_next ? (const char*)g.Bt + (size_t)nxt.pn * tstep : cB;
        for (int t = 0; t < nt; t += 2) {
            const bool last = (t == nt - 2);
            const char* a1 = cA + (size_t)(t + 1) * kstep;
            const char* a2 = last ? nA : cA + (size_t)(t + 2) * kstep; const char* b2 = last ? nB : cB + (size_t)(t + 2) * kstep;
            const char* a3 = a2 + kstep; const char* b3 = b2 + kstep;
            if (last && has_next) S.a_ready(nxt);
            if constexpr (SP2) {
            PG8_LDB(B0, 0, 0); PG8_LDB(B1, 0, 1); PG8_SCHED; PG8_LDA(At, 0, 0); PG8_STAGE(PG8_SA(1, 1), a1 + hstep, voffA);
            PG8_WAIT_V(8); PG8_WAIT_L(0); PG8_BAR; PG8_MMA(0, 0, At, B0); PG8_MMA(0, 1, At, B1); PG8_BAR; PG8_SCHED;
            PG8_LDA(At, 0, 1); PG8_STAGE(PG8_SB(0, 0), b2, voffB); PG8_STAGE(PG8_SB(0, 1), b2 + hstep, voffB); PG8_STAGE(PG8_SA(0, 0), a2, voffA);
            PG8_WAIT_V(8); PG8_WAIT_L(0); PG8_BAR; PG8_MMA(1, 0, At, B0); PG8_MMA(1, 1, At, B1); PG8_BAR; PG8_SCHED;
            PG8_LDB(B0, 1, 0); PG8_LDB(B1, 1, 1); PG8_SCHED; PG8_LDA(At, 1, 0); PG8_STAGE(PG8_SA(0, 1), a2 + hstep, voffA);
            PG8_WAIT_V(8); PG8_WAIT_L(0); PG8_BAR; PG8_MMA(0, 0, At, B0); PG8_MMA(0, 1, At, B1); PG8_BAR; PG8_SCHED;
            PG8_LDA(At, 1, 1); PG8_STAGE(PG8_SB(1, 0), b3, voffB); PG8_STAGE(PG8_SB(1, 1), b3 + hstep, voffB); PG8_STAGE(PG8_SA(1, 0), a3, voffA);
            PG8_WAIT_V(8); PG8_WAIT_L(0); PG8_BAR; PG8_MMA(1, 0, At, B0); PG8_MMA(1, 1, At, B1); PG8_BAR; PG8_SCHED;
            } else {
            PG8_LDB(B0, 0, 0); PG8_SCHED; PG8_LDA(At, 0, 0); PG8_STAGE(PG8_SA(1, 1), a1 + hstep, voffA);
            PG8_WAIT_L(8); PG8_BAR; PG8_WAIT_L(0); PG8_MMA(0, 0, At, B0); PG8_BAR; PG8_SCHED;
            PG8_LDB(B1, 0, 1); PG8_STAGE(PG8_SB(0, 0), b2, voffB);
            PG8_BAR; PG8_WAIT_L(0); PG8_MMA(0, 1, At, B1); PG8_BAR;
            PG8_LDA(At, 0, 1); PG8_STAGE(PG8_SA(0, 0), a2, voffA);
            PG8_BAR; PG8_WAIT_L(0); PG8_MMA(1, 0, At, B0); PG8_BAR; PG8_SCHED;
            PG8_STAGE(PG8_SB(0, 1), b2 + hstep, voffB);
            PG8_WAIT_V(6); PG8_BAR; PG8_MMA(1, 1, At, B1); PG8_BAR;
            PG8_LDB(B0, 1, 0); PG8_SCHED; PG8_LDA(At, 1, 0); PG8_STAGE(PG8_SA(0, 1), a2 + hstep, voffA);
            PG8_WAIT_L(8); PG8_BAR; PG8_WAIT_L(0); PG8_MMA(0, 0, At, B0); PG8_BAR; PG8_SCHED;
            PG8_LDB(B1, 1, 1); PG8_STAGE(PG8_SB(1, 0), b3, voffB);
            PG8_BAR; PG8_WAIT_L(0); PG8_MMA(0, 1, At, B1); PG8_BAR;
            PG8_LDA(At, 1, 1); PG8_STAGE(PG8_SA(1, 0), a3, voffA);
            PG8_BAR; PG8_WAIT_L(0); PG8_MMA(1, 0, At, B0); PG8_BAR; PG8_SCHED;
            PG8_STAGE(PG8_SB(1, 1), b3 + hstep, voffB);
            PG8_WAIT_V(6); PG8_BAR; PG8_MMA(1, 1, At, B1); PG8_BAR;
            }
        }
        if constexpr (ALIGN_EPI) { if (wr == 0) PG8_BAR; }
        if constexpr (!Epi::AFTER_DRAIN) { E(acc, cur, wr, wc, fr, fq); S.done(cur); }
        if (!has_next) break;
#pragma unroll
        for (int a = 0; a < 2; ++a)
#pragma unroll
            for (int b = 0; b < 2; ++b)
#pragma unroll
                for (int m = 0; m < 4; ++m)
#pragma unroll
                    for (int n = 0; n < 2; ++n) acc[a][b][m][n] = (f32x4){0.f, 0.f, 0.f, 0.f};
        cur = nxt; cA = nA; cB = nB; ++ui;
        if constexpr (ALIGN_EPI) { if (wr == 1) PG8_BAR; }
    }
    PG8_WAIT_V(0);
    if constexpr (!ALIGN_EPI) { if (wr == 0) PG8_BAR; }
    PG8_BAR;
    if constexpr (Epi::AFTER_DRAIN) { E.fused(acc, cur, wr, wc, fr, fq, lds, wid, lane); S.done(cur); }
#undef PG8_SA
#undef PG8_SB
#undef PG8_STAGE
#undef PG8_LDA
#undef PG8_LDB
#undef PG8_MMA
#undef PG8_WAIT_V
#undef PG8_WAIT_L
#undef PG8_BAR
#undef PG8_SCHED
}
}
#ifndef PG8_SP2
#define PG8_SP2 true
#endif
#ifndef PG8_ALIGN
#define PG8_ALIGN true
#endif
#include <hip/hip_bf16.h>
#include <cmath>
namespace attn_body {
using bf16=__hip_bfloat16;
using bf16x8=__attribute__((ext_vector_type(8)))short;
using s16x4=__attribute__((ext_vector_type(4)))short;
using f32x16=__attribute__((ext_vector_type(16)))float;
using u32x4=__attribute__((ext_vector_type(4)))unsigned;
constexpr int BATCH=4,NHEAD=8,SEQ=8192,D=64,QPITCH=512,KVPITCH=128,OPITCH=1024;
constexpr int NW=8,QBLK=32,QB=QBLK*NW,KVBLK=64,NQB=SEQ/QB;
constexpr int ATTN_UNIT_ROWS=QB;
__device__ __forceinline__ int crow(int r,int hi){return (r&3)+8*(r>>2)+4*hi;}
#define SBAR() __builtin_amdgcn_sched_barrier(0)
__device__ __forceinline__ void cmask(f32x16&p0,f32x16&p1,int jb,int qrel,int hi){
  const float NEG=-INFINITY; int kb=64*jb+4*hi;
  #pragma unroll
  for(int r=0;r<16;++r){int kv=kb+(r&3)+8*(r>>2); if(kv>qrel)p0[r]=NEG; if(kv+32>qrel)p1[r]=NEG;}
}

constexpr int NSLOT=3, SLOTB=8192;
constexpr int LDS_K=0, LDS_V=NSLOT*SLOTB, LDS_WS=2*NSLOT*SLOTB, LDS_OST=LDS_WS+NW*64*4, LDS_BYTES=LDS_OST+NW*4096;
constexpr float C2=0.125f*1.4426950408889634f;
__device__ __forceinline__ void glds16(const void*gsrc,unsigned lds_dst){unsigned keep;
  asm volatile("s_mov_b32 %0, m0\n\ts_mov_b32 m0, %2\n\ts_nop 0\n\tglobal_load_lds_dwordx4 %1, off\n\ts_mov_b32 m0, %0":"=&s"(keep):"v"(gsrc),"s"(lds_dst):"memory");}
__device__ __forceinline__ float max3f(float a,float b,float c){float r;asm("v_max3_f32 %0, %1, %2, %3":"=v"(r):"v"(a),"v"(b),"v"(c));return r;}
__device__ __forceinline__ float max2f(float a,float b){float r;asm("v_max_f32_e32 %0, %1, %2":"=v"(r):"v"(a),"v"(b));return r;}
__device__ __forceinline__ float fadd_s(float a,float b){float r;asm("v_add_f32_e32 %0, %1, %2":"=v"(r):"v"(a),"v"(b));return r;}
__device__ __forceinline__ float fsub_s(float a,float b){float r;asm("v_sub_f32_e32 %0, %1, %2":"=v"(r):"v"(a),"v"(b));return r;}
typedef float f32x2_t __attribute__((ext_vector_type(2))); typedef __bf16 bf16x2_t __attribute__((ext_vector_type(2)));
__device__ __forceinline__ unsigned cvtpk_s(float lo,float hi){f32x2_t v={lo,hi};bf16x2_t b=__builtin_convertvector(v,bf16x2_t);return __builtin_bit_cast(unsigned,b);}
#define WAIT_BAR(N) asm volatile("s_waitcnt lgkmcnt(0)\n\ts_barrier":::"memory")
#define WAIT_BARC(N,NV) do{ if(kwave){WAIT_BAR(N);}else{WAIT_BAR(NV);} }while(0)

typedef int v8i_t __attribute__((ext_vector_type(8))); typedef int v4i_t __attribute__((ext_vector_type(4)));
__device__ __forceinline__ v8i_t cat8(const v4i_t a,const v4i_t b){return (v8i_t){a.x,a.y,a.z,a.w,b.x,b.y,b.z,b.w};}
__device__ __forceinline__ f32x16 qk8(const v8i_t kf,const v8i_t qf,const f32x16 c){return __builtin_amdgcn_mfma_scale_f32_32x32x64_f8f6f4(kf,qf,c,0,0,0,0,0,0);}
__device__ __forceinline__ void qkt(f32x16&p0,f32x16&p1,const char*Kslot,const v8i_t qr,const f32x16&negm,int r32,int hi){
  const char*kb=Kslot+hi*2048+r32*16;
  const v4i_t a0=*reinterpret_cast<const v4i_t*>(kb),a1=*reinterpret_cast<const v4i_t*>(kb+1024),b0=*reinterpret_cast<const v4i_t*>(kb+512),b1=*reinterpret_cast<const v4i_t*>(kb+1536);
  p0=qk8(cat8(a0,a1),qr,negm);p1=qk8(cat8(b0,b1),qr,negm);
}
typedef __attribute__((address_space(3))) const char* lds_cptr;
typedef short v4i16_t __attribute__((ext_vector_type(4)));
typedef __attribute__((address_space(3))) const v4i_t* lds_v4p;
__device__ __forceinline__ void kload2(v8i_t*kf,lds_cptr kp,int j){ kf[j]=cat8(*(lds_v4p)(kp+j*512),*(lds_v4p)(kp+j*512+1024)); }
__device__ __forceinline__ void kload8(v8i_t*kf,lds_cptr kp){ kload2(kf,kp,0); kload2(kf,kp,1); }
__device__ __forceinline__ s16x4 vtr(lds_cptr p){ return __builtin_bit_cast(s16x4,__builtin_amdgcn_ds_read_tr16_b64_v4i16((__attribute__((address_space(3))) v4i16_t*)p)); }
__device__ __forceinline__ float rowmax(const f32x16&p0,const f32x16&p1){
  float a=max3f(p0[0],p0[1],p1[0]),b=max3f(p0[2],p0[3],p1[1]);a=max3f(a,p1[2],p1[3]);
  #pragma unroll
  for(int r=4;r<16;r+=4){a=max3f(a,p0[r],p0[r+1]);b=max3f(b,p0[r+2],p0[r+3]);a=max3f(a,p1[r],p1[r+1]);b=max3f(b,p1[r+2],p1[r+3]);}
  const float m=max2f(a,b);
  auto rr=__builtin_amdgcn_permlane32_swap(__float_as_uint(m),__float_as_uint(m),false,false);
  return max2f(__uint_as_float(rr[0]),__uint_as_float(rr[1]));
}
__device__ __forceinline__ f32x16 pv8(const v8i_t pa,const v8i_t vb,const f32x16 c){return __builtin_amdgcn_mfma_scale_f32_32x32x64_f8f6f4(pa,vb,c,1,0,0,0,0,0);}
#define PKASM(w,a,b,c,d) do{ int t_; asm volatile("v_cvt_pkrtz_f16_f32 %0, %2, %3\n\tv_cvt_pkrtz_f16_f32 %1, %4, %5\n\tv_perm_b32 %0, %1, %0, %6":"=&v"(w),"=&v"(t_):"v"(a),"v"(b),"v"(c),"v"(d),"s"(0x07050301)); }while(0)
#define PKASML(w,a,b,c,d) do{ int t_; asm volatile("v_cvt_pkrtz_f16_f32 %0, %2, %3\n\tv_cvt_pkrtz_f16_f32 %1, %4, %5\n\tv_perm_b32 %0, %1, %0, %6\n\ts_nop 1":"=&v"(w),"=&v"(t_):"v"(a),"v"(b),"v"(c),"v"(d),"s"(0x07050301)); }while(0)
__device__ __forceinline__ int pk8(float a,float b,float c,float d){int w=0;w=__builtin_amdgcn_cvt_pk_bf8_f32(a,b,w,false);w=__builtin_amdgcn_cvt_pk_bf8_f32(c,d,w,true);return w;}
__device__ __forceinline__ void pv(f32x16*o,lds_cptr vp,const v8i_t pw){
  const v8i_t v0=cat8(*(lds_v4p)(vp),*(lds_v4p)(vp+1024)),v1=cat8(*(lds_v4p)(vp+512),*(lds_v4p)(vp+1536));
  o[0]=pv8(pw,v0,o[0]);o[1]=pv8(pw,v1,o[1]);
}
#ifndef ATTN_STORE16
#define ATTN_STORE16(p,v) (*(u32x4*)(p)=(v))
#endif
template<int THRL> __device__ __forceinline__ void attn_unit(int b,int h,int qb,const bf16*Q,const bf16*__restrict__ K,const bf16*__restrict__ V,bf16*O,char*shm){
  const int tid=threadIdx.x,lane=tid&63,r32=lane&31,hi=lane>>5; const int wid=__builtin_amdgcn_readfirstlane(tid>>6);
  const long rowbase=(long)b*SEQ; const int q0=qb*QB;
  const unsigned lds0=(unsigned)(uintptr_t)shm;
  float*wsf=(float*)(shm+LDS_WS)+wid*64;
  const bool kwave=wid<4;
  const unsigned char*ksrc=(const unsigned char*)K+(rowbase*128+(h>>2)*64)+(long)lane*128+(wid&3)*16;
  const unsigned char*vsrc=(const unsigned char*)V+((size_t)((b*2+(h>>2))*(SEQ/KVBLK))*4096)+(long)lane*64+(wid&3)*16;
  const unsigned char*ssrc=kwave?ksrc:vsrc; const long sstep=kwave?(long)KVBLK*128:4096L;
  typedef __attribute__((address_space(3))) u32x4* lds_w4p; const lds_w4p sdst=(lds_w4p)((__attribute__((address_space(3))) char*)shm+(kwave?LDS_K:LDS_V)+(wid&3)*1024+lane*16);
  #define LDT(t) (*reinterpret_cast<const u32x4*>(ssrc+(long)(t)*sstep))
  #define WRT(slot,reg) (*(lds_w4p)((__attribute__((address_space(3))) char*)sdst+(slot))=(reg))
  const char*Kbase=shm+LDS_K; v8i_t kf[2];
  const lds_cptr shm3=(lds_cptr)shm; const lds_cptr kp0=shm3+LDS_K+hi*2048+r32*16; const lds_cptr vp0=shm3+LDS_V+hi*2048+r32*16;
  const int NT=SEQ/KVBLK;
  u32x4 st0=LDT(0),st1=LDT(1),st2=LDT(kwave?2:1),st3=LDT(kwave?3:1),stn;
  v8i_t qr;{const unsigned char*q8=(const unsigned char*)Q+((rowbase+q0+wid*QBLK+r32)*512+h*64+hi*32);qr=cat8(*reinterpret_cast<const v4i_t*>(q8),*reinterpret_cast<const v4i_t*>(q8+16));}
  float mhat=0.f,l_reg=0.f;f32x16 o[2];o[0]=f32x16{};o[1]=f32x16{};f32x16 negm=f32x16{};asm volatile("":"+v"(negm));
  const int qrel=wid*QBLK+r32;
  #define CMASK(P0,P1,t) do{}while(0)
  bool resc=false;
  #define START(P0,P1) do{ const float rm=rowmax(P0,P1); resc=false; \
    { const float dl=rm; mhat=fadd_s(mhat,dl); \
      _Pragma("unroll") for(int r=0;r<16;++r){P0[r]=fsub_s(P0[r],dl);P1[r]=fsub_s(P1[r],dl);} \
      _Pragma("unroll") for(int r=0;r<16;++r)negm[r]=-mhat; asm volatile("":"+v"(negm)); } \
    _Pragma("unroll") for(int r=0;r<16;++r)P0[r]=__builtin_amdgcn_exp2f(P0[r]); }while(0)
  #define RESC() do{ if(resc){ asm volatile("s_waitcnt lgkmcnt(0)":::"memory"); \
      _Pragma("unroll") for(int d_=0;d_<2;++d_) _Pragma("unroll") for(int r=0;r<16;++r)o[d_][r]*=wsf[crow(r,hi)]; } }while(0)
  f32x16 pA0,pA1,pB0,pB1;
  int sl_prev=0,sl_cur=0,sl_next=SLOTB;
  #define ROT() do{sl_prev=sl_cur;sl_cur=sl_next;sl_next=(sl_next==(NSLOT-1)*SLOTB)?0:sl_next+SLOTB;}while(0)
  WRT(0,st0); if(kwave){WRT(SLOTB,st1);WRT(2*SLOTB,st2);}
  WAIT_BARC(3,0);
  qkt(pA0,pA1,Kbase,qr,negm,r32,hi);asm volatile("s_nop 15\n\ts_nop 7":"+v"(pA0),"+v"(pA1));CMASK(pA0,pA1,0);
  START(pA0,pA1);
  _Pragma("unroll") for(int r=0;r<16;++r)pA1[r]=__builtin_amdgcn_exp2f(pA1[r]);
  WAIT_BAR(0);
  if(kwave){WRT(0,st3);stn=LDT(4);}else{WRT(SLOTB,st1);stn=LDT(2);}
  ROT();
  kload8(kf,kp0+sl_cur);
  WAIT_BAR(1);
  v8i_t vf[2]; v8i_t pw8;
  #define PKW4(P,B) pk8(P[B],P[B+1],P[B+2],P[B+3])
  #define PIN(x) asm volatile("":"+v"(x))
  #define MX3(a,b,c) __builtin_fmaxf(__builtin_fmaxf((a),(b)),(c))
  #define GAPA(MF,A0,A1,A2,A3,W0,W1,PW) do{ MF; sacc+=A0; sacc+=A1; sacc+=A2; sacc+=A3; PIN(sacc); W0; W1; PIN(PW); SBAR(); }while(0)
  #define EX(v) __builtin_amdgcn_exp2f(v)
  #define GAPB(MF,X,B) do{ MF; X[B]=EX(X[B]); X[B+1]=EX(X[B+1]); X[B+2]=EX(X[B+2]); X[B+3]=EX(X[B+3]); PIN(X); SBAR(); }while(0)
  #define VRD8(j) do{ vf[j]=cat8(*(lds_v4p)(vp_+(j)*512),*(lds_v4p)(vp_+(j)*512+1024)); }while(0)
  #define KRD(G,j) do{ if(G){ kload2(kf,kp0+sl_next,j); SBAR(); } }while(0)
  #define STEP(C0,C1,P0,P1,t,GK,GV,GL) do{ SBAR(); \
    const lds_cptr vp_=vp0+sl_prev; \
    VRD8(0); SBAR(); float sacc=(P0[0]+P0[1]); \
    GAPA(C0=qk8(kf[0],qr,negm), P0[2],P0[3],P0[4],P0[5],     pw8[0]=PKW4(P0,0), (void)0, pw8); \
    VRD8(1); SBAR(); GAPA(C1=qk8(kf[1],qr,negm), P0[6],P0[7],P0[8],P0[9],     pw8[1]=PKW4(P0,4), (void)0, pw8); \
    GAPA((void)0,   P0[10],P0[11],P0[12],P0[13], pw8[2]=PKW4(P0,8), (void)0, pw8); \
    GAPA((void)0,   P0[14],P0[15],P1[0],P1[1],   pw8[3]=PKW4(P0,12), (void)0, pw8); \
    GAPA((void)0,   P1[2],P1[3],P1[4],P1[5],     pw8[4]=PKW4(P1,0), (void)0, pw8); \
    GAPA((void)0,   P1[6],P1[7],P1[8],P1[9],     pw8[5]=PKW4(P1,4), (void)0, pw8); \
    GAPA((void)0,   P1[10],P1[11],P1[12],P1[13], pw8[6]=PKW4(P1,8), (void)0, pw8); \
    GAPA((void)0,   P1[14],P1[15],0.f,0.f,       pw8[7]=PKW4(P1,12), (void)0, pw8); \
    l_reg+=sacc; \
    if(kwave){ if(GK){ WRT(sl_cur,stn); if((t)+4<NT) stn=LDT((t)+4); } } else { if(GV){ WRT(sl_next,stn); if((t)+2<NT) stn=LDT((t)+2); } } \
    CMASK(C0,C1,t); \
    { float a=MX3(C0[0],C0[1],C1[0]),b=MX3(C0[2],C0[3],C1[1]); a=MX3(a,C1[2],C1[3]); \
      _Pragma("unroll") for(int r=4;r<16;r+=4){a=MX3(a,C0[r],C0[r+1]);b=MX3(b,C0[r+2],C0[r+3]);a=MX3(a,C1[r],C1[r+1]);b=MX3(b,C1[r+2],C1[r+3]);} \
      float rm=__builtin_fmaxf(a,b); { auto rr=__builtin_amdgcn_permlane32_swap(__float_as_uint(rm),__float_as_uint(rm),false,false); rm=__builtin_fmaxf(__uint_as_float(rr[0]),__uint_as_float(rr[1])); } \
      resc=false; \
      if(__builtin_expect(__any(rm>(float)THRL),0)){ const float dl=__builtin_fmaxf(rm,0.f); mhat+=dl; \
        _Pragma("unroll") for(int r=0;r<16;++r){C0[r]-=dl;C1[r]-=dl;} \
        _Pragma("unroll") for(int r=0;r<16;++r)negm[r]=-mhat; asm volatile("":"+v"(negm)); \
        const float f=__builtin_amdgcn_exp2f(-dl); l_reg*=f; if(hi==0)wsf[r32]=f; resc=true; } } \
    SBAR(); \
    GAPB(o[0]=pv8(pw8,vf[0],o[0]), C0,0); \
    GAPB(o[1]=pv8(pw8,vf[1],o[1]), C0,4); \
    KRD(GL,0); GAPB((void)0, C0,8); \
    KRD(GL,1); GAPB((void)0, C0,12); \
    GAPB((void)0, C1,0); \
    GAPB((void)0, C1,4); \
    GAPB((void)0, C1,8); \
    GAPB((void)0, C1,12); \
    }while(0)
  int t=1;
  #undef CMASK
  #define CMASK(P0,P1,t) do{}while(0)
  for(;t+5<NT;t+=2){
    STEP(pB0,pB1,pA0,pA1,t,true,true,true);     WAIT_BAR(1); RESC(); ROT();
    STEP(pA0,pA1,pB0,pB1,t+1,true,true,true);   WAIT_BAR(1); RESC(); ROT();
  }
  #undef CMASK
  #define CMASK(P0,P1,t) do{}while(0)
  #define ENDW(tt) do{ if((tt)+3<NT){WAIT_BAR(1);} else if((tt)+2<NT){WAIT_BARC(0,1);} else {WAIT_BAR(0);} }while(0)
  for(;t+1<NT;t+=2){
    STEP(pB0,pB1,pA0,pA1,t,(t+3<NT),(t+1<NT),(t+1<NT));       ENDW(t);   RESC(); ROT();
    STEP(pA0,pA1,pB0,pB1,t+1,(t+4<NT),(t+2<NT),(t+2<NT));     ENDW(t+1); RESC(); ROT();
  }
  STEP(pB0,pB1,pA0,pA1,NT-1,false,false,false); RESC();
  { float sacc=pB0[0]+pB0[1]; _Pragma("unroll") for(int r=2;r<16;++r)sacc+=pB0[r]; _Pragma("unroll") for(int r=0;r<16;++r)sacc+=pB1[r]; l_reg+=sacc;
    pw8=(v8i_t){PKW4(pB0,0),PKW4(pB0,4),PKW4(pB0,8),PKW4(pB0,12),PKW4(pB1,0),PKW4(pB1,4),PKW4(pB1,8),PKW4(pB1,12)};
    SBAR(); pv(o,vp0+sl_cur,pw8); }
  #undef PKW4
  #undef PIN
  #undef MX3
  #undef GAPA
  #undef GAPB
  #undef EX
  #undef VRD8
  #undef KRD
  #undef STEP
  #undef ENDW
  {auto rr=__builtin_amdgcn_permlane32_swap(__float_as_uint(l_reg),__float_as_uint(l_reg),false,false);l_reg=__uint_as_float(rr[0])+__uint_as_float(rr[1]);}
  if(hi==0)wsf[32+r32]=l_reg;asm volatile("s_waitcnt lgkmcnt(0)":::"memory");
  float rli[16];
  #pragma unroll
  for(int r=0;r<16;++r)rli[r]=__builtin_amdgcn_rcpf(wsf[32+crow(r,hi)]);
  bf16*Ow=O+(rowbase+q0+wid*QBLK)*OPITCH+h*D;
  { bf16*stg=(bf16*)(shm+LDS_OST)+wid*2048;
    #pragma unroll
    for(int r=0;r<16;++r){const int orow=crow(r,hi);
      #pragma unroll
      for(int d0=0;d0<2;++d0)stg[orow*64+d0*32+r32]=__float2bfloat16(o[d0][r]*rli[r]);}
    asm volatile("s_waitcnt lgkmcnt(0)":::"memory");
    #pragma unroll
    for(int i=0;i<4;++i){const int row=i*8+(lane>>3),ch=lane&7; const u32x4 v=*(const u32x4*)(stg+row*64+ch*8); ATTN_STORE16(Ow+(long)row*OPITCH+ch*8,v);} }
  asm volatile("s_waitcnt lgkmcnt(0)\n\ts_barrier":::"memory");
  #undef LDT
  #undef WRT
  #undef CMASK
  #undef START
  #undef RESC
  #undef ROT
}
__device__ __forceinline__ void attn_unit_fast(int b,int h,int qb,const bf16*Q,const bf16*__restrict__ K,const bf16*__restrict__ V,bf16*O,char*shm){
  const int tid=threadIdx.x,lane=tid&63,r32=lane&31,hi=lane>>5; const int wid=__builtin_amdgcn_readfirstlane(tid>>6);
  const long rowbase=(long)b*SEQ; const int q0=qb*QB;
  const unsigned lds0=(unsigned)(uintptr_t)shm;
  float*wsf=(float*)(shm+LDS_WS)+wid*64;
  const bool kwave=wid<4;
  const unsigned char*sbase=kwave?(const unsigned char*)K+(rowbase*128+(h>>2)*64):(const unsigned char*)V+((size_t)((b*2+(h>>2))*(SEQ/KVBLK))*4096);
  const int svoff=kwave?lane*128+(wid&3)*16:lane*64+(wid&3)*16; const int sstep=kwave?KVBLK*128:4096;
  const __amdgpu_buffer_rsrc_t srs=__builtin_amdgcn_make_buffer_rsrc((void*)sbase,0,0x7fffffff,0x00020000);
  typedef __attribute__((address_space(3))) u32x4* lds_w4p; const lds_w4p sdst=(lds_w4p)((__attribute__((address_space(3))) char*)shm+(kwave?LDS_K:LDS_V)+(wid&3)*1024+lane*16);
  #define LDT(t) __builtin_bit_cast(u32x4,__builtin_amdgcn_raw_buffer_load_b128(srs,svoff,(t)*sstep,0))
  #define WRT(slot,reg) (*(lds_w4p)((__attribute__((address_space(3))) char*)sdst+(slot))=(reg))
  const char*Kbase=shm+LDS_K; v8i_t kf[2];
  const lds_cptr shm3=(lds_cptr)shm; const lds_cptr kp0=shm3+LDS_K+hi*2048+r32*16; const lds_cptr vp0=shm3+LDS_V+hi*2048+r32*16;
  const int NT=SEQ/KVBLK;
  u32x4 st0=LDT(0),st1=LDT(1),st2=LDT(kwave?2:1),st3=LDT(kwave?3:1),stn;
  v8i_t qr;{const unsigned char*q8=(const unsigned char*)Q+((rowbase+q0+wid*QBLK+r32)*512+h*64+hi*32);qr=cat8(*reinterpret_cast<const v4i_t*>(q8),*reinterpret_cast<const v4i_t*>(q8+16));}
  f32x16 o[2];o[0]=f32x16{};o[1]=f32x16{};f32x16 osum=f32x16{};const f32x16 negm=f32x16{};v8i_t ONES8=(v8i_t){0x38383838,0x38383838,0x38383838,0x38383838,0x38383838,0x38383838,0x38383838,0x38383838};asm volatile("":"+v"(ONES8));
  const int qrel=wid*QBLK+r32;
  #define CMASK(P0,P1,t) do{}while(0)
  #define START(P0,P1) do{ _Pragma("unroll") for(int r=0;r<16;++r)P0[r]=__builtin_amdgcn_exp2f(P0[r]); }while(0)
  #define RESC() do{}while(0)
  f32x16 pA0,pA1,pB0,pB1;
  int sl_prev=0,sl_cur=0,sl_next=SLOTB;
  #define ROT() do{sl_prev=sl_cur;sl_cur=sl_next;sl_next=(sl_next==(NSLOT-1)*SLOTB)?0:sl_next+SLOTB;}while(0)
  WRT(0,st0); if(kwave){WRT(SLOTB,st1);WRT(2*SLOTB,st2);}
  WAIT_BARC(3,0);
  qkt(pA0,pA1,Kbase,qr,negm,r32,hi);asm volatile("s_nop 15\n\ts_nop 7":"+v"(pA0),"+v"(pA1));CMASK(pA0,pA1,0);
  START(pA0,pA1);
  _Pragma("unroll") for(int r=0;r<16;++r)pA1[r]=__builtin_amdgcn_exp2f(pA1[r]);
  WAIT_BAR(0);
  if(kwave){WRT(0,st3);stn=LDT(4);}else{WRT(SLOTB,st1);stn=LDT(2);}
  ROT();
  kload8(kf,kp0+sl_cur);
  WAIT_BAR(1);
  v8i_t vf[2]; v8i_t pw8;
  #define PKW4(P,B) pk8(P[B],P[B+1],P[B+2],P[B+3])
  #define PIN(x) asm volatile("":"+v"(x))
  #define MX3(a,b,c) __builtin_fmaxf(__builtin_fmaxf((a),(b)),(c))
  #define GAPA(MF,A0,A1,A2,A3,W0,W1,PW) do{ MF; W0; W1; SBAR(); }while(0)
  #define EX(v) __builtin_amdgcn_exp2f(v)
  #define GAPB(MF,X,B) do{ MF; X[B]=EX(X[B]); X[B+1]=EX(X[B+1]); X[B+2]=EX(X[B+2]); X[B+3]=EX(X[B+3]); SBAR(); }while(0)
  #define VRD8(j) do{ vf[j]=cat8(*(lds_v4p)(vp_+(j)*512),*(lds_v4p)(vp_+(j)*512+1024)); }while(0)
  #define KRD(G,j,SN) do{ if(G){ kload2(kf,kp0+(SN),j); SBAR(); } }while(0)
  #define STEP_(C0,C1,P0,P1,t,GL,SLP,SLN,STG) do{ SBAR(); \
    const lds_cptr vp_=vp0+(SLP); \
    VRD8(0); SBAR(); \
    GAPA(C0=qk8(kf[0],qr,negm), P0[2],P0[3],P0[4],P0[5],     PKASM(pw8[0],P0[0],P0[0+1],P0[0+2],P0[0+3]), (void)0, pw8); \
    VRD8(1); SBAR(); GAPA(C1=qk8(kf[1],qr,negm), P0[6],P0[7],P0[8],P0[9],     PKASM(pw8[1],P0[4],P0[4+1],P0[4+2],P0[4+3]), (void)0, pw8); \
    GAPA((void)0,   P0[10],P0[11],P0[12],P0[13], PKASM(pw8[2],P0[8],P0[8+1],P0[8+2],P0[8+3]), (void)0, pw8); \
    GAPA((void)0,   P0[14],P0[15],P1[0],P1[1],   PKASM(pw8[3],P0[12],P0[12+1],P0[12+2],P0[12+3]), (void)0, pw8); \
    GAPA((void)0,   P1[2],P1[3],P1[4],P1[5],     PKASM(pw8[4],P1[0],P1[0+1],P1[0+2],P1[0+3]), (void)0, pw8); \
    GAPA((void)0,   P1[6],P1[7],P1[8],P1[9],     PKASM(pw8[5],P1[4],P1[4+1],P1[4+2],P1[4+3]), (void)0, pw8); \
    GAPA((void)0,   P1[10],P1[11],P1[12],P1[13], PKASM(pw8[6],P1[8],P1[8+1],P1[8+2],P1[8+3]), (void)0, pw8); \
    GAPA((void)0,   P1[14],P1[15],0.f,0.f,       PKASML(pw8[7],P1[12],P1[12+1],P1[12+2],P1[12+3]), (void)0, pw8); \
    STG; \
    CMASK(C0,C1,t); \
    SBAR(); \
    GAPB(o[0]=pv8(pw8,vf[0],o[0]), C0,0); \
    GAPB(o[1]=pv8(pw8,vf[1],o[1]), C0,4); \
    KRD(GL,0,SLN); GAPB(osum=pv8(pw8,ONES8,osum), C0,8); \
    KRD(GL,1,SLN); GAPB((void)0, C0,12); \
    GAPB((void)0, C1,0); \
    GAPB((void)0, C1,4); \
    GAPB((void)0, C1,8); \
    GAPB((void)0, C1,12); \
    }while(0)
  #define STEP(C0,C1,P0,P1,t,GK,GV,GL) STEP_(C0,C1,P0,P1,t,GL,sl_prev,sl_next, if(kwave){ if(GK){ WRT(sl_cur,stn); if((t)+4<NT) stn=LDT((t)+4); } } else { if(GV){ WRT(sl_next,stn); if((t)+2<NT) stn=LDT((t)+2); } })
  #define STEP6(C0,C1,P0,P1,t,SLP,SLN,WA) STEP_(C0,C1,P0,P1,t,true,SLP,SLN, { *(lds_w4p)(WA)=stn; stn=LDT((t)+kadd); })
  lds_w4p wa0=(lds_w4p)((__attribute__((address_space(3))) char*)sdst+(kwave?1:2)*SLOTB),wa1=(lds_w4p)((__attribute__((address_space(3))) char*)sdst+(kwave?2:0)*SLOTB),wa2=(lds_w4p)((__attribute__((address_space(3))) char*)sdst+(kwave?0:1)*SLOTB);
  asm volatile("":"+v"(wa0),"+v"(wa1),"+v"(wa2));
  const int kadd=kwave?4:2;
  int t=1;
  #undef CMASK
  #define CMASK(P0,P1,t) do{}while(0)
  for(;t+9<NT;t+=6){
    STEP6(pB0,pB1,pA0,pA1,t,  0,2*SLOTB,wa0);       WAIT_BAR(1);
    STEP6(pA0,pA1,pB0,pB1,t+1,SLOTB,0,wa1);         WAIT_BAR(1);
    STEP6(pB0,pB1,pA0,pA1,t+2,2*SLOTB,SLOTB,wa2);   WAIT_BAR(1);
    STEP6(pA0,pA1,pB0,pB1,t+3,0,2*SLOTB,wa0);       WAIT_BAR(1);
    STEP6(pB0,pB1,pA0,pA1,t+4,SLOTB,0,wa1);         WAIT_BAR(1);
    STEP6(pA0,pA1,pB0,pB1,t+5,2*SLOTB,SLOTB,wa2);   WAIT_BAR(1);
  }
  for(;t+5<NT;t+=2){
    STEP(pB0,pB1,pA0,pA1,t,true,true,true);     WAIT_BAR(1); RESC(); ROT();
    STEP(pA0,pA1,pB0,pB1,t+1,true,true,true);   WAIT_BAR(1); RESC(); ROT();
  }
  #undef CMASK
  #define CMASK(P0,P1,t) do{}while(0)
  #define ENDW(tt) do{ if((tt)+3<NT){WAIT_BAR(1);} else if((tt)+2<NT){WAIT_BARC(0,1);} else {WAIT_BAR(0);} }while(0)
  for(;t+1<NT;t+=2){
    STEP(pB0,pB1,pA0,pA1,t,(t+3<NT),(t+1<NT),(t+1<NT));       ENDW(t);   RESC(); ROT();
    STEP(pA0,pA1,pB0,pB1,t+1,(t+4<NT),(t+2<NT),(t+2<NT));     ENDW(t+1); RESC(); ROT();
  }
  STEP(pB0,pB1,pA0,pA1,NT-1,false,false,false); RESC();
  {
    pw8=(v8i_t){PKW4(pB0,0),PKW4(pB0,4),PKW4(pB0,8),PKW4(pB0,12),PKW4(pB1,0),PKW4(pB1,4),PKW4(pB1,8),PKW4(pB1,12)};
    SBAR(); pv(o,vp0+sl_cur,pw8); osum=pv8(pw8,ONES8,osum); }
  #undef PKW4
  #undef PIN
  #undef MX3
  #undef GAPA
  #undef GAPB
  #undef EX
  #undef VRD8
  #undef KRD
  #undef STEP
  #undef STEP_
  #undef STEP6
  #undef ENDW
  float rli[16];
  #pragma unroll
  for(int r=0;r<16;++r)rli[r]=__builtin_amdgcn_rcpf(osum[r]);
  bf16*Ow=O+(rowbase+q0+wid*QBLK)*OPITCH+h*D;
  { bf16*stg=(bf16*)(shm+LDS_OST)+wid*2048;
    #pragma unroll
    for(int r=0;r<16;++r){const int orow=crow(r,hi);
      #pragma unroll
      for(int d0=0;d0<2;++d0)stg[orow*64+d0*32+r32]=__float2bfloat16(o[d0][r]*rli[r]);}
    asm volatile("s_waitcnt lgkmcnt(0)":::"memory");
    #pragma unroll
    for(int i=0;i<4;++i){const int row=i*8+(lane>>3),ch=lane&7; const u32x4 v=*(const u32x4*)(stg+row*64+ch*8); ATTN_STORE16(Ow+(long)row*OPITCH+ch*8,v);} }
  asm volatile("s_waitcnt lgkmcnt(0)\n\ts_barrier":::"memory");
  #undef LDT
  #undef WRT
  #undef CMASK
  #undef START
  #undef RESC
  #undef ROT
}
constexpr int ATTN_LDS_BYTES=LDS_BYTES;
struct AttnTensors { const bf16* Q; const bf16* K; const bf16* V; bf16* O; };
struct AttnUnit { int bh; int qb; };
struct StaticOrder {
  int vcu;
  __device__ __forceinline__ explicit StaticOrder(int grid,int block):vcu((block%8)*(grid/8)+block/8){}
  __device__ __forceinline__ bool next(int i,AttnUnit&u)const{ if(i>=4)return false; const int s=vcu&7; u.bh=vcu>>3; u.qb=(i==0)?s:(i==1)?15-s:(i==2)?16+s:31-s; return true; }
  __device__ __forceinline__ void a_ready(const AttnUnit&)const{}
  __device__ __forceinline__ void done(const AttnUnit&)const{}
};
template<class Sched,int THRL=8> __device__ __forceinline__ void attn_phase(char*lds,const AttnTensors&T,const Sched&S,bool fast){
  AttnUnit u;
  if(fast){ for(int i=0;S.next(i,u);++i){ S.a_ready(u); attn_unit_fast(u.bh/NHEAD,u.bh%NHEAD,u.qb,T.Q,T.K,T.V,T.O,lds); S.done(u); } }
  else { for(int i=0;S.next(i,u);++i){ S.a_ready(u); attn_unit<THRL>(u.bh/NHEAD,u.bh%NHEAD,u.qb,T.Q,T.K,T.V,T.O,lds); S.done(u); } }
}
#undef SBAR
#undef WAIT_BAR
}

constexpr int NWAVES = 8;
#ifndef MK_N_LAUNCHES
#define MK_N_LAUNCHES 1
#endif
constexpr int N_LAUNCHES = MK_N_LAUNCHES;
constexpr int PER_PHASE = 7;

constexpr int BATCH = 4, T = 8192, D = 1024;
constexpr int M = BATCH * T;
constexpr int NIN = 1792;
constexpr int NPQ = 2048;
constexpr int NEXP = 16384;
constexpr float RMS_EPS = 1e-6f;

constexpr size_t MiB = 1u << 20;
constexpr size_t WS_CTL = 0, CTL_ZERO_BYTES = 64 * 1024;
constexpr size_t WS_WIN = 2 * MiB, WS_WOUT = 6 * MiB, WS_WQ = 8 * MiB;
constexpr size_t WS_KEYS = 12 * MiB, WS_SU = 12 * MiB + 512 * 1024, WS_ROPE = 13 * MiB, WS_IG1 = 13 * MiB + 64 * 1024, WS_RSI = 13 * MiB + 128 * 1024, WS_SS = 14 * MiB;
constexpr size_t WS_UT = 16 * MiB, WS_VT = 48 * MiB;
constexpr size_t WS_XN = 80 * MiB;
constexpr size_t WS_XQ = 144 * MiB;
constexpr size_t WS_V8T = 180 * MiB;
constexpr size_t WS_Q = 144 * MiB, WS_K = 176 * MiB, WS_H = 192 * MiB;
constexpr size_t WS_SUO = 192 * MiB;
constexpr size_t WS_MIX = 224 * MiB;
constexpr size_t WS_QP = 288 * MiB;
constexpr size_t WS_IDX = 416 * MiB, WS_GATE = 424 * MiB, WS_END = 440 * MiB;
constexpr int CW_TMO = 0, CW_CODE = 1;
constexpr int CW_BAR = 4096;
constexpr int RING_OFF = 0, RING_BYTES = 131072;
constexpr int LDSCTL_OFF = RING_BYTES, MISC_OFF = LDSCTL_OFF + 320;
constexpr int LDS_BYTES = 147456;
static_assert(MISC_OFF + 128 <= LDS_BYTES, "LDS map");
#define GAS __attribute__((address_space(1)))
#define LAS __attribute__((address_space(3)))
typedef unsigned short bf16;
typedef unsigned v4u __attribute__((ext_vector_type(4)));
typedef float f32x4 __attribute__((ext_vector_type(4)));
typedef short bf16x8 __attribute__((ext_vector_type(8)));
typedef GAS unsigned gu32;
typedef GAS unsigned long long gu64;
#define RLX_AGENT __ATOMIC_RELAXED, __HIP_MEMORY_SCOPE_AGENT
#define LDS_WAIT() asm volatile("s_waitcnt lgkmcnt(0)" ::: "memory")
#define VM_WAIT() asm volatile("s_waitcnt vmcnt(0)" ::: "memory")
__device__ __forceinline__ unsigned long long rt() { return __builtin_amdgcn_s_memrealtime(); }
__device__ __forceinline__ unsigned f2bf(float f) { unsigned u = __builtin_bit_cast(unsigned, f); return (u + 0x7fffu + ((u >> 16) & 1u)) >> 16; }
__device__ __forceinline__ unsigned pk2(float lo, float hi) { return f2bf(lo) | (f2bf(hi) << 16); }

#define XB_TMO      128
#define XB_XCNT(j)  (256  + 64 * (j))
#define XB_XSUB(j)  (1280 + 64 * (j))
#define XB_XGEN(j)  (2304 + 64 * (j))
#define XB_TOP      3328
#define XB_TOPGEN   3392
#define XCD_BAR_WORDS 3456
#define XB_SPIN_CAP (1u << 18)

__device__ __forceinline__ unsigned xb_ld(unsigned* p)              { return __hip_atomic_load(p, __ATOMIC_RELAXED, __HIP_MEMORY_SCOPE_AGENT); }
__device__ __forceinline__ unsigned xb_add(unsigned* p, unsigned v) { return __hip_atomic_fetch_add(p, v, __ATOMIC_RELAXED, __HIP_MEMORY_SCOPE_AGENT); }
__device__ __forceinline__ unsigned xb_xcc_id() { return (unsigned)__builtin_amdgcn_s_getreg((3 << 11) | 20) & 0xFu; }
#define XB_SPIN(cond, bar) do { unsigned _sp = 0; while (cond) { __builtin_amdgcn_s_sleep(1); \
    if ((++_sp & 255u) == 0u) { if (xb_ld(&(bar)[XB_TMO])) break; if (_sp > XB_SPIN_CAP) { atomicAdd(&(bar)[XB_TMO], 1u); break; } } } } while (0)

#ifndef BAR_EARLY_WB
#define BAR_EARLY_WB 0
#endif
struct XcdBarrier {
    unsigned* bar; unsigned x;
    volatile LAS unsigned* st;
};

__device__ __forceinline__ XcdBarrier xcd_barrier_post(unsigned* bar, volatile LAS unsigned* st) {
    XcdBarrier b; b.bar = bar; b.x = xb_xcc_id(); b.st = st;
    if (threadIdx.x == 0) (void)xb_add(&bar[XB_XCNT(b.x)], 1u);
    return b;
}
__device__ __forceinline__ void xcd_barrier_complete(unsigned* bar, unsigned x, unsigned& nloc, unsigned& nx) {
    const unsigned G = gridDim.x * gridDim.y * gridDim.z;
    unsigned sum, cnt, mine, sp = 0u;
    for (;;) {
        sum = 0u; cnt = 0u; mine = 0u;
#pragma unroll
        for (unsigned j = 0; j < 16; ++j) { const unsigned c = xb_ld(&bar[XB_XCNT(j)]); sum += c; cnt += (c > 0u) ? 1u : 0u; mine = (j == x) ? c : mine; }
        if (sum == G) break;
        __builtin_amdgcn_s_sleep(1);
        if ((++sp & 255u) == 0u) { if (xb_ld(&bar[XB_TMO])) break; if (sp > XB_SPIN_CAP) { atomicAdd(&bar[XB_TMO], 1u); break; } }
    }
    nloc = mine > 0u ? mine : 1u; nx = cnt > 0u ? cnt : 1u;
}

__device__ __forceinline__ void xcd_barrier(const XcdBarrier& b) {
    asm volatile("s_waitcnt vmcnt(0)" ::: "memory");
    __syncthreads();
    if (threadIdx.x == 0) {
        unsigned* bar = b.bar;
        __builtin_amdgcn_s_waitcnt(0);
        unsigned nloc = b.st[0], nx = b.st[1];
        if (nloc == 0u) { xcd_barrier_complete(bar, b.x, nloc, nx); b.st[0] = nloc; b.st[1] = nx; }
#if BAR_EARLY_WB
        __builtin_amdgcn_fence(__ATOMIC_RELEASE, "agent");
        asm volatile("s_waitcnt vmcnt(0)" ::: "memory");
#endif
        const unsigned old = xb_add(&bar[XB_XSUB(b.x)], 1u);
        const unsigned gen = old / nloc;
        if (old + 1u == (gen + 1u) * nloc) {
            __builtin_amdgcn_fence(__ATOMIC_RELEASE, "agent");
            asm volatile("s_waitcnt vmcnt(0)" ::: "memory");
            const unsigned og = xb_add(&bar[XB_TOP], 1u);
            const unsigned tg = og / nx;
            if (og + 1u == (tg + 1u) * nx) xb_add(&bar[XB_TOPGEN], 1u);
            else XB_SPIN(xb_ld(&bar[XB_TOPGEN]) == tg, bar);
            __builtin_amdgcn_fence(__ATOMIC_ACQUIRE, "agent");
            xb_add(&bar[XB_XGEN(b.x)], 1u);
            asm volatile("s_waitcnt vmcnt(0)" ::: "memory");
        } else {
            XB_SPIN(xb_ld(&bar[XB_XGEN(b.x)]) == gen, bar);
            __builtin_amdgcn_fence(__ATOMIC_ACQUIRE, "agent");
            asm volatile("s_waitcnt vmcnt(0)" ::: "memory");
        }
    }
    __syncthreads();
}

struct Frame {
    LAS unsigned char* lds;
    volatile LAS unsigned* MISC;
    gu32* ctl;
    int tid, lane, wave;
    int vcu, G;
    const float* in[16]; float* out; unsigned char* ws;
};

typedef __bf16 bf16x2_dg __attribute__((ext_vector_type(2)));
__device__ __forceinline__ float dot2bf_(unsigned a, unsigned b, float c) { return __builtin_amdgcn_fdot2_f32_bf16(__builtin_bit_cast(bf16x2_dg, a), __builtin_bit_cast(bf16x2_dg, b), c, false); }
__device__ __forceinline__ float wave_sum(float v) {
#pragma unroll
    for (int o = 1; o < 64; o <<= 1) v += __shfl_xor(v, o);
    return v;
}
__device__ __forceinline__ int win_src_col(int rho) {
    const int pn = rho >> 8, bj = (rho >> 7) & 1, wc = (rho >> 5) & 3, fq = (rho >> 3) & 3, n = (rho >> 2) & 1, e = rho & 3;
    if (pn < 2) return 64 * (4 * pn + wc) + 32 * bj + 16 * n + 4 * fq + e;
    if (pn == 2) { if (wc < 2) return 512 + 64 * wc + 32 * bj + 16 * n + 4 * fq + e; return 640 + 64 * (wc - 2) + 32 * bj + 8 * fq + 4 * n + e; }
    const int c = 128 * (pn - 3) + 32 * wc + 8 * fq + 4 * n + e;
    return (bj ? 1280 : 768) + c;
}
template <bool PERMW>
__device__ __forceinline__ void p0_transpose_item(const float* W, int K, int N, const float* ks, bf16* WT, LAS float* scr, int item, int lane) {
    const int nblk = N / 32, kb = item / nblk, nb = item % nblk, k0 = 64 * kb, n0 = 32 * nb;
    const int sc = PERMW ? win_src_col(n0 + (lane & 31)) : (n0 + (lane & 31));
#pragma unroll 8
    for (int i = 0; i < 32; ++i) { const int kk = 2 * i + (lane >> 5); float v = W[(size_t)(k0 + kk) * N + sc]; if (ks) v *= ks[k0 + kk]; scr[kk * 33 + (lane & 31)] = v; }
    LDS_WAIT(); asm volatile("" ::: "memory");
    const int c = lane & 7;
#pragma unroll
    for (int j = 0; j < 4; ++j) { const int n = (lane >> 3) + 8 * j; const LAS float* s = scr + (8 * c) * 33 + n;
        v4u o; o.x = pk2(s[0 * 33], s[1 * 33]); o.y = pk2(s[2 * 33], s[3 * 33]); o.z = pk2(s[4 * 33], s[5 * 33]); o.w = pk2(s[6 * 33], s[7 * 33]);
        *(GAS v4u*)(WT + (size_t)(n0 + n) * K + k0 + 8 * c) = o; }
    LDS_WAIT(); asm volatile("" ::: "memory");
}
template <int NR>
__device__ __forceinline__ void rms_rows_to_bf16(int lane, const float* x, const float* g, bf16* o, float* rsi, int row0, int rstride) {
    f32x4 v[NR][4];
#pragma unroll
    for (int r = 0; r < NR; ++r) { const GAS f32x4* xr = (const GAS f32x4*)(x + (size_t)(row0 + r * rstride) * D) + lane;
#pragma unroll
        for (int j = 0; j < 4; ++j) v[r][j] = xr[64 * j]; }
    f32x4 gg[4];
#pragma unroll
    for (int j = 0; j < 4; ++j) gg[j] = ((const GAS f32x4*)g + lane)[64 * j];
#pragma unroll
    for (int r = 0; r < NR; ++r) { float s = 0.f;
#pragma unroll
        for (int j = 0; j < 4; ++j) s += (v[r][j].x * v[r][j].x + v[r][j].y * v[r][j].y) + (v[r][j].z * v[r][j].z + v[r][j].w * v[r][j].w);
        const float rms = sqrtf(wave_sum(s) * (1.f / D) + RMS_EPS), rstd = 1.f / rms;
        if (lane == 0) rsi[row0 + r * rstride] = rms;
        GAS unsigned long long* o8 = (GAS unsigned long long*)(o + (size_t)(row0 + r * rstride) * D) + lane;
#pragma unroll
        for (int j = 0; j < 4; ++j) o8[64 * j] = (unsigned long long)pk2(v[r][j].x * rstd * gg[j].x, v[r][j].y * rstd * gg[j].y) | ((unsigned long long)pk2(v[r][j].z * rstd * gg[j].z, v[r][j].w * rstd * gg[j].w) << 32); }
}
__device__ __forceinline__ unsigned pack_i8x4(const f32x4 v) {
    unsigned w = 0u;
    w = __builtin_amdgcn_cvt_pk_u8_f32(__builtin_rintf(v.x) + 128.0f, 0u, w); w = __builtin_amdgcn_cvt_pk_u8_f32(__builtin_rintf(v.y) + 128.0f, 1u, w);
    w = __builtin_amdgcn_cvt_pk_u8_f32(__builtin_rintf(v.z) + 128.0f, 2u, w); w = __builtin_amdgcn_cvt_pk_u8_f32(__builtin_rintf(v.w) + 128.0f, 3u, w);
    return w ^ 0x80808080u;
}
__device__ __forceinline__ void expert_rows_load(f32x4 (&a)[2][4], const float* pu, const float* pv, int e, int lane) {
#pragma unroll
    for (int r = 0; r < 2; ++r) { const GAS f32x4* src = (const GAS f32x4*)(((r & 1) ? pv : pu) + (size_t)e * D + 16 * lane);
#pragma unroll
        for (int q = 0; q < 4; ++q) a[r][q] = src[q]; }
}
__device__ __forceinline__ void expert_rows_finish(f32x4 (&a)[2][4], const float* norm2_g, unsigned char* ut, unsigned char* vt, float* suv, int e, int lane) {
    const GAS f32x4* sg = (const GAS f32x4*)(norm2_g + 16 * lane); f32x4 gq[4];
#pragma unroll
    for (int q = 0; q < 4; ++q) gq[q] = sg[q];
#pragma unroll
    for (int r = 0; r < 2; ++r) { const bool isv = (r & 1) != 0; float amax = 0.f;
#pragma unroll
        for (int q = 0; q < 4; ++q) { if (!isv) a[r][q] = a[r][q] * gq[q];
            amax = fmaxf(amax, fmaxf(fmaxf(fabsf(a[r][q].x), fabsf(a[r][q].y)), fmaxf(fabsf(a[r][q].z), fabsf(a[r][q].w)))); }
#pragma unroll
        for (int o = 1; o < 64; o <<= 1) amax = fmaxf(amax, __shfl_xor(amax, o));
        const float scale = amax > 0.f ? amax * (1.0f / 127.0f) : 1.0f, inv = amax > 0.f ? 127.0f / amax : 0.f;
        v4u o4;
#pragma unroll
        for (int q = 0; q < 4; ++q) o4[q] = pack_i8x4(a[r][q] * inv);
        const int sl = lane >> 3, mm = lane & 7;
        if (!isv) *(GAS v4u*)(ut + ((size_t)sl * NEXP + e) * 128 + (size_t)mm * 16) = o4;
        else {
            typedef unsigned v2u_t __attribute__((ext_vector_type(2)));
            const v2u_t ev = (v2u_t){__builtin_amdgcn_perm(o4[1], o4[0], 0x06040200u), __builtin_amdgcn_perm(o4[3], o4[2], 0x06040200u)}, od = (v2u_t){__builtin_amdgcn_perm(o4[1], o4[0], 0x07050301u), __builtin_amdgcn_perm(o4[3], o4[2], 0x07050301u)};
            unsigned char* row = vt + ((size_t)sl * NEXP + e) * 128 + (size_t)(mm >> 1) * 32 + (size_t)(mm & 1) * 8;
            *(GAS v2u_t*)row = ev; *(GAS v2u_t*)(row + 16) = od; }
        if (lane == 0) suv[2 * e + (isv ? 1 : 0)] = scale; }
}
__device__ __forceinline__ void p0_prologue(Frame& F) {
    LAS float* scr = (LAS float*)(F.lds + RING_OFF + F.wave * 16384);
    const int gw = F.vcu * NWAVES + F.wave, NGW = F.G * NWAVES;
    const float* w_in = F.in[2]; const float* w_out = F.in[9]; const float* peer_wq = F.in[11]; const float* norm2_g = F.in[10];
    constexpr int I_IN = (D / 64) * (NIN / 32), I_OUT = (D / 64) * (D / 32), I_WQ = (D / 64) * (NPQ / 32);
    constexpr int NITEMS = I_IN + I_OUT + I_WQ;
    for (int it = gw; it < NITEMS; it += NGW) {
        int r = it;
        if (r < I_IN) { p0_transpose_item<true>(w_in, D, NIN, nullptr, (bf16*)(F.ws + WS_WIN), scr, r, F.lane); continue; } r -= I_IN;
        if (r < I_OUT) { p0_transpose_item<false>(w_out, D, D, nullptr, (bf16*)(F.ws + WS_WOUT), scr, r, F.lane); continue; } r -= I_OUT;
        p0_transpose_item<false>(peer_wq, D, NPQ, norm2_g, (bf16*)(F.ws + WS_WQ), scr, r, F.lane);
    }
    const int gt = F.vcu * (NWAVES * 64) + F.tid, NGT = F.G * NWAVES * 64;
    { float* ig = (float*)(F.ws + WS_IG1); for (int i = gt; i < D; i += NGT) ig[i] = 1.0f / F.in[1][i]; }
    { const float* pk = F.in[12]; bf16* kb = (bf16*)(F.ws + WS_KEYS);
      for (int i = gt; i < 2 * 128 * 128 / 2; i += NGT) { const float a = pk[2 * i], b = pk[2 * i + 1]; ((GAS unsigned*)kb)[i] = pk2(a, b); } }
    { float* rt_ = (float*)(F.ws + WS_ROPE);
      for (int i = gt; i < 128 * 16; i += NGT) { const int pos = i >> 4, k = i & 15; const float inv = powf(10000.0f, -(float)k / 16.0f); const float ang = (float)pos * inv; float s, c; sincosf(ang, &s, &c); rt_[2 * i] = c; rt_[2 * i + 1] = s; } }
    for (int m = gw; m < M; m += 4 * NGW) rms_rows_to_bf16<4>(F.lane, F.in[0], F.in[1], (bf16*)(F.ws + WS_XN), (float*)(F.ws + WS_RSI), m, NGW);
}

__device__ __forceinline__ void conv_phase(Frame& F) {
    const bf16* H = (const bf16*)(F.ws + WS_H); bf16* MIX = (bf16*)(F.ws + WS_MIX);
    const float* cw = F.in[5]; const float* cb = F.in[6]; const float* lg = F.in[7]; const float* lb = F.in[8];
    LAS unsigned short* hs = (LAS unsigned short*)(F.lds + RING_OFF);
    LAS float* co = (LAS float*)(F.lds + RING_OFF + 63488);
    const int c = F.tid;
    float w[31];
#pragma unroll
    for (int j = 0; j < 31; ++j) w[j] = cw[j * 512 + c];
    const float bias = cb[c];
    constexpr int NT_ = M / 32;
    v4u hreg[8];
#define CONV_LOADH(tile_) do { const int t0_ = (tile_) * 32, tb_ = t0_ & ~(T - 1); _Pragma("unroll") for (int q_ = 0; q_ < 8; ++q_) { const int i_ = F.tid + q_ * (NWAVES * 64); const int r_ = i_ >> 6, ch_ = i_ & 63, tk_ = t0_ - 15 + r_; \
        hreg[q_] = (v4u){0u, 0u, 0u, 0u}; if (i_ < 62 * 64 && tk_ >= tb_ && tk_ < tb_ + T) hreg[q_] = *(const GAS v4u*)(H + (size_t)tk_ * 512 + ch_ * 8); } } while (0)
    const float* pu_ = F.in[13]; const float* pv_ = F.in[14]; unsigned char* ut_ = F.ws + WS_UT; unsigned char* vt_ = F.ws + WS_VT; float* suv_ = (float*)(F.ws + WS_SU);
    const int gwv = F.vcu * NWAVES + F.wave, NGWv = F.G * NWAVES; int eb = gwv;
    f32x4 tq[2][4];
    if (F.vcu < NT_) CONV_LOADH(F.vcu);
    for (int tile = F.vcu; tile < NT_; tile += F.G) {
        const int t0 = tile * 32;
        bool tb_ = eb < NEXP;
        if (tb_) expert_rows_load(tq, pu_, pv_, eb, F.lane);
#pragma unroll
        for (int q = 0; q < 8; ++q) { const int i = F.tid + q * (NWAVES * 64); if (i < 62 * 64) *(LAS v4u*)(hs + (i >> 6) * 512 + (i & 63) * 8) = hreg[q]; }
        __syncthreads();
        if (tile + F.G < NT_) CONV_LOADH(tile + F.G);
#pragma unroll 1
        for (int g = 0; g < 4; ++g) {
            if (g == 2) { if (tb_) { expert_rows_finish(tq, F.in[10], ut_, vt_, suv_, eb, F.lane); eb += NGWv; }
                          tb_ = eb < NEXP; if (tb_) expert_rows_load(tq, pu_, pv_, eb, F.lane); }
            float hv[38];
#pragma unroll
            for (int r = 0; r < 38; ++r) hv[r] = __uint_as_float((unsigned)hs[(g * 8 + r) * 512 + c] << 16);
#pragma unroll
            for (int tt = 0; tt < 8; ++tt) { float a = bias;
#pragma unroll
                for (int j = 0; j < 31; ++j) a += w[j] * hv[tt + j];
                co[(g * 8 + tt) * 512 + c] = a; }
        }
        __syncthreads();
#pragma unroll 1
        for (int q = 0; q < 4; ++q) { const int tt = F.wave * 4 + q;
            const f32x4 a = *(const LAS f32x4*)(co + tt * 512 + 8 * F.lane), b = *(const LAS f32x4*)(co + tt * 512 + 8 * F.lane + 4);
            const float mean = wave_sum((a.x + a.y) + (a.z + a.w) + (b.x + b.y) + (b.z + b.w)) * (1.f / 512.f);
            const f32x4 da = a - mean, db = b - mean;
            const float var = wave_sum((da.x * da.x + da.y * da.y) + (da.z * da.z + da.w * da.w) + (db.x * db.x + db.y * db.y) + (db.z * db.z + db.w * db.w)) * (1.f / 512.f);
            const float rstd = 1.f / sqrtf(var + RMS_EPS);
            const f32x4 g0 = *(const GAS f32x4*)(lg + 8 * F.lane), g1 = *(const GAS f32x4*)(lg + 8 * F.lane + 4), b0 = *(const GAS f32x4*)(lb + 8 * F.lane), b1 = *(const GAS f32x4*)(lb + 8 * F.lane + 4);
            f32x4 y0 = da * rstd * g0 + b0, y1 = db * rstd * g1 + b1;
#pragma unroll
            for (int e = 0; e < 4; ++e) { y0[e] = y0[e] * __builtin_amdgcn_rcpf(1.f + __builtin_amdgcn_exp2f(-1.4426950408889634f * y0[e])); y1[e] = y1[e] * __builtin_amdgcn_rcpf(1.f + __builtin_amdgcn_exp2f(-1.4426950408889634f * y1[e])); }
            v4u o; o.x = pk2(y0.x, y0.y); o.y = pk2(y0.z, y0.w); o.z = pk2(y1.x, y1.y); o.w = pk2(y1.z, y1.w);
            *(GAS v4u*)(MIX + (size_t)(t0 + tt) * 1024 + 512 + 8 * F.lane) = o; }
        if (tb_) { expert_rows_finish(tq, F.in[10], ut_, vt_, suv_, eb, F.lane); eb += NGWv; }
        __syncthreads();
    }
    for (; eb < NEXP; eb += NGWv) { expert_rows_load(tq, pu_, pv_, eb, F.lane); expert_rows_finish(tq, F.in[10], ut_, vt_, suv_, eb, F.lane); }
}

__device__ __forceinline__ unsigned f2sort(float x) { const unsigned u = __float_as_uint(x); return (u & 0x80000000u) ? ~u : (u | 0x80000000u); }
__device__ __forceinline__ float sort2f(unsigned s) { const unsigned u = (s & 0x80000000u) ? (s & 0x7fffffffu) : ~s; return __uint_as_float(u); }
template <bool DESC> __device__ __forceinline__ void ce(unsigned& a, unsigned& b) { const unsigned hi = a > b ? a : b, lo = a > b ? b : a; if (DESC) { a = hi; b = lo; } else { a = lo; b = hi; } }
template <int K, int J, bool DESC> __device__ __forceinline__ void bst(unsigned (&a)[16]) {
#pragma unroll
    for (int i = 0; i < 16; ++i) { const int l = i ^ J; if (l > i) { if (((i & K) == 0) == DESC) ce<true>(a[i], a[l]); else ce<false>(a[i], a[l]); } }
}
template <bool DESC> __device__ __forceinline__ void sort16(unsigned (&a)[16]) { ce<DESC>(a[0], a[1]); ce<DESC>(a[2], a[3]); ce<DESC>(a[0], a[2]); ce<DESC>(a[1], a[3]); ce<DESC>(a[1], a[2]); ce<DESC>(a[4], a[5]); ce<DESC>(a[6], a[7]); ce<DESC>(a[4], a[6]); ce<DESC>(a[5], a[7]); ce<DESC>(a[5], a[6]); ce<DESC>(a[0], a[4]); ce<DESC>(a[2], a[6]); ce<DESC>(a[2], a[4]); ce<DESC>(a[1], a[5]); ce<DESC>(a[3], a[7]); ce<DESC>(a[3], a[5]); ce<DESC>(a[1], a[2]); ce<DESC>(a[3], a[4]); ce<DESC>(a[5], a[6]); ce<DESC>(a[8], a[9]); ce<DESC>(a[10], a[11]); ce<DESC>(a[8], a[10]); ce<DESC>(a[9], a[11]); ce<DESC>(a[9], a[10]); ce<DESC>(a[12], a[13]); ce<DESC>(a[14], a[15]); ce<DESC>(a[12], a[14]); ce<DESC>(a[13], a[15]); ce<DESC>(a[13], a[14]); ce<DESC>(a[8], a[12]); ce<DESC>(a[10], a[14]); ce<DESC>(a[10], a[12]); ce<DESC>(a[9], a[13]); ce<DESC>(a[11], a[15]); ce<DESC>(a[11], a[13]); ce<DESC>(a[9], a[10]); ce<DESC>(a[11], a[12]); ce<DESC>(a[13], a[14]); ce<DESC>(a[0], a[8]); ce<DESC>(a[4], a[12]); ce<DESC>(a[4], a[8]); ce<DESC>(a[2], a[10]); ce<DESC>(a[6], a[14]); ce<DESC>(a[6], a[10]); ce<DESC>(a[2], a[4]); ce<DESC>(a[6], a[8]); ce<DESC>(a[10], a[12]); ce<DESC>(a[1], a[9]); ce<DESC>(a[5], a[13]); ce<DESC>(a[5], a[9]); ce<DESC>(a[3], a[11]); ce<DESC>(a[7], a[15]); ce<DESC>(a[7], a[11]); ce<DESC>(a[3], a[5]); ce<DESC>(a[7], a[9]); ce<DESC>(a[11], a[13]); ce<DESC>(a[1], a[2]); ce<DESC>(a[3], a[4]); ce<DESC>(a[5], a[6]); ce<DESC>(a[7], a[8]); ce<DESC>(a[9], a[10]); ce<DESC>(a[11], a[12]); ce<DESC>(a[13], a[14]); }
template <bool DESC> __device__ __forceinline__ void merge16(unsigned (&a)[16]) { bst<16, 8, DESC>(a); bst<16, 4, DESC>(a); bst<16, 2, DESC>(a); bst<16, 1, DESC>(a); }
__device__ __forceinline__ void max16(unsigned (&a)[16], const unsigned (&b)[16]) {
#pragma unroll
    for (int i = 0; i < 16; ++i) a[i] = a[i] > b[i] ? a[i] : b[i];
}
__device__ __forceinline__ void top16_of_128(unsigned (&g)[8][16]) {
    sort16<true>(g[0]); sort16<false>(g[1]); sort16<true>(g[2]); sort16<false>(g[3]); sort16<true>(g[4]); sort16<false>(g[5]); sort16<true>(g[6]); sort16<false>(g[7]);
    max16(g[0], g[1]); merge16<true>(g[0]); max16(g[2], g[3]); merge16<false>(g[2]); max16(g[4], g[5]); merge16<true>(g[4]); max16(g[6], g[7]); merge16<false>(g[6]);
    max16(g[0], g[2]); merge16<true>(g[0]); max16(g[4], g[6]); merge16<false>(g[4]);
    max16(g[0], g[4]); merge16<true>(g[0]);
}
__device__ __forceinline__ void top16_of_64(unsigned (&g)[4][16]) {
    sort16<true>(g[0]); sort16<false>(g[1]); sort16<true>(g[2]); sort16<false>(g[3]);
    max16(g[0], g[1]); merge16<true>(g[0]); max16(g[2], g[3]); merge16<false>(g[2]);
    max16(g[0], g[2]); merge16<true>(g[0]);
}

constexpr int P5_KEYS_BYTES = 65536, P5_SCR_OFF = 65536;
typedef float f32x2p5 __attribute__((ext_vector_type(2)));
__device__ __forceinline__ void topk_phase(Frame& F) {
    typedef float f32x16 __attribute__((ext_vector_type(16)));
    const bf16* QP = (const bf16*)(F.ws + WS_QP); const bf16* KEYS = (const bf16*)(F.ws + WS_KEYS);
    unsigned short* IDX = (unsigned short*)(F.ws + WS_IDX); float* GATE = (float*)(F.ws + WS_GATE); float* SUO = (float*)(F.ws + WS_SUO);
    const GAS f32x2p5* SUVt = (const GAS f32x2p5*)(F.ws + WS_SU);
    for (int i = F.tid; i < 256 * 16; i += NWAVES * 64) { const int row = i >> 4, ch = i & 15;
        const v4u v = *(const GAS v4u*)(KEYS + row * 128 + ch * 8); *(LAS v4u*)(F.lds + RING_OFF + row * 256 + ((ch ^ (row & 15)) << 4)) = v; }
    __syncthreads();
    const int lane = F.lane, r32 = lane & 31, hi = lane >> 5, h = F.wave;
    LAS unsigned char* scr = F.lds + RING_OFF + P5_SCR_OFF + F.wave * 2048 + lane * 32;
    const bool own = (F.G == 256); const int g_lo = own ? 4 * F.vcu : F.vcu, g_hi = own ? 4 * F.vcu + 4 : M / 32, g_st = own ? 1 : F.G;
    bf16x8 qf[2][8];
#define P5_LOADQ(grp_) do { const size_t tk_ = (size_t)((grp_) * 32 + r32); _Pragma("unroll") for (int s = 0; s < 2; ++s) _Pragma("unroll") for (int ks = 0; ks < 8; ++ks) \
        qf[s][ks] = *(const GAS bf16x8*)(QP + tk_ * NPQ + 256 * h + 128 * s + 16 * ks + 8 * hi); } while (0)
    for (int grp = g_lo; grp < g_hi; grp += g_st) {
        const int tok = grp * 32 + r32;
        P5_LOADQ(grp);
        f32x16 sc[2][4];
#pragma unroll
        for (int s = 0; s < 2; ++s)
#pragma unroll
            for (int kb = 0; kb < 4; ++kb) {
                f32x16 a = {};
                const int row = s * 128 + kb * 32 + r32;
#pragma unroll
                for (int ks = 0; ks < 8; ++ks) {
                    const bf16x8 kf = *(const LAS bf16x8*)(F.lds + RING_OFF + row * 256 + (((2 * ks + hi) ^ (row & 15)) << 4));
                    a = __builtin_amdgcn_mfma_f32_32x32x16_bf16(kf, qf[s][ks], a, 0, 0, 0);
                }
                sc[s][kb] = a;
            }
        unsigned g[8][16];
#pragma unroll
        for (int kb = 0; kb < 4; ++kb)
#pragma unroll
            for (int r = 0; r < 16; ++r) {
                auto rr = __builtin_amdgcn_permlane32_swap(__float_as_uint(sc[0][kb][r]), __float_as_uint(sc[1][kb][r]), false, false);
                const int key0 = 32 * kb + (r & 3) + 8 * (r >> 2);
                g[2 * kb][r] = (f2sort(__uint_as_float(rr[0])) & ~127u) | (unsigned)(127 - key0);
                g[2 * kb + 1][r] = (f2sort(__uint_as_float(rr[1])) & ~127u) | (unsigned)(127 - (key0 + 4));
            }
        top16_of_128(g);
        unsigned s1[16], s2[16];
#pragma unroll
        for (int i = 0; i < 16; ++i) { auto rr = __builtin_amdgcn_permlane32_swap(g[0][i], g[0][i], false, false); s1[i] = rr[0]; s2[i] = rr[1]; }
        {
            unsigned w1[4], w2[4];
#pragma unroll
            for (int q = 0; q < 4; ++q) {
                w1[q] = (127u - (s1[4 * q] & 127u)) | ((127u - (s1[4 * q + 1] & 127u)) << 8) | ((127u - (s1[4 * q + 2] & 127u)) << 16) | ((127u - (s1[4 * q + 3] & 127u)) << 24);
                w2[q] = (127u - (s2[4 * q] & 127u)) | ((127u - (s2[4 * q + 1] & 127u)) << 8) | ((127u - (s2[4 * q + 2] & 127u)) << 16) | ((127u - (s2[4 * q + 3] & 127u)) << 24);
            }
            *(LAS v4u*)(scr) = (v4u){w1[0], w1[1], w1[2], w1[3]}; *(LAS v4u*)(scr + 16) = (v4u){w2[0], w2[1], w2[2], w2[3]};
        }
        float v1[16], v2[16];
#pragma unroll
        for (int i = 0; i < 16; ++i) { v1[i] = sort2f(s1[i] & ~127u); v2[i] = sort2f(s2[i] & ~127u); }
        unsigned c[4][16];
        {
            int n = 0;
#pragma unroll
            for (int a = 0; a < 16; ++a)
#pragma unroll
                for (int b = 0; b < 16; ++b)
                    if ((a + 1) * (b + 1) <= 16) { c[n >> 4][n & 15] = (f2sort(v1[a] + v2[b]) & ~255u) | (unsigned)(255 - (16 * a + b)); ++n; }
#pragma unroll
            for (int q = 50; q < 64; ++q) c[q >> 4][q & 15] = 0u;
        }
        top16_of_64(c);
        asm volatile("s_waitcnt lgkmcnt(0)" ::: "memory");
        float ts[16]; unsigned ex[16];
#pragma unroll
        for (int k = 0; k < 16; ++k) {
            const unsigned ab = 255u - (c[0][k] & 255u); const unsigned a = ab >> 4, b = ab & 15u;
            const unsigned i1 = *(const LAS unsigned char*)(scr + a), i2 = *(const LAS unsigned char*)(scr + 16 + b);
            ex[k] = i1 * 128u + i2; ts[k] = sort2f(c[0][k] & ~255u);
        }
        float den = 0.f; const float tmax = ts[0];
#pragma unroll
        for (int k = 0; k < 16; ++k) { ts[k] = __builtin_amdgcn_exp2f((ts[k] - tmax) * 1.4426950408889634f); den += ts[k]; }
        const float rden = __builtin_amdgcn_rcpf(den);
        unsigned eo[8]; float go[8];
#pragma unroll
        for (int k = 0; k < 8; ++k) { eo[k] = hi ? ex[k + 8] : ex[k]; go[k] = (hi ? ts[k + 8] : ts[k]) * rden; }
        float so[8];
#pragma unroll
        for (int k = 0; k < 8; ++k) { const f32x2p5 sv2 = SUVt[eo[k]]; so[k] = sv2.x; go[k] *= sv2.y; }
        const size_t ob = (size_t)tok * 128 + h * 16 + hi * 8;
        *(GAS v4u*)(IDX + ob) = (v4u){eo[0] | (eo[1] << 16), eo[2] | (eo[3] << 16), eo[4] | (eo[5] << 16), eo[6] | (eo[7] << 16)};
        *(GAS f32x4*)(GATE + ob) = (f32x4){go[0], go[1], go[2], go[3]}; *(GAS f32x4*)(GATE + ob + 4) = (f32x4){go[4], go[5], go[6], go[7]};
        *(GAS f32x4*)(SUO + ob) = (f32x4){so[0], so[1], so[2], so[3]}; *(GAS f32x4*)(SUO + ob + 4) = (f32x4){so[4], so[5], so[6], so[7]};
    }
#undef P5_LOADQ
    __syncthreads();
}

typedef float f32x2 __attribute__((ext_vector_type(2)));
__device__ __forceinline__ v4u bufload16(__amdgpu_buffer_rsrc_t rsrc, unsigned voff, unsigned soff) { return __builtin_bit_cast(v4u, __builtin_amdgcn_raw_buffer_load_b128(rsrc, (int)voff, (int)soff, 0)); }
__device__ __forceinline__ int dot4(unsigned a, unsigned b, int c) { return __builtin_amdgcn_sdot4((int)a, (int)b, c, false); }
template <int CTRL> __device__ __forceinline__ int dpp_mov(int v) { return __builtin_amdgcn_update_dpp(0, v, CTRL, 0xf, 0xf, false); }
#ifndef P6_PREFETCH
#define P6_PREFETCH 0
#endif
template <bool VPASS>
__device__ __forceinline__ void p6_load(v4u (&u)[16], v4u& xq, unsigned& x1w, const __amdgpu_buffer_rsrc_t rt, const unsigned char* XQ, const bf16* X1B, LAS unsigned* ids, int tok0, int it, int g, int m,
                                        const __amdgpu_buffer_rsrc_t rpf_u, const __amdgpu_buffer_rsrc_t rpf_v, unsigned pfbase, int lane, unsigned& pv) {
    const int s = it >> 4, t = it & 15; const unsigned soff = (unsigned)s << 21;
    pv = 0u;
#if P6_PREFETCH
    if (lane < 4) {
        const bool last = (s == 7);
        if (!(VPASS && last)) {
            const unsigned nso = last ? 0u : (unsigned)(s + 1) << 21;
            pv = (unsigned)__builtin_amdgcn_raw_buffer_load_b32((!VPASS && !last) ? rpf_u : rpf_v, (int)(pfbase + 512u * (unsigned)t + 128u * (unsigned)lane), (int)nso, 0);
        }
    }
#endif
    if (VPASS) x1w = __builtin_nontemporal_load((const GAS unsigned*)(X1B + (size_t)(tok0 + t) * D + 128 * s + 2 * lane));
    else xq = __builtin_nontemporal_load((const GAS v4u*)(XQ + (size_t)(tok0 + t) * D + 128 * s + 16 * m));
    const v4u ia = *(const LAS v4u*)(ids + t * 64 + 8 * g), ib = *(const LAS v4u*)(ids + t * 64 + 8 * g + 4);
    const unsigned idw[8] = {ia.x, ia.y, ia.z, ia.w, ib.x, ib.y, ib.z, ib.w};
#pragma unroll
    for (int k = 0; k < 16; ++k) { const unsigned id = (k & 1) ? (idw[k >> 1] >> 16) : (idw[k >> 1] & 0xffffu); u[k] = bufload16(rt, (id << 7) | ((unsigned)m << 4), soff); }
}
__device__ __forceinline__ void p6_comp_u(const v4u (&u)[16], const v4u xq, LAS int* da, int it, int lane) {
    const int t = it & 15;
    int p[16];
#pragma unroll
    for (int k = 0; k < 16; ++k) { int q0; asm("v_dot4_i32_i8 %0, %1, %2, 0" : "=v"(q0) : "v"(u[k].x), "v"(xq.x));
        p[k] = dot4(u[k].w, xq.w, dot4(u[k].z, xq.z, dot4(u[k].y, xq.y, q0))); }
    asm volatile("s_nop 1\n\t"
        "v_add_u32_dpp %0, %0, %0 row_half_mirror row_mask:0xf bank_mask:0x5\n\tv_add_u32_dpp %1, %1, %1 row_half_mirror row_mask:0xf bank_mask:0x5\n\t"
        "v_add_u32_dpp %2, %2, %2 row_half_mirror row_mask:0xf bank_mask:0x5\n\tv_add_u32_dpp %3, %3, %3 row_half_mirror row_mask:0xf bank_mask:0x5\n\t"
        "v_add_u32_dpp %4, %4, %4 row_half_mirror row_mask:0xf bank_mask:0x5\n\tv_add_u32_dpp %5, %5, %5 row_half_mirror row_mask:0xf bank_mask:0x5\n\t"
        "v_add_u32_dpp %6, %6, %6 row_half_mirror row_mask:0xf bank_mask:0x5\n\tv_add_u32_dpp %7, %7, %7 row_half_mirror row_mask:0xf bank_mask:0x5\n\t"
        "v_add_u32_dpp %0, %8, %8 row_half_mirror row_mask:0xf bank_mask:0xa\n\tv_add_u32_dpp %1, %9, %9 row_half_mirror row_mask:0xf bank_mask:0xa\n\t"
        "v_add_u32_dpp %2, %10, %10 row_half_mirror row_mask:0xf bank_mask:0xa\n\tv_add_u32_dpp %3, %11, %11 row_half_mirror row_mask:0xf bank_mask:0xa\n\t"
        "v_add_u32_dpp %4, %12, %12 row_half_mirror row_mask:0xf bank_mask:0xa\n\tv_add_u32_dpp %5, %13, %13 row_half_mirror row_mask:0xf bank_mask:0xa\n\t"
        "v_add_u32_dpp %6, %14, %14 row_half_mirror row_mask:0xf bank_mask:0xa\n\tv_add_u32_dpp %7, %15, %15 row_half_mirror row_mask:0xf bank_mask:0xa\n\ts_nop 1"
        : "+v"(p[0]), "+v"(p[1]), "+v"(p[2]), "+v"(p[3]), "+v"(p[4]), "+v"(p[5]), "+v"(p[6]), "+v"(p[7])
        : "v"(p[8]), "v"(p[9]), "v"(p[10]), "v"(p[11]), "v"(p[12]), "v"(p[13]), "v"(p[14]), "v"(p[15]));
    { const bool up = (lane & 2) != 0;
#pragma unroll
      for (int k = 0; k < 4; ++k) { const int keep = up ? p[k + 4] : p[k], send = up ? p[k] : p[k + 4]; p[k] = keep + dpp_mov<0x4E>(send); } }
    { const bool up = (lane & 1) != 0;
#pragma unroll
      for (int k = 0; k < 2; ++k) { const int keep = up ? p[k + 2] : p[k], send = up ? p[k] : p[k + 2]; p[k] = keep + dpp_mov<0xB1>(send); } }
    typedef int i32x2 __attribute__((ext_vector_type(2)));
    LAS i32x2* dp = (LAS i32x2*)(da + t * 128 + 2 * lane); i32x2 dv = *dp; dv.x += p[0]; dv.y += p[1]; *dp = dv;
}
typedef int v2i32_t __attribute__((ext_vector_type(2)));
constexpr int P6_PLANE = 1040;
__device__ __forceinline__ void p6_comp_v(const v4u (&u)[16], const unsigned x1w, LAS unsigned char* img, const LAS unsigned char* wq, const LAS float* sc, bf16* XF, int tok0, int it, int lane, int g, int m) {
    const int s = it >> 4, t = it & 15;
    const int h = lane >> 5, pp = (lane >> 4) & 1, i16 = lane & 15;
    LAS unsigned char* wa = img + m * P6_PLANE + (8 * g) * 16;
    const LAS unsigned char* ra = img + (4 * h) * P6_PLANE + (8 * pp + (i16 >> 1)) * 16 + 8 * (i16 & 1);
    v4u W4[4];
#pragma unroll
    for (int n = 0; n < 4; ++n) W4[n] = *(const LAS v4u*)(wq + t * 128 + (2 * n + pp) * 16);
    int a[4] = {0, 0, 0, 0};
#pragma unroll
    for (int hf = 0; hf < 2; ++hf) {
#pragma unroll
        for (int k = 0; k < 8; ++k) *(LAS v4u*)(wa + 16 * k) = u[8 * hf + k];
#pragma unroll
        for (int n = 0; n < 4; ++n)
#pragma unroll
            for (int dbi = 0; dbi < 4; ++dbi) {
                const v2i32_t v = __builtin_amdgcn_ds_read_tr8_b64_v2i32((LAS v2i32_t*)(ra + dbi * P6_PLANE + 256 * n));
                a[dbi] = dot4((unsigned)v.y, W4[n][2 * hf + 1], dot4((unsigned)v.x, W4[n][2 * hf], a[dbi]));
            }
    }
    int tot[2];
#pragma unroll
    for (int d = 0; d < 2; ++d) { auto rr = __builtin_amdgcn_permlane16_swap((unsigned)a[d], (unsigned)a[d + 2], false, false); tot[d] = (int)rr[0] + (int)rr[1]; }
    const float sw = sc[16 + t];
    const float xf0 = __uint_as_float(x1w << 16) + (float)tot[0] * sw, xf1 = __uint_as_float(x1w & 0xffff0000u) + (float)tot[1] * sw;
    *(GAS unsigned*)(XF + (size_t)(tok0 + t) * D + 128 * s + 2 * lane) = pk2(xf0, xf1);
}
__device__ __forceinline__ void peer_phase(Frame& F) {
    const bf16* X1B = (const bf16*)(F.ws + WS_XN); bf16* XF = (bf16*)(F.ws + WS_MIX);
    unsigned char* XQ = F.ws + WS_XQ;
    const unsigned short* IDX = (const unsigned short*)(F.ws + WS_IDX); const float* GATE = (const float*)(F.ws + WS_GATE); const float* SS = (const float*)(F.ws + WS_SS);
    const float* SUO = (const float*)(F.ws + WS_SUO);
    const float* fg = F.in[15]; float* OUT = F.out;
    const int lane = F.lane, g = lane >> 3, m = lane & 7;
    const __amdgpu_buffer_rsrc_t ru = __builtin_amdgcn_make_buffer_rsrc((void*)(F.ws + WS_UT), 0, 16 << 20, 0x00020000);
    const __amdgpu_buffer_rsrc_t rv = __builtin_amdgcn_make_buffer_rsrc((void*)(F.ws + WS_VT), 0, 16 << 20, 0x00020000);
    LAS unsigned char* wl = F.lds + RING_OFF + F.wave * 16384;
    LAS unsigned* ids = (LAS unsigned*)wl;
    LAS int* da = (LAS int*)(wl + 4096);
    LAS unsigned char* img = wl + 4096;
    LAS unsigned char* wq = wl + 12416;
    LAS float* sc = (LAS float*)(wl + 14464);
    const int gw = F.vcu * NWAVES + F.wave, NGW = F.G * NWAVES;
    const unsigned pfbase = (unsigned)(((F.vcu & 31) * NWAVES + F.wave) * 8192);
    for (int tg = gw; tg < M / 16; tg += NGW) {
        const int tok0 = tg * 16;
#pragma unroll 1
        for (int tb = 0; tb < 16; tb += 4) {
            v4u xa[4], xb[4]; unsigned idv[4];
#pragma unroll
            for (int j = 0; j < 4; ++j) { const int t = tb + j;
                idv[j] = *(const GAS unsigned*)(IDX + (size_t)(tok0 + t) * 128 + 2 * lane);
                const GAS v4u* xp = (const GAS v4u*)(X1B + (size_t)(tok0 + t) * D + 16 * lane); xa[j] = xp[0]; xb[j] = xp[1]; }
#pragma unroll
            for (int j = 0; j < 4; ++j) { const int t = tb + j;
                ids[t * 64 + lane] = idv[j];
                typedef int i32x2 __attribute__((ext_vector_type(2)));
                *(LAS i32x2*)(da + t * 128 + 2 * lane) = (i32x2){0, 0};
                const unsigned xw[8] = {xa[j].x, xa[j].y, xa[j].z, xa[j].w, xb[j].x, xb[j].y, xb[j].z, xb[j].w};
                float xv[16]; float amax = 0.f;
#pragma unroll
                for (int q = 0; q < 8; ++q) { xv[2 * q] = __uint_as_float(xw[q] << 16); xv[2 * q + 1] = __uint_as_float(xw[q] & 0xffff0000u); amax = fmaxf(amax, fmaxf(fabsf(xv[2 * q]), fabsf(xv[2 * q + 1]))); }
#pragma unroll
                for (int o = 1; o < 64; o <<= 1) amax = fmaxf(amax, __shfl_xor(amax, o));
                const float inv = amax > 0.f ? 127.0f / amax : 0.f;
                v4u o4;
#pragma unroll
                for (int q = 0; q < 4; ++q) o4[q] = pack_i8x4((f32x4){xv[4 * q], xv[4 * q + 1], xv[4 * q + 2], xv[4 * q + 3]} * inv);
                *(GAS v4u*)(XQ + (size_t)(tok0 + t) * D + 16 * lane) = o4;
                if (lane == 0) sc[t] = amax > 0.f ? amax * (1.0f / 127.0f) : 1.0f; }
        }
        asm volatile("s_waitcnt vmcnt(0)" ::: "memory");
        {
            v4u uA[16], uB[16]; v4u xA, xB; unsigned dummy; unsigned pvA, pvB, pfacc = 0u;
            p6_load<false>(uA, xA, dummy, ru, XQ, X1B, ids, tok0, 0, g, m, ru, rv, pfbase, lane, pvA);
#pragma unroll 1
            for (int it = 0; it < 128; it += 2) {
                p6_load<false>(uB, xB, dummy, ru, XQ, X1B, ids, tok0, it + 1, g, m, ru, rv, pfbase, lane, pvB);
                p6_comp_u(uA, xA, da, it, lane);
                pfacc ^= pvA; p6_load<false>(uA, xA, dummy, ru, XQ, X1B, ids, tok0, (it + 2 < 128) ? it + 2 : 127, g, m, ru, rv, pfbase, lane, pvA);
                p6_comp_u(uB, xB, da, it + 1, lane); pfacc ^= pvB;
            }
            asm volatile("" :: "v"(pfacc ^ pvA));
        }
#pragma unroll 1
        for (int tb = 0; tb < 16; tb += 4) {
            float ssv[4]; f32x2 gt2[4]; f32x2 su2[4];
#pragma unroll
            for (int j = 0; j < 4; ++j) { const int t = tb + j, tok = tok0 + t;
                ssv[j] = (lane < 16) ? SS[(size_t)tok * 16 + lane] : 0.f;
                gt2[j] = *(const GAS f32x2*)(GATE + (size_t)tok * 128 + 2 * lane);
                su2[j] = *(const GAS f32x2*)(SUO + (size_t)tok * 128 + 2 * lane); }
#pragma unroll
            for (int j = 0; j < 4; ++j) { const int t = tb + j;
                const float rstd2 = 1.f / sqrtf(wave_sum(ssv[j]) * (1.f / D) + RMS_EPS);
                typedef int i32x2 __attribute__((ext_vector_type(2)));
                const i32x2 dv = *(const LAS i32x2*)(da + t * 128 + 2 * lane);
                const float zs = sc[t] * rstd2;
                const float z0 = (float)dv.x * su2[j].x * zs, z1 = (float)dv.y * su2[j].y * zs;
                const float h0 = z0 * __builtin_amdgcn_rcpf(1.f + __builtin_amdgcn_exp2f(-1.4426950408889634f * 1.5957691216057308f * (z0 + 0.044715f * z0 * z0 * z0)));
                const float h1 = z1 * __builtin_amdgcn_rcpf(1.f + __builtin_amdgcn_exp2f(-1.4426950408889634f * 1.5957691216057308f * (z1 + 0.044715f * z1 * z1 * z1)));
                const float w0 = gt2[j].x * h0, w1 = gt2[j].y * h1;
                float wmax = fmaxf(fabsf(w0), fabsf(w1));
#pragma unroll
                for (int o = 1; o < 64; o <<= 1) wmax = fmaxf(wmax, __shfl_xor(wmax, o));
                const float winv = wmax > 0.f ? 127.0f / wmax : 0.f;
                const int q0 = (int)__builtin_rintf(w0 * winv), q1 = (int)__builtin_rintf(w1 * winv);
                *(LAS unsigned short*)(wq + t * 128 + 2 * lane) = (unsigned short)((q0 & 0xff) | ((q1 & 0xff) << 8));
                if (lane == 0) sc[16 + t] = wmax * (1.0f / 127.0f); }
        }
        {
            v4u uA[16], uB[16]; unsigned xA, xB; v4u dummy; unsigned pvA, pvB, pfacc = 0u;
            p6_load<true>(uA, dummy, xA, rv, XQ, X1B, ids, tok0, 0, g, m, ru, rv, pfbase, lane, pvA);
#pragma unroll 1
            for (int it = 0; it < 128; it += 2) {
                p6_load<true>(uB, dummy, xB, rv, XQ, X1B, ids, tok0, it + 1, g, m, ru, rv, pfbase, lane, pvB);
                p6_comp_v(uA, xA, img, wq, sc, XF, tok0, it, lane, g, m);
                pfacc ^= pvA; p6_load<true>(uA, dummy, xA, rv, XQ, X1B, ids, tok0, (it + 2 < 128) ? it + 2 : 127, g, m, ru, rv, pfbase, lane, pvA);
                p6_comp_v(uB, xB, img, wq, sc, XF, tok0, it + 1, lane, g, m); pfacc ^= pvB;
            }
            asm volatile("" :: "v"(pfacc ^ pvA));
        }
#pragma unroll 1
        for (int tb = 0; tb < 16; tb += 4) {
            unsigned xw[4][8];
#pragma unroll
            for (int j = 0; j < 4; ++j)
#pragma unroll
                for (int s = 0; s < 8; ++s) xw[j][s] = *(const GAS unsigned*)(XF + (size_t)(tok0 + tb + j) * D + 128 * s + 2 * lane);
            f32x2 gg[8];
#pragma unroll
            for (int s = 0; s < 8; ++s) gg[s] = *(const GAS f32x2*)(fg + 128 * s + 2 * lane);
#pragma unroll
            for (int j = 0; j < 4; ++j) {
                float ss = 0.f;
#pragma unroll
                for (int s = 0; s < 8; ++s) { const float a0 = __uint_as_float(xw[j][s] << 16), a1 = __uint_as_float(xw[j][s] & 0xffff0000u); ss += a0 * a0 + a1 * a1; }
                const float rstd = 1.f / sqrtf(wave_sum(ss) * (1.f / D) + RMS_EPS);
#pragma unroll
                for (int s = 0; s < 8; ++s) { const size_t off = (size_t)(tok0 + tb + j) * D + 128 * s + 2 * lane;
                    f32x2 ov = (f32x2){__uint_as_float(xw[j][s] << 16) * rstd * gg[s].x, __uint_as_float(xw[j][s] & 0xffff0000u) * rstd * gg[s].y};
                    __builtin_nontemporal_store(ov, (GAS f32x2*)(OUT + off)); }
            }
        }
    }
}

struct Args { const float* in[16]; float* out; unsigned char* ws; int ph_lo, ph_hi, li, pad; };
__global__ void __launch_bounds__(NWAVES * 64, 2) mk_fwd(Args args) {
    extern __shared__ __attribute__((aligned(16))) unsigned char lds[];
    Frame F;
    F.lds = (LAS unsigned char*)lds;
    F.MISC = (volatile LAS unsigned*)(F.lds + MISC_OFF);
    F.tid = threadIdx.x; F.lane = F.tid & 63; F.wave = __builtin_amdgcn_readfirstlane(F.tid >> 6);
    F.G = gridDim.x; { const int bx = blockIdx.x; F.vcu = (F.G % 8 == 0) ? (bx % 8) * (F.G / 8) + bx / 8 : bx; }
#define GRID_BAR(seam) do { if (N_LAUNCHES == PER_PHASE) { if (F.tid == 0) __hip_atomic_store(F.ctl + CW_TMO, 0xBADBA0u | (unsigned)(seam), RLX_AGENT); } \
    else { xcd_barrier(bar); } } while (0)
    unsigned char* ws = args.ws;
    F.ctl = (gu32*)(ws + WS_CTL); F.ws = ws; F.out = args.out;
#pragma unroll
    for (int i = 0; i < 16; ++i) F.in[i] = args.in[i];
    for (int u = F.tid; u < (LDS_BYTES - LDSCTL_OFF) / 4; u += NWAVES * 64) ((LAS unsigned*)(F.lds + LDSCTL_OFF))[u] = 0u;
    __syncthreads();
    XcdBarrier bar; bar.bar = (unsigned*)(F.ctl + CW_BAR); bar.x = 0; bar.st = nullptr;
    if (N_LAUNCHES != PER_PHASE) bar = xcd_barrier_post((unsigned*)(F.ctl + CW_BAR), F.MISC + 8);

    const pg8::WsSt WST{__builtin_amdgcn_make_buffer_rsrc((void*)ws, 0, (int)WS_END, 0x00020000), ws};
    const int lo = args.ph_lo, hi = args.ph_hi;
#define IN(k) (lo <= (k) && (k) < hi)
#define BOTH(k) (IN(k) && IN((k) + 1))

    if (IN(0)) { p0_prologue(F); if (BOTH(0)) GRID_BAR(0); }

    if (IN(1)) {
        pg8::Gemm g{(const pg8::bf16_t*)(ws + WS_XN), (const pg8::bf16_t*)(ws + WS_WIN), M, NIN, D}; pg8::StaticOrder S; S.init(M, NIN, F.G, (int)blockIdx.x);
        pg8::EpiP1 E{WST, WS_Q, WS_K, WS_V8T, WS_H, F.in[3], F.in[4], (const float*)(ws + WS_ROPE), attn_body::C2};
        pg8::gemm_phase<pg8::EpiP1, pg8::StaticOrder, PG8_ALIGN, PG8_SP2>(F.lds + RING_OFF, g, S, E);
        if (BOTH(1)) GRID_BAR(1);
    }

    if (IN(2)) {
        const attn_body::AttnTensors AT{(const attn_body::bf16*)(ws + WS_Q), (const attn_body::bf16*)(ws + WS_K), (const attn_body::bf16*)(ws + WS_V8T), (attn_body::bf16*)(ws + WS_MIX)};
        const attn_body::StaticOrder S((int)F.G, (int)blockIdx.x);
        bool attn_fast;
        { const float gq = fabsf(F.in[3][F.lane]), gk = fabsf(F.in[4][F.lane]); float mq = gq, mk = gk;
#pragma unroll
          for (int o = 1; o < 64; o <<= 1) { mq = fmaxf(mq, __shfl_xor(mq, o)); mk = fmaxf(mk, __shfl_xor(mk, o)); }
          attn_fast = (64.0f * attn_body::C2 * mq * mk <= 14.0f); }
#if defined(FORCE_ATTN_SLOW)
        attn_fast = false;
#endif
        attn_body::attn_phase<attn_body::StaticOrder>((char*)lds + RING_OFF, AT, S, attn_fast);
        __syncthreads();
        conv_phase(F);
        if (BOTH(2)) GRID_BAR(2);
    }

    if (IN(3)) {
        pg8::Gemm g{(const pg8::bf16_t*)(ws + WS_MIX), (const pg8::bf16_t*)(ws + WS_WOUT), M, D, D}; pg8::StaticOrder S; S.init(M, D, F.G, (int)blockIdx.x);
        pg8::EpiP3 E{WST, WS_XN, (pg8::bf16_t*)(ws + WS_XN), (const float*)(ws + WS_RSI), (const float*)(ws + WS_IG1), (float*)(ws + WS_SS)};
        pg8::gemm_phase<pg8::EpiP3, pg8::StaticOrder, PG8_ALIGN, PG8_SP2>(F.lds + RING_OFF, g, S, E);
        if (BOTH(3)) GRID_BAR(3);
    }

    if (IN(4)) {
        pg8::Gemm g{(const pg8::bf16_t*)(ws + WS_XN), (const pg8::bf16_t*)(ws + WS_WQ), M, NPQ, D}; pg8::StaticOrder S; S.init(M, NPQ, F.G, (int)blockIdx.x);
        pg8::EpiP4 E{WST, WS_QP, (const float*)(ws + WS_SS)};
        pg8::gemm_phase<pg8::EpiP4, pg8::StaticOrder, PG8_ALIGN, PG8_SP2>(F.lds + RING_OFF, g, S, E);
        if (BOTH(4)) GRID_BAR(4);
    }

    if (IN(5)) { topk_phase(F); if (BOTH(5)) { if (F.G == 256) { asm volatile("s_waitcnt vmcnt(0)" ::: "memory"); __syncthreads(); } else GRID_BAR(5); } }

    if (IN(6)) { peer_phase(F); }
#undef IN
#undef BOTH
}

extern "C" void kernel_launch(void* const* d_in, const int* in_sizes, int n_in, void* d_out, int out_size, void* d_ws, size_t ws_size, hipStream_t stream) {
    static int grid = 0;
    if (grid == 0) {
        if (n_in != 16 || in_sizes[0] != M * D || out_size != M * D || ws_size < WS_END) { fprintf(stderr, "kernel_launch: built for 16 inputs, x and out of %d floats, >= %zu bytes of workspace; got n_in %d, in0 %d, out %d, ws %zu; nothing launched\n", M * D, (size_t)WS_END, n_in, n_in > 0 ? in_sizes[0] : -1, out_size, ws_size); grid = -1; return; }
        int dev = 0, cus = 0, per_cu = 0;
        if (hipGetDevice(&dev) != hipSuccess || hipDeviceGetAttribute(&cus, hipDeviceAttributeMultiprocessorCount, dev) != hipSuccess) { fprintf(stderr, "kernel_launch: hipGetDevice / hipDeviceGetAttribute failed; nothing launched\n"); grid = -1; return; }
        if (hipFuncSetAttribute((const void*)mk_fwd, hipFuncAttributeMaxDynamicSharedMemorySize, LDS_BYTES) != hipSuccess) { fprintf(stderr, "kernel_launch: hipFuncSetAttribute failed\n"); grid = -1; return; }
        if (hipOccupancyMaxActiveBlocksPerMultiprocessor(&per_cu, (const void*)mk_fwd, NWAVES * 64, LDS_BYTES) != hipSuccess || per_cu < 1)
            fprintf(stderr, "kernel_launch: note: the occupancy query reports %d workgroups per CU\n", per_cu);
        (void)hipGetLastError();
        grid = cus;
        if (grid != 256) { fprintf(stderr, "kernel_launch: this kernel's static work deals are built for the 256 CUs of an MI355X; found %d; nothing launched\n", grid); grid = -1; return; }
    }
    if (grid < 0) return;
    if (hipMemsetAsync((char*)d_ws + WS_CTL, 0, CTL_ZERO_BYTES, stream) != hipSuccess) { fprintf(stderr, "kernel_launch: hipMemsetAsync of the control words failed; nothing launched\n"); return; }
    Args a{};
    for (int i = 0; i < 16; ++i) a.in[i] = (const float*)d_in[i];
    a.out = (float*)d_out; a.ws = (unsigned char*)d_ws;
    for (int li = 0; li < N_LAUNCHES; ++li) {
        a.ph_lo = (N_LAUNCHES == PER_PHASE) ? li : 0; a.ph_hi = (N_LAUNCHES == PER_PHASE) ? li + 1 : PER_PHASE; a.li = li;
        hipLaunchKernelGGL(mk_fwd, dim3(grid), dim3(NWAVES * 64), LDS_BYTES, stream, a);
        const hipError_t le = hipPeekAtLastError();
        if (le != hipSuccess) { fprintf(stderr, "kernel_launch: launch %d failed: %s\n", li, hipGetErrorName(le)); break; }
    }
}
```
